# Optimizing an MI355X kernel written in HIP

```python
import math
import jax, jax.numpy as jnp
from jax import lax
import numpy as np

D_MODEL = 1024
BATCH = 4
SEQ = 8192
DEPTH = 1

CHUNK = 64
EPS = 1e-6

A_HEADS = 8
A_HEAD_DIM = 64
A_WIDTH = A_HEADS * A_HEAD_DIM
A_LEFT_CHUNKS = 8
A_BAND = (A_LEFT_CHUNKS + 1) * CHUNK
A_REL_CLIP = 256

B_HEADS = 8
B_HEAD_DIM = 64
B_WIDTH = B_HEADS * B_HEAD_DIM
IDX_HEADS = 8
IDX_DIM = 64
TOPK_MAX = 256
Q_BLOCK = 128

T5_BUCKETS = 32
T5_MAX_DIST = 128

SPLITS = (A_WIDTH, A_WIDTH, A_WIDTH, A_WIDTH,
          B_WIDTH, B_HEAD_DIM, B_HEAD_DIM, B_WIDTH,
          IDX_HEADS * IDX_DIM, IDX_DIM, IDX_HEADS,
          D_MODEL, D_MODEL)
IN_COLS = 4 * A_WIDTH + 2 * B_WIDTH + 2 * B_HEAD_DIM + IDX_HEADS * IDX_DIM + IDX_DIM + IDX_HEADS + 2 * D_MODEL

kernel_name = "hybrid_chunkband_dsa_gated_merge"

NEG = -1e30


def rms_norm(x, g):
    xf = x.astype(jnp.float32)
    y = xf * lax.rsqrt(jnp.mean(xf * xf, axis=-1, keepdims=True) + EPS)
    return (y * g.astype(jnp.float32)).astype(x.dtype)


def t5_bucket(rel):
    half = T5_BUCKETS // 2
    max_exact = half // 2
    ret = jnp.where(rel > 0, half, 0)
    n = jnp.abs(rel)
    nf = jnp.maximum(n, 1).astype(jnp.float32)
    large = max_exact + (jnp.log(nf / max_exact) / math.log(T5_MAX_DIST / max_exact)
                         * (half - max_exact)).astype(jnp.int32)
    large = jnp.minimum(large, half - 1)
    return ret + jnp.where(n < max_exact, n, large)


def chunk_band_attention(q, k, v, rel_bias):
    B, S, H, Dh = q.shape
    nc = S // CHUNK
    pad = A_LEFT_CHUNKS * CHUNK
    kp = jnp.pad(k, ((0, 0), (pad, 0), (0, 0), (0, 0))).astype(jnp.float32)
    vp = jnp.pad(v, ((0, 0), (pad, 0), (0, 0), (0, 0))).astype(jnp.float32)
    qc = q.astype(jnp.float32).reshape(B, nc, CHUNK, H, Dh).swapaxes(0, 1)
    i = jnp.arange(CHUNK)
    j = jnp.arange(A_BAND)
    rel = i[:, None] - (j[None, :] - pad)
    bias = rel_bias.astype(jnp.float32)[:, jnp.clip(rel, -A_REL_CLIP, A_REL_CLIP) + A_REL_CLIP]
    scale = Dh ** -0.5

    def one_chunk(args):
        qb, c = args
        kb = lax.dynamic_slice_in_dim(kp, c * CHUNK, A_BAND, axis=1)
        vb = lax.dynamic_slice_in_dim(vp, c * CHUNK, A_BAND, axis=1)
        s = jnp.einsum('bqhd,bkhd->bhqk', qb, kb) * scale + bias[None]
        valid = (c * CHUNK - pad + j) >= 0
        s = jnp.where(valid[None, None, None, :], s, NEG)
        p = jax.nn.softmax(s, axis=-1)
        return jnp.einsum('bhqk,bkhd->bqhd', p, vb)

    out = lax.map(one_chunk, (qc, jnp.arange(nc)))
    return out.swapaxes(0, 1).reshape(B, S, H * Dh).astype(q.dtype)


def dsa_attention(q, k, v, qi, ki, wi, t5_bias):
    B, S, H, Dh = q.shape
    n_sel = min(TOPK_MAX, S // 4)
    nb = S // Q_BLOCK
    key_chunk = jnp.arange(S) // CHUNK
    k32 = k.astype(jnp.float32)
    v32 = v.astype(jnp.float32)
    ki32 = ki.astype(jnp.float32)
    tb = t5_bias.astype(jnp.float32)
    scale = Dh ** -0.5
    idx_scale = (IDX_HEADS ** -0.5) * (IDX_DIM ** -0.5)

    def blocks(a):
        return a.reshape((B, nb, Q_BLOCK) + a.shape[2:]).swapaxes(0, 1)

    gather = jax.vmap(lambda kk, ss: kk[ss])

    def one_block(args):
        qb, qib, wib, blk = args
        qpos = blk * Q_BLOCK + jnp.arange(Q_BLOCK)
        qchunk = qpos // CHUNK
        admissible = key_chunk[None, :] <= qchunk[:, None]
        idx_logits = jnp.einsum('bqhd,bsd->bqhs', qib.astype(jnp.float32), ki32)
        score = jnp.einsum('bqhs,bqh->bqs', jax.nn.relu(idx_logits),
                           wib.astype(jnp.float32) * idx_scale)
        score = jnp.where(admissible[None], score, -jnp.inf)
        _, sel = lax.top_k(score, n_sel)
        sel_ok = (sel // CHUNK) <= qchunk[None, :, None]
        ks = gather(k32, sel)
        vs = gather(v32, sel)
        s = jnp.einsum('bqhd,bqkd->bqhk', qb.astype(jnp.float32), ks) * scale
        bias = tb[t5_bucket(sel - qpos[None, :, None])]
        s = s + jnp.swapaxes(bias, 2, 3)
        s = jnp.where(sel_ok[:, :, None, :], s, NEG)
        p = jax.nn.softmax(s, axis=-1)
        return jnp.einsum('bqhk,bqkd->bqhd', p, vs)

    out = lax.map(one_block, (blocks(q), blocks(qi), blocks(wi), jnp.arange(nb)))
    return out.swapaxes(0, 1).reshape(B, S, H * Dh).astype(q.dtype)


def setup_inputs(seed: int = 0) -> dict:
    key = jax.random.key(seed)
    ks = jax.random.split(key, 10)
    f32 = jnp.float32
    x = jax.random.normal(ks[0], (BATCH, SEQ, D_MODEL), f32)
    norm_gain = 1.0 + 0.01 * jax.random.normal(ks[1], (DEPTH, D_MODEL), f32)
    w_in = jax.random.normal(ks[2], (DEPTH, D_MODEL, IN_COLS), f32) * D_MODEL ** -0.5
    a_rel_bias = 0.1 * jax.random.normal(ks[3], (DEPTH, A_HEADS, 2 * A_REL_CLIP + 1), f32)
    t5_bias = 0.1 * jax.random.normal(ks[4], (T5_BUCKETS, B_HEADS), f32)
    w_a_out = jax.random.normal(ks[5], (DEPTH, A_WIDTH, D_MODEL), f32) * A_WIDTH ** -0.5
    w_b_out = jax.random.normal(ks[6], (DEPTH, B_WIDTH, D_MODEL), f32) * B_WIDTH ** -0.5
    w_out = jax.random.normal(ks[7], (DEPTH, D_MODEL, D_MODEL), f32) * D_MODEL ** -0.5
    final_gain = 1.0 + 0.01 * jax.random.normal(ks[8], (D_MODEL,), f32)
    return {"x": x, "norm_gain": norm_gain, "w_in": w_in, "a_rel_bias": a_rel_bias,
            "t5_bias": t5_bias, "w_a_out": w_a_out, "w_b_out": w_b_out,
            "w_out": w_out, "final_gain": final_gain}


def reference(x, norm_gain, w_in, a_rel_bias, t5_bias, w_a_out, w_b_out, w_out, final_gain):
    B, S, _ = x.shape
    offsets = [int(o) for o in np.cumsum(SPLITS)[:-1]]
    h = x
    for l in range(DEPTH):
        hn = rms_norm(h, norm_gain[l])
        proj = hn @ w_in[l]
        (qa, ka, va, za, qb, kb, vb, zb, qi, ki, wi, ga, gb) = jnp.split(proj, offsets, axis=-1)
        ya = chunk_band_attention(qa.reshape(B, S, A_HEADS, A_HEAD_DIM),
                                  ka.reshape(B, S, A_HEADS, A_HEAD_DIM),
                                  va.reshape(B, S, A_HEADS, A_HEAD_DIM),
                                  a_rel_bias[l]) * jax.nn.silu(za)
        yb = dsa_attention(qb.reshape(B, S, B_HEADS, B_HEAD_DIM), kb, vb,
                           qi.reshape(B, S, IDX_HEADS, IDX_DIM), ki, wi,
                           t5_bias) * jax.nn.silu(zb)
        merged = jax.nn.sigmoid(ga) * (ya @ w_a_out[l]) + jax.nn.sigmoid(gb) * (yb @ w_b_out[l])
        h = h + merged @ w_out[l]
    return rms_norm(h, final_gain)
```

```cpp
#include <hip/hip_runtime.h>
#include <hip/hip_cooperative_groups.h>
#include <cstdio>
#include <cstdint>
namespace cg = cooperative_groups;

#ifndef MK_ONE_LAUNCH
#define MK_ONE_LAUNCH 0
#endif

#define LAS __attribute__((address_space(3)))
typedef unsigned short bf16_t;
typedef short bf16x8 __attribute__((ext_vector_type(8)));
typedef short s16x4 __attribute__((ext_vector_type(4)));
typedef float f32x4 __attribute__((ext_vector_type(4)));
typedef float f32x2 __attribute__((ext_vector_type(2)));
typedef float f32x16 __attribute__((ext_vector_type(16)));
typedef unsigned u32x4 __attribute__((ext_vector_type(4)));
typedef unsigned u32x2 __attribute__((ext_vector_type(2)));
typedef __bf16 bf16x2_t __attribute__((ext_vector_type(2)));

constexpr int BATCH = 4, SEQ = 8192, DM = 1024, NTOK = BATCH * SEQ;
constexpr int IN_COLS = 5832;
constexpr int PW = 5632;
constexpr int NW1 = 5888;
constexpr int C_QA = 0, C_KA = 512, C_VA = 1024, C_ZA = 1536, C_QB = 2048, C_ZB = 2560, C_QI = 3072, C_GA = 3584, C_GB = 4608;
constexpr float LOG2E = 1.4426950408889634f;
constexpr float QSC = 0.125f * LOG2E;
constexpr float IDX_SCALE = 0.04419417382415922f;
constexpr float EPS = 1e-6f;

constexpr size_t MiB = 1u << 20;
constexpr size_t WS_CTL = 0;
constexpr size_t WS_WT1 = 2 * MiB;
constexpr size_t WS_WAT = 14 * MiB;
constexpr size_t WS_WBT = 15 * MiB;
constexpr size_t WS_WOT = 16 * MiB;
constexpr size_t WS_KB = 18 * MiB;
constexpr size_t WS_VB = 22 * MiB;
constexpr size_t WS_KI = 26 * MiB;
constexpr size_t WS_WI = 30 * MiB;
constexpr size_t WS_RSS = 31 * MiB;
constexpr size_t WS_XN = 32 * MiB;
constexpr size_t WS_P = 96 * MiB;
constexpr size_t WS_END = 448 * MiB;

constexpr int NWAVES = 8;
constexpr int LDS_BYTES = 147456;

__device__ __forceinline__ unsigned cvtpk(float lo, float hi) { f32x2 v = {lo, hi}; bf16x2_t b = __builtin_convertvector(v, bf16x2_t); return __builtin_bit_cast(unsigned, b); }
__device__ __forceinline__ float bf_lo(unsigned u) { return __uint_as_float(u << 16); }
__device__ __forceinline__ float bf_hi(unsigned u) { return __uint_as_float(u & 0xffff0000u); }
__device__ __forceinline__ float bf2f(bf16_t b) { return __uint_as_float((unsigned)b << 16); }
__device__ __forceinline__ bf16_t f2bf(float f) { return (bf16_t)(cvtpk(f, 0.f) & 0xffffu); }
__device__ __forceinline__ float fast_sigmoid(float x) { return __builtin_amdgcn_rcpf(1.f + __builtin_amdgcn_exp2f(-x * LOG2E)); }
__device__ __forceinline__ float wave_sum(float v) {
#pragma unroll
    for (int o = 32; o >= 1; o >>= 1) v += __shfl_xor(v, o);
    return v;
}
__device__ __forceinline__ float wave_max(float v) {
#pragma unroll
    for (int o = 32; o >= 1; o >>= 1) v = fmaxf(v, __shfl_xor(v, o));
    return v;
}
__device__ __forceinline__ int wave_sum_i(int v) {
#pragma unroll
    for (int o = 32; o >= 1; o >>= 1) v += __shfl_xor(v, o);
    return v;
}
__device__ __forceinline__ int crow(int r, int hi) { return (r & 3) + 8 * (r >> 2) + 4 * hi; }

namespace pg8 {
constexpr int BM = 256, BK = 64, HALF = 128, HTB = HALF * BK * 2, STAGE_BYTES = 8 * HTB, NXCD = 8, WGM = 8;
__host__ __device__ __forceinline__ int lds_byte(int r, int c) { const int st = (r >> 4) * 2 + (c >> 5), rr = r & 15, cc = c & 31, ob = rr * 64 + cc * 2; return st * 1024 + (ob ^ (((ob >> 9) & 1) << 5)); }
__host__ __device__ __forceinline__ void stage_rc(int b, int& R, int& C) { const int st = b / 1024, sb = b % 1024, swz = sb ^ (((sb >> 9) & 1) << 5); R = (st >> 1) * 16 + swz / 64; C = (st & 1) * 32 + (swz % 64) / 2; }
__host__ __device__ __forceinline__ int perm32(int rho) { const int n = rho >> 4, i = rho & 15; return 8 * (i >> 2) + 4 * n + (i & 3); }

struct Unit { int pm, pn; };
struct Gemm { const bf16_t* A; const bf16_t* Bt; const bf16_t* A2; const bf16_t* Bt2; int lda, ldb, M, N, K, K1; };

struct StaticOrder {
    int nM, nN, nwg, G, c;
    __host__ __device__ void init(int M, int N, int G_, int c_) { nM = M / BM; nN = N / BM; nwg = nM * nN; G = G_; c = c_; }
    __host__ __device__ bool next(int i, Unit& u) const {
        const long L = (long)i * G + c; if (L >= nwg) return false;
        int wgid = (int)L; { const int q = nwg / NXCD, r = nwg % NXCD, xcd = wgid % NXCD, off = wgid / NXCD; wgid = (xcd < r ? xcd * (q + 1) : r * (q + 1) + (xcd - r) * q) + off; }
        const int nig = WGM * nN, gid = wgid / nig, fm = gid * WGM, gsz = (nM - fm) < WGM ? (nM - fm) : WGM;
        u.pm = fm + ((wgid % nig) % gsz); u.pn = (wgid % nig) / gsz; return true;
    }
};

template <class Epi, class Sched, bool ALIGN_EPI>
__device__ __forceinline__ void gemm_phase(LAS unsigned char* lds, const Gemm g, const Sched& S, const Epi& E) {
    const int tid = threadIdx.x, wid = __builtin_amdgcn_readfirstlane(tid >> 6), lane = tid & 63, wr = wid >> 2, wc = wid & 3, fr = lane & 15, fq = lane >> 4;
    const int nt = g.K / BK, nt1 = g.K1 / BK;
    unsigned voffA[2], voffB[2];
#pragma unroll
    for (int i = 0; i < 2; ++i) { int R, C; stage_rc(tid * 16 + i * 8192, R, C); const int Rb = Epi::PERM ? ((R & ~31) + perm32(R & 31)) : R;
        voffA[i] = (unsigned)(R * g.lda + C) * 2u; voffB[i] = (unsigned)(Rb * g.ldb + C) * 2u; }
    const size_t kstep = (size_t)(BK * 2);
    const size_t hstepA = (size_t)HALF * g.lda * 2, hstepB = (size_t)HALF * g.ldb * 2;
    const size_t tstepA = 2 * hstepA, tstepB = 2 * hstepB;
    const unsigned ldsw = (unsigned)wid * 1024u;
    const int aoff = lds_byte(wr * 64 + fr, fq * 8), boff = lds_byte(wc * 32 + fr, fq * 8);
#define PG8_SA(b, h) (((b) * 2 + (h)) * HTB)
#define PG8_SB(b, h) ((4 + (b) * 2 + (h)) * HTB)
#define PG8_STAGE(bufoff, gbase, voff) do { _Pragma("unroll") for (int _i = 0; _i < 2; ++_i) \
        __builtin_amdgcn_global_load_lds((const unsigned*)((const char*)(gbase) + (voff)[_i]), (LAS unsigned*)(lds + (bufoff) + ldsw + _i * 8192), 16, 0, 0); } while (0)
#define PG8_LDA(dst, b, h) do { _Pragma("unroll") for (int m = 0; m < 4; ++m) _Pragma("unroll") for (int k = 0; k < 2; ++k) dst[m][k] = *(const LAS bf16x8*)(lds + PG8_SA(b, h) + aoff + m * 2048 + k * 1024); } while (0)
#define PG8_LDB(dst, b, h) do { _Pragma("unroll") for (int n = 0; n < 2; ++n) _Pragma("unroll") for (int k = 0; k < 2; ++k) dst[n][k] = *(const LAS bf16x8*)(lds + PG8_SB(b, h) + boff + n * 2048 + k * 1024); } while (0)
#define PG8_MMA(ai, bj, At, Bt) do { __builtin_amdgcn_s_setprio(1); _Pragma("unroll") for (int m = 0; m < 4; ++m) _Pragma("unroll") for (int n = 0; n < 2; ++n) _Pragma("unroll") for (int k = 0; k < 2; ++k) \
        acc[ai][bj][m][n] = __builtin_amdgcn_mfma_f32_16x16x32_bf16(Bt[n][k], At[m][k], acc[ai][bj][m][n], 0, 0, 0); __builtin_amdgcn_s_setprio(0); } while (0)
#define PG8_WAIT_V(n) asm volatile("s_waitcnt vmcnt(" #n ")" ::: "memory")
#define PG8_WAIT_L(n) asm volatile("s_waitcnt lgkmcnt(" #n ")" ::: "memory")
#define PG8_BAR __builtin_amdgcn_s_barrier()
#define PG8_SCHED __builtin_amdgcn_sched_barrier(0)
#define PG8_KT(b1, b2, t) ((t) < nt1 ? (b1) + (size_t)(t) * kstep : (b2) + (size_t)((t) - nt1) * kstep)
    Unit cur, nxt; int ui = 0;
    if (!S.next(0, cur)) return;
    f32x4 acc[2][2][4][2];
#pragma unroll
    for (int a = 0; a < 2; ++a)
#pragma unroll
        for (int b = 0; b < 2; ++b)
#pragma unroll
            for (int m = 0; m < 4; ++m)
#pragma unroll
                for (int n = 0; n < 2; ++n) acc[a][b][m][n] = (f32x4){0.f, 0.f, 0.f, 0.f};
    bf16x8 At[4][2], B0[2][2], B1[2][2];
    const char* cA = (const char*)g.A + (size_t)cur.pm * tstepA; const char* cB = (const char*)g.Bt + (size_t)cur.pn * tstepB;
    const char* cA2 = (const char*)g.A2 + (size_t)cur.pm * tstepA; const char* cB2 = (const char*)g.Bt2 + (size_t)cur.pn * tstepB;
    PG8_STAGE(PG8_SB(0, 0), cB, voffB); PG8_STAGE(PG8_SB(0, 1), cB + hstepB, voffB); PG8_STAGE(PG8_SA(0, 0), cA, voffA); PG8_STAGE(PG8_SA(0, 1), cA + hstepA, voffA);
    if (wr == 1) PG8_BAR;
    PG8_WAIT_V(2); PG8_BAR;
    PG8_STAGE(PG8_SB(1, 0), cB + kstep, voffB); PG8_STAGE(PG8_SA(1, 0), cA + kstep, voffA); PG8_STAGE(PG8_SB(1, 1), cB + hstepB + kstep, voffB);
    PG8_WAIT_V(6); PG8_BAR;
    for (;;) {
        const bool has_next = S.next(ui + 1, nxt);
        const char* nA = has_next ? (const char*)g.A + (size_t)nxt.pm * tstepA : cA; const char* nB = has_next ? (const char*)g.Bt + (size_t)nxt.pn * tstepB : cB;
        for (int seg = 0; seg < 2; ++seg) {
        const int tb = seg ? nt1 : 0, te = seg ? nt : nt1;
        if (seg && tb < te) { PG8_SCHED; E.mid(acc, cur, wr, wc, fr, fq); PG8_SCHED; }
        for (int t = tb; t < te; t += 2) {
            const bool last = (t == nt - 2);
            const char* a1 = PG8_KT(cA, cA2, t + 1);
            const char* a2 = last ? nA : PG8_KT(cA, cA2, t + 2); const char* b2 = last ? nB : PG8_KT(cB, cB2, t + 2);
            const char* a3 = a2 + kstep; const char* b3 = b2 + kstep;
            PG8_LDB(B0, 0, 0); PG8_LDB(B1, 0, 1); PG8_SCHED; PG8_LDA(At, 0, 0); PG8_STAGE(PG8_SA(1, 1), a1 + hstepA, voffA);
            PG8_WAIT_V(8); PG8_WAIT_L(0); PG8_BAR; PG8_MMA(0, 0, At, B0); PG8_MMA(0, 1, At, B1); PG8_BAR; PG8_SCHED;
            PG8_LDA(At, 0, 1); PG8_STAGE(PG8_SB(0, 0), b2, voffB); PG8_STAGE(PG8_SB(0, 1), b2 + hstepB, voffB); PG8_STAGE(PG8_SA(0, 0), a2, voffA);
            PG8_WAIT_V(8); PG8_WAIT_L(0); PG8_BAR; PG8_MMA(1, 0, At, B0); PG8_MMA(1, 1, At, B1); PG8_BAR; PG8_SCHED;
            PG8_LDB(B0, 1, 0); PG8_LDB(B1, 1, 1); PG8_SCHED; PG8_LDA(At, 1, 0); PG8_STAGE(PG8_SA(0, 1), a2 + hstepA, voffA);
            PG8_WAIT_V(8); PG8_WAIT_L(0); PG8_BAR; PG8_MMA(0, 0, At, B0); PG8_MMA(0, 1, At, B1); PG8_BAR; PG8_SCHED;
            PG8_LDA(At, 1, 1); PG8_STAGE(PG8_SB(1, 0), b3, voffB); PG8_STAGE(PG8_SB(1, 1), b3 + hstepB, voffB); PG8_STAGE(PG8_SA(1, 0), a3, voffA);
            PG8_WAIT_V(8); PG8_WAIT_L(0); PG8_BAR; PG8_MMA(1, 0, At, B0); PG8_MMA(1, 1, At, B1); PG8_BAR; PG8_SCHED;
        }
        }
        if constexpr (ALIGN_EPI) { if (wr == 0) PG8_BAR; }
        E(acc, cur, wr, wc, fr, fq);
        if (!has_next) break;
#pragma unroll
        for (int a = 0; a < 2; ++a)
#pragma unroll
            for (int b = 0; b < 2; ++b)
#pragma unroll
                for (int m = 0; m < 4; ++m)
#pragma unroll
                    for (int n = 0; n < 2; ++n) acc[a][b][m][n] = (f32x4){0.f, 0.f, 0.f, 0.f};
        cur = nxt; cA = nA; cB = nB; ++ui;
        cA2 = (const char*)g.A2 + (size_t)cur.pm * tstepA; cB2 = (const char*)g.Bt2 + (size_t)cur.pn * tstepB;
        if constexpr (ALIGN_EPI) { if (wr == 1) PG8_BAR; }
    }
    PG8_WAIT_V(0);
    if constexpr (!ALIGN_EPI) { if (wr == 0) PG8_BAR; }
    PG8_BAR;
#undef PG8_SA
#undef PG8_SB
#undef PG8_STAGE
#undef PG8_LDA
#undef PG8_LDB
#undef PG8_MMA
#undef PG8_WAIT_V
#undef PG8_WAIT_L
#undef PG8_BAR
#undef PG8_SCHED
#undef PG8_KT
}
}

struct EpiProj {
    static constexpr bool PERM = true;
    bf16_t* P; bf16_t* KB; bf16_t* VB; bf16_t* KI; float* WI;
    __device__ __forceinline__ void mid(f32x4 (&)[2][2][4][2], const pg8::Unit&, int, int, int, int) const {}
    __device__ __forceinline__ void operator()(const f32x4 (&acc)[2][2][4][2], const pg8::Unit& u, int wr, int wc, int fr, int fq) const {
        const int row0 = u.pm * 256 + wr * 64 + fr;
        const int pn = u.pn;
        if (pn < 22) {
            int mode = 0; float sc = 1.f;
            if (pn < 2 || pn == 8 || pn == 9) sc = QSC;
            else if (pn == 6 || pn == 7 || pn == 10 || pn == 11) mode = 1;
            else if (pn >= 14) mode = 2;
            const int col0 = pn * 256 + wc * 32 + 8 * fq;
#pragma unroll
            for (int ai = 0; ai < 2; ++ai)
#pragma unroll
                for (int m = 0; m < 4; ++m) {
                    bf16_t* rowp = P + (size_t)(row0 + ai * 128 + m * 16) * PW + col0;
#pragma unroll
                    for (int bj = 0; bj < 2; ++bj) {
                        float v[8];
#pragma unroll
                        for (int e = 0; e < 4; ++e) { v[e] = acc[ai][bj][m][0][e]; v[4 + e] = acc[ai][bj][m][1][e]; }
                        if (mode == 0) {
#pragma unroll
                            for (int e = 0; e < 8; ++e) v[e] *= sc;
                        } else if (mode == 1) {
#pragma unroll
                            for (int e = 0; e < 8; ++e) v[e] = v[e] * fast_sigmoid(v[e]);
                        } else {
#pragma unroll
                            for (int e = 0; e < 8; ++e) v[e] = fast_sigmoid(v[e]);
                        }
                        u32x4 w; w.x = cvtpk(v[0], v[1]); w.y = cvtpk(v[2], v[3]); w.z = cvtpk(v[4], v[5]); w.w = cvtpk(v[6], v[7]);
                        *(u32x4*)(rowp + bj * 128) = w;
                    }
                }
        } else {
#pragma unroll
            for (int ai = 0; ai < 2; ++ai)
#pragma unroll
                for (int m = 0; m < 4; ++m) {
                    const size_t row = (size_t)(row0 + ai * 128 + m * 16);
                    {
                        const f32x4 a = acc[ai][0][m][0], b = acc[ai][0][m][1];
                        u32x4 w; w.x = cvtpk(a[0], a[1]); w.y = cvtpk(a[2], a[3]); w.z = cvtpk(b[0], b[1]); w.w = cvtpk(b[2], b[3]);
                        bf16_t* dst = (wc < 2) ? (KB + row * 64 + wc * 32 + 8 * fq) : (VB + row * 64 + (wc - 2) * 32 + 8 * fq);
                        *(u32x4*)dst = w;
                    }
                    {
                        const f32x4 a = acc[ai][1][m][0], b = acc[ai][1][m][1];
                        if (wc < 2) {
                            u32x4 w; w.x = cvtpk(a[0], a[1]); w.y = cvtpk(a[2], a[3]); w.z = cvtpk(b[0], b[1]); w.w = cvtpk(b[2], b[3]);
                            *(u32x4*)(KI + row * 64 + wc * 32 + 8 * fq) = w;
                        } else if (wc == 2 && fq == 0) {
                            *(f32x4*)(WI + row * 8) = a * IDX_SCALE; *(f32x4*)(WI + row * 8 + 4) = b * IDX_SCALE;
                        }
                    }
                }
        }
    }
};

typedef int i32x4 __attribute__((ext_vector_type(4)));
__device__ __forceinline__ u32x4 buf_load16(__amdgpu_buffer_rsrc_t r, unsigned voff, unsigned soff) { return __builtin_bit_cast(u32x4, __builtin_amdgcn_raw_buffer_load_b128(r, (int)voff, (int)soff, 0)); }
__device__ __forceinline__ void buf_store16(__amdgpu_buffer_rsrc_t r, unsigned voff, unsigned soff, u32x4 v) { __builtin_amdgcn_raw_buffer_store_b128(v, r, (int)voff, (int)soff, 0); }
struct EpiMerge {
    static constexpr bool PERM = true;
    const bf16_t* P; bf16_t* MG;
    __device__ __forceinline__ void mid(f32x4 (&acc)[2][2][4][2], const pg8::Unit& u, int wr, int wc, int fr, int fq) const {
        const __amdgpu_buffer_rsrc_t rp = __builtin_amdgcn_make_buffer_rsrc((void*)P, (short)0, (int)((size_t)NTOK * PW * 2), 0x00020000);
        const unsigned voff = (unsigned)(fr * PW + 8 * fq) * 2u;
#pragma unroll
        for (int ai = 0; ai < 2; ++ai)
#pragma unroll
            for (int m = 0; m < 4; ++m) {
                const unsigned soff = ((unsigned)(u.pm * 256 + wr * 64 + ai * 128 + m * 16) * (unsigned)PW + (unsigned)(u.pn * 256 + wc * 32)) * 2u;
#pragma unroll
                for (int bj = 0; bj < 2; ++bj) {
                    const u32x4 sa = buf_load16(rp, voff, soff + (C_GA + bj * 128) * 2), sb = buf_load16(rp, voff, soff + (C_GB + bj * 128) * 2);
#pragma unroll
                    for (int e = 0; e < 4; ++e) {
                        const float r0 = bf_lo(sa[e]) * __builtin_amdgcn_rcpf(bf_lo(sb[e])), r1 = bf_hi(sa[e]) * __builtin_amdgcn_rcpf(bf_hi(sb[e]));
                        acc[ai][bj][m][e >> 1][(e & 1) * 2] *= r0; acc[ai][bj][m][e >> 1][(e & 1) * 2 + 1] *= r1;
                    }
                }
                asm volatile("" ::: "memory");
            }
    }
    __device__ __forceinline__ void operator()(const f32x4 (&acc)[2][2][4][2], const pg8::Unit& u, int wr, int wc, int fr, int fq) const {
        const __amdgpu_buffer_rsrc_t rp = __builtin_amdgcn_make_buffer_rsrc((void*)P, (short)0, (int)((size_t)NTOK * PW * 2), 0x00020000);
        const __amdgpu_buffer_rsrc_t ro = __builtin_amdgcn_make_buffer_rsrc((void*)MG, (short)0, (int)((size_t)NTOK * DM * 2), 0x00020000);
        const unsigned voff = (unsigned)(fr * PW + 8 * fq) * 2u, voffo = (unsigned)(fr * DM + 8 * fq) * 2u;
#pragma unroll
        for (int ai = 0; ai < 2; ++ai)
#pragma unroll
            for (int m = 0; m < 4; ++m) {
                const unsigned rowu = (unsigned)(u.pm * 256 + wr * 64 + ai * 128 + m * 16), colu = (unsigned)(u.pn * 256 + wc * 32);
                const unsigned soff = (rowu * (unsigned)PW + colu) * 2u, soffo = (rowu * (unsigned)DM + colu) * 2u;
#pragma unroll
                for (int bj = 0; bj < 2; ++bj) {
                    const u32x4 sb = buf_load16(rp, voff, soff + (C_GB + bj * 128) * 2);
                    const f32x4 a = acc[ai][bj][m][0], b = acc[ai][bj][m][1];
                    u32x4 w;
                    w.x = cvtpk(a[0] * bf_lo(sb.x), a[1] * bf_hi(sb.x)); w.y = cvtpk(a[2] * bf_lo(sb.y), a[3] * bf_hi(sb.y));
                    w.z = cvtpk(b[0] * bf_lo(sb.z), b[1] * bf_hi(sb.z)); w.w = cvtpk(b[2] * bf_lo(sb.w), b[3] * bf_hi(sb.w));
                    buf_store16(ro, voffo, soffo + bj * 256, w);
                }
                asm volatile("" ::: "memory");
            }
    }
};

struct EpiOut {
    static constexpr bool PERM = false;
    const float* X; float* O; float* RSS;
    __device__ __forceinline__ void mid(f32x4 (&)[2][2][4][2], const pg8::Unit&, int, int, int, int) const {}
    __device__ __forceinline__ void operator()(const f32x4 (&acc)[2][2][4][2], const pg8::Unit& u, int wr, int wc, int fr, int fq) const {
        const int col0 = u.pn * 256 + wc * 32 + 4 * fq;
#pragma unroll
        for (int ai = 0; ai < 2; ++ai)
#pragma unroll
            for (int m = 0; m < 4; ++m) {
                const int row = u.pm * 256 + ai * 128 + wr * 64 + m * 16 + fr;
                const size_t off = (size_t)row * DM + col0;
                float ss = 0.f;
#pragma unroll
                for (int bj = 0; bj < 2; ++bj)
#pragma unroll
                    for (int n = 0; n < 2; ++n) {
                        const f32x4 xv = *(const f32x4*)(X + off + bj * 128 + n * 16);
                        const f32x4 hv = xv + acc[ai][bj][m][n];
                        ss += (hv[0] * hv[0] + hv[1] * hv[1]) + (hv[2] * hv[2] + hv[3] * hv[3]);
                        *(f32x4*)(O + off + bj * 128 + n * 16) = hv;
                    }
                ss += __shfl_xor(ss, 16); ss += __shfl_xor(ss, 32);
                if (fq == 0) atomicAdd(RSS + row, ss);
            }
    }
};

struct Ctx {
    LAS unsigned char* lds;
    int tid, lane, wave, G, bid;
    const float *x, *norm_gain, *w_in, *a_rel, *t5, *w_a, *w_b, *w_o, *fgain;
    float* out;
    bf16_t *WT1, *WAT, *WBT, *WOT, *KB, *VB, *KI, *XN, *P;
    float *WI, *RSS;
};

__device__ __forceinline__ int proj_src_col(int d0, int& nvalid) {
    nvalid = 32;
    if (d0 < 2560) return d0;
    if (d0 < 3072) return d0 - 2560 + 2688;
    if (d0 < 3584) return d0 - 3072 + 3200;
    if (d0 < 5632) return d0 - 3584 + 3784;
    if (d0 < 5760) return d0 - 5632 + 2560;
    if (d0 < 5824) return d0 - 5760 + 3712;
    if (d0 == 5824) { nvalid = 8; return 3776; }
    nvalid = 0; return 0;
}
__device__ __forceinline__ void transpose_item(const float* W, int ldw, int src_n0, int nvalid, const float* gain, bf16_t* WT, int K, int dst_row0, int k0, LAS float* scr, int lane) {
#pragma unroll 8
    for (int i = 0; i < 32; ++i) {
        const int kk = 2 * i + (lane >> 5), col = lane & 31;
        float v = 0.f;
        if (col < nvalid) { v = W[(size_t)(k0 + kk) * ldw + src_n0 + col]; if (gain) v *= gain[k0 + kk]; }
        scr[kk * 33 + col] = v;
    }
    asm volatile("s_waitcnt lgkmcnt(0)" ::: "memory");
    const int c = lane & 7;
#pragma unroll
    for (int j = 0; j < 4; ++j) {
        const int n = (lane >> 3) + 8 * j; const LAS float* s = scr + (8 * c) * 33 + n;
        u32x4 o; o.x = cvtpk(s[0 * 33], s[1 * 33]); o.y = cvtpk(s[2 * 33], s[3 * 33]); o.z = cvtpk(s[4 * 33], s[5 * 33]); o.w = cvtpk(s[6 * 33], s[7 * 33]);
        *(u32x4*)(WT + (size_t)(dst_row0 + n) * K + k0 + 8 * c) = o;
    }
    asm volatile("s_waitcnt lgkmcnt(0)" ::: "memory");
}
__device__ __forceinline__ void p0_prologue(Ctx& C) {
    LAS float* scr = (LAS float*)(C.lds + C.wave * 16384);
    const int gw = C.bid * NWAVES + C.wave, NGW = C.G * NWAVES;
    constexpr int I_IN = 16 * (NW1 / 32), I_A = 8 * 32, I_O = 16 * 32, NITEMS = I_IN + 2 * I_A + I_O;
    for (int it = gw; it < NITEMS; it += NGW) {
        int r = it;
        if (r < I_IN) { const int kb = r / (NW1 / 32), nb = r % (NW1 / 32); int nv; const int sc = proj_src_col(nb * 32, nv);
            transpose_item(C.w_in, IN_COLS, sc, nv, C.norm_gain, C.WT1, DM, nb * 32, kb * 64, scr, C.lane); continue; }
        r -= I_IN;
        if (r < I_A) { transpose_item(C.w_a, DM, (r % 32) * 32, 32, nullptr, C.WAT, 512, (r % 32) * 32, (r / 32) * 64, scr, C.lane); continue; }
        r -= I_A;
        if (r < I_A) { transpose_item(C.w_b, DM, (r % 32) * 32, 32, nullptr, C.WBT, 512, (r % 32) * 32, (r / 32) * 64, scr, C.lane); continue; }
        r -= I_A;
        transpose_item(C.w_o, DM, (r % 32) * 32, 32, nullptr, C.WOT, DM, (r % 32) * 32, (r / 32) * 64, scr, C.lane);
    }
    for (int m = gw; m < NTOK; m += NGW) {
        const f32x4* xr = (const f32x4*)(C.x + (size_t)m * DM) + C.lane;
        f32x4 v[4]; float s = 0.f;
#pragma unroll
        for (int j = 0; j < 4; ++j) { v[j] = xr[64 * j]; s += (v[j].x * v[j].x + v[j].y * v[j].y) + (v[j].z * v[j].z + v[j].w * v[j].w); }
        const float rstd = __builtin_amdgcn_rsqf(wave_sum(s) * (1.f / DM) + EPS);
        u32x2* o8 = (u32x2*)(C.XN + (size_t)m * DM) + C.lane;
#pragma unroll
        for (int j = 0; j < 4; ++j) { u32x2 w; w.x = cvtpk(v[j].x * rstd, v[j].y * rstd); w.y = cvtpk(v[j].z * rstd, v[j].w * rstd); o8[64 * j] = w; }
    }
    for (int i = C.bid * 512 + C.tid; i < NTOK; i += C.G * 512) C.RSS[i] = 0.f;
}

constexpr int A_WAVE_LDS = 1280 + 4096 + 9216;
__device__ __forceinline__ s16x4 tr_read(LAS unsigned char* p) { return __builtin_bit_cast(s16x4, __builtin_amdgcn_ds_read_tr16_b64_v4i16((LAS s16x4*)p)); }
__device__ __forceinline__ void mixerA_unit(Ctx& C, int b, int c) {
    const int lane = C.lane, h = C.wave, r32 = lane & 31, hi = lane >> 5;
    LAS unsigned char* wl = C.lds + h * A_WAVE_LDS;
    LAS float* btab = (LAS float*)wl;
    LAS unsigned char* vimg = wl + 1280;
    LAS bf16_t* ost = (LAS bf16_t*)(wl + 1280 + 4096);
    for (int i = lane; i < 320; i += 64) btab[i] = C.a_rel[h * 513 + i + 193] * LOG2E;
    const size_t tok0 = (size_t)b * SEQ + (size_t)c * 64;
    const bf16_t* Qp = C.P + tok0 * PW + C_QA + h * 64;
    bf16x8 qf[2][4];
#pragma unroll
    for (int qg = 0; qg < 2; ++qg)
#pragma unroll
        for (int ks = 0; ks < 4; ++ks) qf[qg][ks] = *(const bf16x8*)(Qp + (size_t)(32 * qg + r32) * PW + 16 * ks + 8 * hi);
    f32x16 o[2][2];
#pragma unroll
    for (int a = 0; a < 2; ++a)
#pragma unroll
        for (int q = 0; q < 2; ++q)
#pragma unroll
            for (int i = 0; i < 16; ++i) o[a][q][i] = 0.f;
    float mrun[2] = {-1e30f, -1e30f}, lrun[2] = {0.f, 0.f};
    const int t0 = c < 8 ? (8 - c) * 2 : 0;
    const long kbase = (long)b * SEQ + (long)(c - 8) * 64;
    const int i16 = lane & 15, qq = i16 >> 2, pp = i16 & 3, blk = (lane >> 4) & 1;
    asm volatile("s_waitcnt lgkmcnt(0)" ::: "memory");
    for (int t = t0; t < 18; ++t) {
        const int j0 = t * 32;
        const bf16_t* Kp = C.P + (size_t)(kbase + j0 + r32) * PW + C_KA + h * 64 + 8 * hi;
        bf16x8 kf[4];
#pragma unroll
        for (int ks = 0; ks < 4; ++ks) kf[ks] = *(const bf16x8*)(Kp + 16 * ks);
#pragma unroll
        for (int r = 0; r < 4; ++r) {
            const int pc = lane + 64 * r, key = pc >> 3, ch = pc & 7;
            const u32x4 v = *(const u32x4*)(C.P + (size_t)(kbase + j0 + key) * PW + C_VA + h * 64 + ch * 8);
            *(LAS u32x4*)(vimg + (ch >> 2) * 2048 + key * 64 + (ch & 3) * 16) = v;
        }
        f32x16 s[2];
#pragma unroll
        for (int qg = 0; qg < 2; ++qg) {
#pragma unroll
            for (int i = 0; i < 16; ++i) s[qg][i] = 0.f;
#pragma unroll
            for (int ks = 0; ks < 4; ++ks) s[qg] = __builtin_amdgcn_mfma_f32_32x32x16_bf16(kf[ks], qf[qg][ks], s[qg], 0, 0, 0);
        }
        bf16x8 pk[2][2];
#pragma unroll
        for (int qg = 0; qg < 2; ++qg) {
            const int q = 32 * qg + r32;
            float tmax = -1e30f;
#pragma unroll
            for (int i = 0; i < 16; ++i) {
                const int j = j0 + crow(i, hi); const int rel = 512 + q - j; const int bi = (rel < 256 ? rel : 256) + 63;
                s[qg][i] += btab[bi]; tmax = fmaxf(tmax, s[qg][i]);
            }
            tmax = fmaxf(tmax, __shfl_xor(tmax, 32));
            const float mn = fmaxf(mrun[qg], tmax), alpha = __builtin_amdgcn_exp2f(mrun[qg] - mn); mrun[qg] = mn;
            float ps = 0.f;
#pragma unroll
            for (int i = 0; i < 16; ++i) { const float p = __builtin_amdgcn_exp2f(s[qg][i] - mn); s[qg][i] = p; ps += p; }
            lrun[qg] = lrun[qg] * alpha + ps;
#pragma unroll
            for (int dt = 0; dt < 2; ++dt)
#pragma unroll
                for (int i = 0; i < 16; ++i) o[dt][qg][i] *= alpha;
#pragma unroll
            for (int st = 0; st < 2; ++st) {
                u32x4 w; w.x = cvtpk(s[qg][8 * st + 0], s[qg][8 * st + 1]); w.y = cvtpk(s[qg][8 * st + 2], s[qg][8 * st + 3]);
                w.z = cvtpk(s[qg][8 * st + 4], s[qg][8 * st + 5]); w.w = cvtpk(s[qg][8 * st + 6], s[qg][8 * st + 7]);
                pk[qg][st] = __builtin_bit_cast(bf16x8, w);
            }
        }
        asm volatile("s_waitcnt lgkmcnt(0)" ::: "memory");
#pragma unroll
        for (int dt = 0; dt < 2; ++dt)
#pragma unroll
            for (int st = 0; st < 2; ++st) {
                LAS unsigned char* pb = vimg + dt * 2048 + (16 * st + 4 * hi + qq) * 64 + (16 * blk + 4 * pp) * 2;
                const s16x4 lo = tr_read(pb), hi4 = tr_read(pb + 8 * 64);
                const bf16x8 vf = __builtin_shufflevector(lo, hi4, 0, 1, 2, 3, 4, 5, 6, 7);
#pragma unroll
                for (int qg = 0; qg < 2; ++qg) o[dt][qg] = __builtin_amdgcn_mfma_f32_32x32x16_bf16(vf, pk[qg][st], o[dt][qg], 0, 0, 0);
            }
        asm volatile("s_waitcnt lgkmcnt(0)" ::: "memory");
    }
#pragma unroll
    for (int qg = 0; qg < 2; ++qg) {
        const float lt = lrun[qg] + __shfl_xor(lrun[qg], 32); const float inv = __builtin_amdgcn_rcpf(lt);
#pragma unroll
        for (int dt = 0; dt < 2; ++dt)
#pragma unroll
            for (int i = 0; i < 16; ++i) ost[(32 * qg + r32) * 72 + 32 * dt + crow(i, hi)] = f2bf(o[dt][qg][i] * inv);
    }
    asm volatile("s_waitcnt lgkmcnt(0)" ::: "memory");
#pragma unroll
    for (int r = 0; r < 8; ++r) {
        const int row = (lane >> 3) + 8 * r, ch = lane & 7;
        const u32x4 ov = *(const LAS u32x4*)(ost + row * 72 + ch * 8);
        bf16_t* gp = C.P + (tok0 + row) * PW + h * 64 + ch * 8;
        const u32x4 zv = *(const u32x4*)(gp + C_ZA);
        u32x4 w;
#pragma unroll
        for (int e = 0; e < 4; ++e) w[e] = cvtpk(bf_lo(ov[e]) * bf_lo(zv[e]), bf_hi(ov[e]) * bf_hi(zv[e]));
        *(u32x4*)(gp + C_QA) = w;
    }
    asm volatile("s_waitcnt lgkmcnt(0)" ::: "memory");
}

constexpr int BS_T5 = 1024;
constexpr int BS_WAVE_LDS = 32768 + 1024 + 1024 + 512 + 512;
__device__ __forceinline__ float dot2bf(unsigned a, unsigned b, float c) { return __builtin_amdgcn_fdot2_f32_bf16(__builtin_bit_cast(bf16x2_t, a), __builtin_bit_cast(bf16x2_t, b), c, false); }
__device__ __forceinline__ int t5_bucket(int rel) {
    const int n = rel < 0 ? -rel : rel;
    int bkt = n < 8 ? n : 8 + (n >= 12) + (n >= 16) + (n >= 23) + (n >= 32) + (n >= 46) + (n >= 64) + (n >= 91);
    return bkt + (rel > 0 ? 16 : 0);
}
__device__ __forceinline__ void mixerB_simple_group(Ctx& C, int g) {
    if (C.wave >= 4) return;
    const int lane = C.lane, w = C.wave;
    LAS float* t5L = (LAS float*)C.lds;
    LAS unsigned char* wl = C.lds + BS_T5 + w * BS_WAVE_LDS;
    LAS unsigned* list = (LAS unsigned*)wl;
    LAS unsigned* qiL = (LAS unsigned*)(wl + 32768);
    LAS unsigned* qbL = qiL + 256;
    LAS unsigned short* selL = (LAS unsigned short*)(qbL + 256);
    LAS float* wiL = (LAS float*)(wl + 32768 + 1024 + 1024 + 512);
    const int tok = g * 4 + w; const int b = tok >> 13, pos = tok & 8191, c = pos >> 6, n = (c + 1) * 64, ntile = c + 1;
    {
        const u32x4 v = *(const u32x4*)(C.P + (size_t)tok * PW + C_QI + lane * 8); *(LAS u32x4*)(qiL + lane * 4) = v;
        const u32x4 v2 = *(const u32x4*)(C.P + (size_t)tok * PW + C_QB + lane * 8); *(LAS u32x4*)(qbL + lane * 4) = v2;
        if (lane < 8) wiL[lane] = C.WI[(size_t)tok * 8 + lane];
    }
    asm volatile("s_waitcnt lgkmcnt(0)" ::: "memory");
    const bf16_t* KIb = C.KI + (size_t)b * SEQ * 64;
#pragma unroll 1
    for (int t = 0; t < ntile; ++t) {
        const int key = t * 64 + lane;
        unsigned kr[32];
#pragma unroll
        for (int j = 0; j < 8; ++j) { const u32x4 v = *(const u32x4*)(KIb + (size_t)key * 64 + j * 8); kr[4 * j] = v.x; kr[4 * j + 1] = v.y; kr[4 * j + 2] = v.z; kr[4 * j + 3] = v.w; }
        float sc = 0.f;
#pragma unroll 1
        for (int h = 0; h < 8; ++h) {
            float d = 0.f;
#pragma unroll
            for (int j = 0; j < 8; ++j) { const u32x4 qv = *(const LAS u32x4*)(qiL + h * 32 + 4 * j);
                d = dot2bf(kr[4 * j], qv.x, d); d = dot2bf(kr[4 * j + 1], qv.y, d); d = dot2bf(kr[4 * j + 2], qv.z, d); d = dot2bf(kr[4 * j + 3], qv.w, d); }
            sc += wiL[h] * fmaxf(d, 0.f);
        }
        unsigned u = __float_as_uint(sc); u = (u & 0x80000000u) ? ~u : (u | 0x80000000u);
        list[key] = (u & 0xFFFFE000u) | (unsigned)(8191 - key);
    }
    asm volatile("s_waitcnt lgkmcnt(0)" ::: "memory");
    unsigned T = 0u;
    if (n > 256) {
#pragma unroll 1
        for (int bit = 31; bit >= 0; --bit) {
            const unsigned cand = T | (1u << bit);
            int cnt = 0;
#pragma unroll 4
            for (int t = 0; t < ntile; ++t) cnt += (list[t * 64 + lane] >= cand) ? 1 : 0;
            cnt = wave_sum_i(cnt);
            if (cnt >= 256) T = cand;
        }
    }
    int nsel = 0;
#pragma unroll 1
    for (int t = 0; t < ntile; ++t) {
        const unsigned v = list[t * 64 + lane]; const bool s = v >= T;
        const unsigned long long mk = __ballot(s);
        const int pre = __builtin_amdgcn_mbcnt_hi((unsigned)(mk >> 32), __builtin_amdgcn_mbcnt_lo((unsigned)mk, 0u));
        if (s) selL[nsel + pre] = (unsigned short)(t * 64 + lane);
        nsel += __popcll(mk);
    }
    asm volatile("s_waitcnt lgkmcnt(0)" ::: "memory");
    LAS float* PL = (LAS float*)list;
    const bf16_t* KBb = C.KB + (size_t)b * SEQ * 64;
#pragma unroll 1
    for (int r = 0; r < 4; ++r) {
        const int j = r * 64 + lane; const bool valid = j < nsel; const int key = valid ? (int)selL[j] : 0;
        unsigned kr[32];
#pragma unroll
        for (int jj = 0; jj < 8; ++jj) { const u32x4 v = *(const u32x4*)(KBb + (size_t)key * 64 + jj * 8); kr[4 * jj] = v.x; kr[4 * jj + 1] = v.y; kr[4 * jj + 2] = v.z; kr[4 * jj + 3] = v.w; }
        const int bk = t5_bucket(key - pos);
#pragma unroll 1
        for (int h = 0; h < 8; ++h) {
            float d = 0.f;
#pragma unroll
            for (int jj = 0; jj < 8; ++jj) { const u32x4 qv = *(const LAS u32x4*)(qbL + h * 32 + 4 * jj);
                d = dot2bf(kr[4 * jj], qv.x, d); d = dot2bf(kr[4 * jj + 1], qv.y, d); d = dot2bf(kr[4 * jj + 2], qv.z, d); d = dot2bf(kr[4 * jj + 3], qv.w, d); }
            PL[j * 8 + h] = valid ? d + t5L[bk * 8 + h] : -1e30f;
        }
    }
    asm volatile("s_waitcnt lgkmcnt(0)" ::: "memory");
#pragma unroll 1
    for (int h = 0; h < 8; ++h) {
        float v0 = PL[lane * 8 + h], v1 = PL[(64 + lane) * 8 + h], v2 = PL[(128 + lane) * 8 + h], v3 = PL[(192 + lane) * 8 + h];
        const float mx = wave_max(fmaxf(fmaxf(v0, v1), fmaxf(v2, v3)));
        v0 = __builtin_amdgcn_exp2f(v0 - mx); v1 = __builtin_amdgcn_exp2f(v1 - mx); v2 = __builtin_amdgcn_exp2f(v2 - mx); v3 = __builtin_amdgcn_exp2f(v3 - mx);
        const float inv = 1.f / wave_sum((v0 + v1) + (v2 + v3));
        PL[lane * 8 + h] = v0 * inv; PL[(64 + lane) * 8 + h] = v1 * inv; PL[(128 + lane) * 8 + h] = v2 * inv; PL[(192 + lane) * 8 + h] = v3 * inv;
    }
    asm volatile("s_waitcnt lgkmcnt(0)" ::: "memory");
    float acc[8];
#pragma unroll
    for (int h = 0; h < 8; ++h) acc[h] = 0.f;
    const bf16_t* VBb = C.VB + (size_t)b * SEQ * 64;
#pragma unroll 4
    for (int j = 0; j < nsel; ++j) {
        const int key = selL[j]; const float v = bf2f(VBb[(size_t)key * 64 + lane]);
        const f32x4 p0 = *(const LAS f32x4*)(PL + j * 8), p1 = *(const LAS f32x4*)(PL + j * 8 + 4);
        acc[0] += p0.x * v; acc[1] += p0.y * v; acc[2] += p0.z * v; acc[3] += p0.w * v;
        acc[4] += p1.x * v; acc[5] += p1.y * v; acc[6] += p1.z * v; acc[7] += p1.w * v;
    }
#pragma unroll
    for (int h = 0; h < 8; ++h) {
        bf16_t* gp = C.P + (size_t)tok * PW + h * 64 + lane;
        const float z = bf2f(gp[C_ZB]);
        gp[C_QB] = f2bf(acc[h] * z);
    }
    asm volatile("s_waitcnt lgkmcnt(0)" ::: "memory");
}

struct Args { const float* in[9]; float* out; unsigned char* ws; int ph_lo, ph_hi; };
__global__ void __launch_bounds__(NWAVES * 64, 2) fwd_kernel(Args args) {
    extern __shared__ __attribute__((aligned(16))) unsigned char lds_raw[];
    Ctx C;
    C.lds = (LAS unsigned char*)lds_raw;
    C.tid = threadIdx.x; C.lane = C.tid & 63; C.wave = __builtin_amdgcn_readfirstlane(C.tid >> 6);
    C.G = gridDim.x; C.bid = blockIdx.x;
    C.x = args.in[0]; C.norm_gain = args.in[1]; C.w_in = args.in[2]; C.a_rel = args.in[3]; C.t5 = args.in[4];
    C.w_a = args.in[5]; C.w_b = args.in[6]; C.w_o = args.in[7]; C.fgain = args.in[8]; C.out = args.out;
    unsigned char* ws = args.ws;
    C.WT1 = (bf16_t*)(ws + WS_WT1); C.WAT = (bf16_t*)(ws + WS_WAT); C.WBT = (bf16_t*)(ws + WS_WBT); C.WOT = (bf16_t*)(ws + WS_WOT);
    C.KB = (bf16_t*)(ws + WS_KB); C.VB = (bf16_t*)(ws + WS_VB); C.KI = (bf16_t*)(ws + WS_KI); C.XN = (bf16_t*)(ws + WS_XN); C.P = (bf16_t*)(ws + WS_P);
    C.WI = (float*)(ws + WS_WI); C.RSS = (float*)(ws + WS_RSS);
    const int lo = args.ph_lo, hi = args.ph_hi;
#if MK_ONE_LAUNCH
    cg::grid_group grid = cg::this_grid();
#define GRID_SYNC() grid.sync()
#else
#define GRID_SYNC() do {} while (0)
#endif
#ifndef PH_ENABLE
#define PH_ENABLE 63
#endif
#define IN(k) (((PH_ENABLE >> (k)) & 1) && lo <= (k) && (k) < hi)
#define BOTH(k) (IN(k) && IN((k) + 1))

    if (IN(0)) { p0_prologue(C); if (BOTH(0)) GRID_SYNC(); }

    if (IN(1)) {
        pg8::Gemm g{C.XN, C.WT1, C.XN, C.WT1, DM, DM, NTOK, NW1, DM, DM};
        pg8::StaticOrder S; S.init(NTOK, NW1, C.G, C.bid);
        EpiProj E{C.P, C.KB, C.VB, C.KI, C.WI};
        pg8::gemm_phase<EpiProj, pg8::StaticOrder, true>(C.lds, g, S, E);
        if (BOTH(1)) GRID_SYNC();
    }

    if (IN(2)) {
#ifndef NO_A
        for (int u = C.bid; u < BATCH * 128; u += C.G) mixerA_unit(C, u >> 7, u & 127);
#endif
        __syncthreads();
        for (int i = C.tid; i < 256; i += NWAVES * 64) ((LAS float*)C.lds)[i] = C.t5[i] * LOG2E;
        __syncthreads();
#ifndef NO_B
        for (int g = C.bid; g < NTOK / 4; g += C.G) mixerB_simple_group(C, g);
#endif
        __syncthreads();
        if (BOTH(2)) GRID_SYNC();
    }

    if (IN(3)) {
        pg8::Gemm g{C.P + C_QA, C.WAT, C.P + C_QB, C.WBT, PW, 512, NTOK, DM, 1024, 512};
        pg8::StaticOrder S; S.init(NTOK, DM, C.G, C.bid);
        EpiMerge E{C.P, C.XN};
        pg8::gemm_phase<EpiMerge, pg8::StaticOrder, true>(C.lds, g, S, E);
        if (BOTH(3)) GRID_SYNC();
    }

    if (IN(4)) {
        pg8::Gemm g{C.XN, C.WOT, C.XN, C.WOT, DM, DM, NTOK, DM, DM, DM};
        pg8::StaticOrder S; S.init(NTOK, DM, C.G, C.bid);
        EpiOut E{C.x, C.out, C.RSS};
        pg8::gemm_phase<EpiOut, pg8::StaticOrder, true>(C.lds, g, S, E);
        if (BOTH(4)) GRID_SYNC();
    }

    if (IN(5)) {
        const int gw = C.bid * NWAVES + C.wave, NGW = C.G * NWAVES;
        for (int m = gw; m < NTOK; m += NGW) {
            f32x4* orow = (f32x4*)(C.out + (size_t)m * DM) + C.lane;
            const f32x4* gr = (const f32x4*)C.fgain + C.lane;
            const float rs = __builtin_amdgcn_rsqf(C.RSS[m] * (1.f / DM) + EPS);
#pragma unroll
            for (int j = 0; j < 4; ++j) { f32x4 v = orow[64 * j]; const f32x4 gg = gr[64 * j]; v = v * rs * gg; orow[64 * j] = v; }
        }
    }
#undef IN
#undef BOTH
}

extern "C" void kernel_launch(void* const* d_in, const int* in_sizes, int n_in, void* d_out, int out_size, void* d_ws, size_t ws_size, hipStream_t stream) {
    static int grid = 0;
    if (grid == 0) {
        if (n_in != 9 || in_sizes[0] != NTOK * DM || out_size != NTOK * DM || ws_size < WS_END) {
            fprintf(stderr, "kernel_launch: unexpected shapes (n_in %d, in0 %d, out %d, ws %zu)\n", n_in, n_in > 0 ? in_sizes[0] : -1, out_size, ws_size); grid = -1; return; }
        int dev = 0, cus = 0, per_cu = 0;
        if (hipGetDevice(&dev) != hipSuccess || hipDeviceGetAttribute(&cus, hipDeviceAttributeMultiprocessorCount, dev) != hipSuccess) { grid = -1; return; }
        if (hipFuncSetAttribute((const void*)fwd_kernel, hipFuncAttributeMaxDynamicSharedMemorySize, LDS_BYTES) != hipSuccess) { fprintf(stderr, "kernel_launch: hipFuncSetAttribute failed\n"); grid = -1; return; }
        if (hipOccupancyMaxActiveBlocksPerMultiprocessor(&per_cu, (const void*)fwd_kernel, NWAVES * 64, LDS_BYTES) != hipSuccess || per_cu < 1) { fprintf(stderr, "kernel_launch: occupancy query gives %d\n", per_cu); per_cu = 1; }
        (void)hipGetLastError();
        grid = cus;
    }
    if (grid < 0) return;
    Args a{};
    for (int i = 0; i < 9; ++i) a.in[i] = (const float*)d_in[i];
    a.out = (float*)d_out; a.ws = (unsigned char*)d_ws;
#if MK_ONE_LAUNCH
    a.ph_lo = 0; a.ph_hi = 6;
    void* kargs[] = {&a};
    hipError_t e = hipLaunchCooperativeKernel((const void*)fwd_kernel, dim3(grid), dim3(NWAVES * 64), kargs, LDS_BYTES, stream);
    if (e != hipSuccess) fprintf(stderr, "cooperative launch failed: %s (grid %d)\n", hipGetErrorString(e), grid);
#else
    for (int ph = 0; ph < 6; ++ph) {
        a.ph_lo = ph; a.ph_hi = ph + 1;
        hipLaunchKernelGGL(fwd_kernel, dim3(grid), dim3(NWAVES * 64), LDS_BYTES, stream, a);
    }
#endif
}
```

```cpp
#include <hip/hip_runtime.h>
#include <cstdio>
#include <cstdint>

#ifndef MK_ONE_LAUNCH
#define MK_ONE_LAUNCH 1
#endif


#define LAS __attribute__((address_space(3)))
typedef unsigned short bf16_t;
typedef short bf16x8 __attribute__((ext_vector_type(8)));
typedef short s16x4 __attribute__((ext_vector_type(4)));
typedef float f32x4 __attribute__((ext_vector_type(4)));
typedef float f32x2 __attribute__((ext_vector_type(2)));
typedef int i32x4 __attribute__((ext_vector_type(4)));
typedef int i32x2 __attribute__((ext_vector_type(2)));
typedef float f32x16 __attribute__((ext_vector_type(16)));
typedef unsigned u32x4 __attribute__((ext_vector_type(4)));
typedef unsigned u32x2 __attribute__((ext_vector_type(2)));
typedef __bf16 bf16x2_t __attribute__((ext_vector_type(2)));

constexpr int BATCH = 4, SEQ = 8192, DM = 1024, NTOK = BATCH * SEQ;
constexpr int IN_COLS = 5832;
constexpr int PW = 5632;
constexpr int NW1 = 5888;
constexpr int C_QA = 0, C_KA = 512, C_VA = 1024, C_ZA = 1536, C_QB = 2048, C_ZB = 2560, C_QI = 3072, C_GA = 3584, C_GB = 4608;
constexpr float LOG2E = 1.4426950408889634f;
constexpr float QSC = 0.125f * LOG2E;
constexpr float IDX_SCALE = 0.04419417382415922f;
constexpr float EPS = 1e-6f;

constexpr size_t MiB = 1u << 20;
constexpr size_t WS_CTL = 0;
constexpr size_t WS_WT1 = 2 * MiB;
constexpr size_t WS_WT18 = 4 * MiB;
constexpr size_t WS_WAT = 14 * MiB;
constexpr size_t WS_WBT = 15 * MiB;
constexpr size_t WS_WOT = 16 * MiB;
constexpr size_t WS_KB = 18 * MiB;
constexpr size_t WS_VB = 22 * MiB;
constexpr size_t WS_KI = 26 * MiB;
constexpr size_t WS_WI = 30 * MiB;
constexpr size_t WS_RSS = 31 * MiB;
constexpr size_t WS_RSX = 31 * MiB + 512 * 1024;
constexpr size_t WS_XN = 32 * MiB;
constexpr size_t WS_P = 96 * MiB;
constexpr size_t WS_Y8 = 448 * MiB;
constexpr size_t WS_XN8 = 480 * MiB;
constexpr size_t WS_END = 512 * MiB;

constexpr int NWAVES = 8;
constexpr int LDS_BYTES = 163840;

__device__ __forceinline__ unsigned cvtpk(float lo, float hi) { f32x2 v = {lo, hi}; bf16x2_t b = __builtin_convertvector(v, bf16x2_t); return __builtin_bit_cast(unsigned, b); }
__device__ __forceinline__ float bf_lo(unsigned u) { return __uint_as_float(u << 16); }
__device__ __forceinline__ float bf_hi(unsigned u) { return __uint_as_float(u & 0xffff0000u); }
__device__ __forceinline__ float bf2f(bf16_t b) { return __uint_as_float((unsigned)b << 16); }
__device__ __forceinline__ bf16_t f2bf(float f) { return (bf16_t)(cvtpk(f, 0.f) & 0xffffu); }
__device__ __forceinline__ float fast_sigmoid(float x) { return __builtin_amdgcn_rcpf(1.f + __builtin_amdgcn_exp2f(-x * LOG2E)); }
typedef int i32x8 __attribute__((ext_vector_type(8)));
typedef unsigned char fp8_t;
constexpr float Y8_SCALE = 64.f, W8_SCALE = 32.f;
constexpr float ACC8_UNSCALE = 1.f / (64.f * 32.f);
__device__ __forceinline__ unsigned pk4_fp8_raw(float a, float b, float c, float d) { int p = __builtin_amdgcn_cvt_pk_fp8_f32(a, b, 0, false); p = __builtin_amdgcn_cvt_pk_fp8_f32(c, d, p, true); return (unsigned)p; }
__device__ __forceinline__ float sat8(float x) { return __builtin_amdgcn_fmed3f(x, -448.f, 448.f); }
__device__ __forceinline__ unsigned pk4_fp8(float a, float b, float c, float d) { return pk4_fp8_raw(sat8(a), sat8(b), sat8(c), sat8(d)); }
__device__ __forceinline__ float wave_sum(float v) {
#pragma unroll
    for (int o = 32; o >= 1; o >>= 1) v += __shfl_xor(v, o);
    return v;
}
__device__ __forceinline__ float wave_max(float v) {
#pragma unroll
    for (int o = 32; o >= 1; o >>= 1) v = fmaxf(v, __shfl_xor(v, o));
    return v;
}
__device__ __forceinline__ int wave_sum_i(int v) {
#pragma unroll
    for (int o = 32; o >= 1; o >>= 1) v += __shfl_xor(v, o);
    return v;
}
__device__ __forceinline__ float xmax16(float m) { auto r = __builtin_amdgcn_permlane16_swap(__float_as_uint(m), __float_as_uint(m), false, false); return fmaxf(__uint_as_float(r[0]), __uint_as_float(r[1])); }
__device__ __forceinline__ float xmax32(float m) { auto r = __builtin_amdgcn_permlane32_swap(__float_as_uint(m), __float_as_uint(m), false, false); return fmaxf(__uint_as_float(r[0]), __uint_as_float(r[1])); }
__device__ __forceinline__ float xsum16(float m) { auto r = __builtin_amdgcn_permlane16_swap(__float_as_uint(m), __float_as_uint(m), false, false); return __uint_as_float(r[0]) + __uint_as_float(r[1]); }
__device__ __forceinline__ float xsum32(float m) { auto r = __builtin_amdgcn_permlane32_swap(__float_as_uint(m), __float_as_uint(m), false, false); return __uint_as_float(r[0]) + __uint_as_float(r[1]); }
template <int CTRL, int ROWMASK> __device__ __forceinline__ unsigned dpp_u(unsigned old, unsigned src) { return (unsigned)__builtin_amdgcn_update_dpp((int)old, (int)src, CTRL, ROWMASK, 0xf, false); }
__device__ __forceinline__ int crow(int r, int hi) { return (r & 3) + 8 * (r >> 2) + 4 * hi; }

namespace pg8 {
constexpr int BM = 256, BK = 64, HALF = 128, HTB = HALF * BK * 2, STAGE_BYTES = 8 * HTB, NXCD = 8, WGM = 8;
__host__ __device__ __forceinline__ int lds_byte(int r, int c) { const int st = (r >> 4) * 2 + (c >> 5), rr = r & 15, cc = c & 31, ob = rr * 64 + cc * 2; return st * 1024 + (ob ^ (((ob >> 9) & 1) << 5)); }
__host__ __device__ __forceinline__ void stage_rc(int b, int& R, int& C) { const int st = b / 1024, sb = b % 1024, swz = sb ^ (((sb >> 9) & 1) << 5); R = (st >> 1) * 16 + swz / 64; C = (st & 1) * 32 + (swz % 64) / 2; }
__host__ __device__ __forceinline__ int perm32(int rho) { const int n = rho >> 4, i = rho & 15; return 8 * (i >> 2) + 4 * n + (i & 3); }

struct Unit { int pm, pn; };
struct Gemm { const void* A; const void* Bt; const void* A2; const void* Bt2; int lda, ldb, M, N, K, K1; };

struct StaticOrder {
    int nM, nN, nwg, G, c;
    __host__ __device__ void init(int M, int N, int G_, int c_) { nM = M / BM; nN = N / BM; nwg = nM * nN; G = G_; c = c_; }
    __host__ __device__ bool next(int i, Unit& u) const { const long L = (long)i * G + c; if (L >= nwg) return false; map((int)L, u); return true; }
    __host__ __device__ void map(int L, Unit& u) const {
        int wgid = L; { const int q = nwg / NXCD, r = nwg % NXCD, xcd = wgid % NXCD, off = wgid / NXCD; wgid = (xcd < r ? xcd * (q + 1) : r * (q + 1) + (xcd - r) * q) + off; }
        const int nig = WGM * nN, gid = wgid / nig, fm = gid * WGM, gsz = (nM - fm) < WGM ? (nM - fm) : WGM;
        u.pm = fm + ((wgid % nig) % gsz); u.pn = (wgid % nig) / gsz;
    }
};
struct SplitOrder {
    StaticOrder so;
    __host__ __device__ void init(int M, int N, int G_, int c_) { so.init(M, N, G_, c_); }
    __host__ __device__ bool next(int i, Unit& u) const {
        if (so.G != 256 || so.nwg != 2560) return so.next(i, u);
        int L;
        if (i < 9) L = i * 256 + so.c;
        else if (so.c >= 128 && i < 11) L = 2304 + (i - 9) * 128 + (so.c - 128);
        else return false;
        so.map(L, u); return true;
    }
};

template <class Epi, class Sched, bool ALIGN_EPI, bool FP8 = false>
__device__ __forceinline__ void gemm_phase(LAS unsigned char* lds, const Gemm g, const Sched& S, const Epi& E) {
    const int tid = threadIdx.x, wid = __builtin_amdgcn_readfirstlane(tid >> 6), lane = tid & 63, wr = wid >> 2, wc = wid & 3, fr = lane & 15, fq = lane >> 4;
    const int nt = g.K / (2 * BK), nt1 = g.K1 / (2 * BK);
    unsigned voffA[2], voffB[2];
#pragma unroll
    for (int i = 0; i < 2; ++i) { int R, C; stage_rc(tid * 16 + i * 8192, R, C); const int Rb = Epi::PERM ? ((R & ~31) + perm32(R & 31)) : R;
        voffA[i] = (unsigned)(R * g.lda + 2 * C); voffB[i] = (unsigned)(Rb * g.ldb + 2 * C); }
    const size_t kstep = (size_t)(BK * 2);
    const size_t hstepA = (size_t)HALF * g.lda, hstepB = (size_t)HALF * g.ldb;
    const size_t tstepA = 2 * hstepA, tstepB = 2 * hstepB;
    const unsigned ldsw = (unsigned)wid * 1024u;
    const int aoff = lds_byte(wr * 64 + fr, fq * 8), boff = lds_byte(wc * 32 + fr, fq * 8);
#define PG8_SA(b, h) (((b) * 2 + (h)) * HTB)
#define PG8_SB(b, h) ((4 + (b) * 2 + (h)) * HTB)
#define PG8_STAGE(bufoff, gbase, voff) do { _Pragma("unroll") for (int _i = 0; _i < 2; ++_i) \
        __builtin_amdgcn_global_load_lds((const unsigned*)((const char*)(gbase) + (voff)[_i]), (LAS unsigned*)(lds + (bufoff) + ldsw + _i * 8192), 16, 0, 0); } while (0)
#define PG8_LD8(addr_) __builtin_shufflevector(*(const LAS i32x4*)(addr_), *(const LAS i32x4*)((addr_) + 1024), 0, 1, 2, 3, 4, 5, 6, 7)
#define PG8_LDA(dst, b, h) do { _Pragma("unroll") for (int m = 0; m < 4; ++m) dst[m] = PG8_LD8(lds + PG8_SA(b, h) + aoff + m * 2048); } while (0)
#define PG8_LDB(dst, b, h) do { _Pragma("unroll") for (int n = 0; n < 2; ++n) dst[n] = PG8_LD8(lds + PG8_SB(b, h) + boff + n * 2048); } while (0)
#define PG8_LO(x_) __builtin_bit_cast(bf16x8, __builtin_shufflevector((x_), (x_), 0, 1, 2, 3))
#define PG8_HI(x_) __builtin_bit_cast(bf16x8, __builtin_shufflevector((x_), (x_), 4, 5, 6, 7))
#define PG8_MMA(ai, bj, At, Bt) do { __builtin_amdgcn_s_setprio(1); \
        if constexpr (FP8) { asm volatile("s_nop 1"); _Pragma("unroll") for (int m = 0; m < 4; ++m) _Pragma("unroll") for (int n = 0; n < 2; ++n) \
            asm volatile("v_mfma_f32_16x16x128_f8f6f4 %0, %1, %2, %0" : "+v"(acc[ai][bj][m][n]) : "v"(Bt[n]), "v"(At[m])); }   \
        else { _Pragma("unroll") for (int m = 0; m < 4; ++m) _Pragma("unroll") for (int n = 0; n < 2; ++n) { \
            acc[ai][bj][m][n] = __builtin_amdgcn_mfma_f32_16x16x32_bf16(PG8_LO(Bt[n]), PG8_LO(At[m]), acc[ai][bj][m][n], 0, 0, 0); \
            acc[ai][bj][m][n] = __builtin_amdgcn_mfma_f32_16x16x32_bf16(PG8_HI(Bt[n]), PG8_HI(At[m]), acc[ai][bj][m][n], 0, 0, 0); } } \
        __builtin_amdgcn_s_setprio(0); } while (0)
#define PG8_WAIT_V(n) asm volatile("s_waitcnt vmcnt(" #n ")" ::: "memory")
#define PG8_WAIT_L(n) asm volatile("s_waitcnt lgkmcnt(" #n ")" ::: "memory")
#define PG8_BAR __builtin_amdgcn_s_barrier()
#define PG8_SCHED __builtin_amdgcn_sched_barrier(0)
#define PG8_KT(b1, b2, t) ((t) < nt1 ? (b1) + (size_t)(t) * kstep : (b2) + (size_t)((t) - nt1) * kstep)
    Unit cur, nxt; int ui = 0;
    if (!S.next(0, cur)) return;
    f32x4 acc[2][2][4][2];
#pragma unroll
    for (int a = 0; a < 2; ++a)
#pragma unroll
        for (int b = 0; b < 2; ++b)
#pragma unroll
            for (int m = 0; m < 4; ++m)
#pragma unroll
                for (int n = 0; n < 2; ++n) acc[a][b][m][n] = (f32x4){0.f, 0.f, 0.f, 0.f};
    i32x8 At[4], B0[2], B1[2];
    const char* cA = (const char*)g.A + (size_t)cur.pm * tstepA; const char* cB = (const char*)g.Bt + (size_t)cur.pn * tstepB;
    const char* cA2 = (const char*)g.A2 + (size_t)cur.pm * tstepA; const char* cB2 = (const char*)g.Bt2 + (size_t)cur.pn * tstepB;
    PG8_STAGE(PG8_SB(0, 0), cB, voffB); PG8_STAGE(PG8_SB(0, 1), cB + hstepB, voffB); PG8_STAGE(PG8_SA(0, 0), cA, voffA); PG8_STAGE(PG8_SA(0, 1), cA + hstepA, voffA);
    if (wr == 1) PG8_BAR;
    PG8_WAIT_V(2); PG8_BAR;
    PG8_STAGE(PG8_SB(1, 0), cB + kstep, voffB); PG8_STAGE(PG8_SA(1, 0), cA + kstep, voffA); PG8_STAGE(PG8_SB(1, 1), cB + hstepB + kstep, voffB);
    PG8_WAIT_V(6); PG8_BAR;
    for (;;) {
        const bool has_next = S.next(ui + 1, nxt);
        const char* nA = has_next ? (const char*)g.A + (size_t)nxt.pm * tstepA : cA; const char* nB = has_next ? (const char*)g.Bt + (size_t)nxt.pn * tstepB : cB;
        for (int seg = 0; seg < 2; ++seg) {
        const int tb = seg ? nt1 : 0, te = seg ? nt : nt1;
        if (seg && tb < te) { PG8_SCHED; if constexpr (FP8) asm volatile("s_nop 15\n\ts_nop 15" ::: "memory"); E.mid(acc, cur, wr, wc, fr, fq); PG8_SCHED; }
        for (int t = tb; t < te; t += 2) {
            const bool last = (t == nt - 2);
            const char* a1 = PG8_KT(cA, cA2, t + 1);
            const char* a2 = last ? nA : PG8_KT(cA, cA2, t + 2); const char* b2 = last ? nB : PG8_KT(cB, cB2, t + 2);
            const char* a3 = a2 + kstep; const char* b3 = b2 + kstep;
            PG8_LDB(B0, 0, 0); PG8_LDB(B1, 0, 1); PG8_SCHED; PG8_LDA(At, 0, 0); PG8_STAGE(PG8_SA(1, 1), a1 + hstepA, voffA);
            PG8_WAIT_V(8); PG8_WAIT_L(0); PG8_BAR; PG8_MMA(0, 0, At, B0); PG8_MMA(0, 1, At, B1); PG8_BAR; PG8_SCHED;
            PG8_LDA(At, 0, 1); PG8_STAGE(PG8_SB(0, 0), b2, voffB); PG8_STAGE(PG8_SB(0, 1), b2 + hstepB, voffB); PG8_STAGE(PG8_SA(0, 0), a2, voffA);
            PG8_WAIT_V(8); PG8_WAIT_L(0); PG8_BAR; PG8_MMA(1, 0, At, B0); PG8_MMA(1, 1, At, B1); PG8_BAR; PG8_SCHED;
            PG8_LDB(B0, 1, 0); PG8_LDB(B1, 1, 1); PG8_SCHED; PG8_LDA(At, 1, 0); PG8_STAGE(PG8_SA(0, 1), a2 + hstepA, voffA);
            PG8_WAIT_V(8); PG8_WAIT_L(0); PG8_BAR; PG8_MMA(0, 0, At, B0); PG8_MMA(0, 1, At, B1); PG8_BAR; PG8_SCHED;
            PG8_LDA(At, 1, 1); PG8_STAGE(PG8_SB(1, 0), b3, voffB); PG8_STAGE(PG8_SB(1, 1), b3 + hstepB, voffB); PG8_STAGE(PG8_SA(1, 0), a3, voffA);
            PG8_WAIT_V(8); PG8_WAIT_L(0); PG8_BAR; PG8_MMA(1, 0, At, B0); PG8_MMA(1, 1, At, B1); PG8_BAR; PG8_SCHED;
        }
        }
        if constexpr (ALIGN_EPI) { if (wr == 0) PG8_BAR; }
        if constexpr (FP8) asm volatile("s_nop 15\n\ts_nop 15" ::: "memory");
        E(acc, cur, wr, wc, fr, fq);
        if (!has_next) break;
#pragma unroll
        for (int a = 0; a < 2; ++a)
#pragma unroll
            for (int b = 0; b < 2; ++b)
#pragma unroll
                for (int m = 0; m < 4; ++m)
#pragma unroll
                    for (int n = 0; n < 2; ++n) { float z_ = 0.f; asm volatile("" : "+v"(z_)); acc[a][b][m][n] = (f32x4){z_, z_, z_, z_}; }
        cur = nxt; cA = nA; cB = nB; ++ui;
        cA2 = (const char*)g.A2 + (size_t)cur.pm * tstepA; cB2 = (const char*)g.Bt2 + (size_t)cur.pn * tstepB;
        if constexpr (ALIGN_EPI) { if (wr == 1) PG8_BAR; }
    }
    PG8_WAIT_V(0);
    if constexpr (!ALIGN_EPI) { if (wr == 0) PG8_BAR; }
    PG8_BAR;
#undef PG8_SA
#undef PG8_SB
#undef PG8_STAGE
#undef PG8_LDA
#undef PG8_LDB
#undef PG8_MMA
#undef PG8_LD8
#undef PG8_LO
#undef PG8_HI
#undef PG8_WAIT_V
#undef PG8_WAIT_L
#undef PG8_BAR
#undef PG8_SCHED
#undef PG8_KT
}
}

struct EpiProj {
    static constexpr bool PERM = true;
    bf16_t* P; bf16_t* KB; bf16_t* VB; bf16_t* KI; float* WI; int part; float ascale;
    __device__ __forceinline__ void mid(f32x4 (&)[2][2][4][2], const pg8::Unit&, int, int, int, int) const {}
    __device__ __forceinline__ void operator()(const f32x4 (&acc)[2][2][4][2], const pg8::Unit& u, int wr, int wc, int fr, int fq) const {
        const int row0 = u.pm * 256 + wr * 64 + fr;
        const int pn = part ? (u.pn < 12 ? u.pn : u.pn + 2) : (u.pn < 2 ? 12 + u.pn : 22);
        if (pn < 22) {
            int mode = 0; float sc = ascale;
            if (pn < 2 || pn == 8 || pn == 9) sc = QSC * ascale;
            else if (pn == 6 || pn == 7 || pn == 10 || pn == 11) mode = 1;
            else if (pn >= 14) mode = 2;
            const int col0 = pn * 256 + wc * 32 + 8 * fq;
            const float c2 = -sc * LOG2E;
#define EPI_BODY(EXPR_) do { _Pragma("unroll") for (int ai = 0; ai < 2; ++ai) _Pragma("unroll") for (int m = 0; m < 4; ++m) { \
                bf16_t* rowp = P + (size_t)(row0 + ai * 128 + m * 16) * PW + col0; \
                _Pragma("unroll") for (int bj = 0; bj < 2; ++bj) { float v[8]; \
                    _Pragma("unroll") for (int e = 0; e < 4; ++e) { v[e] = acc[ai][bj][m][0][e]; v[4 + e] = acc[ai][bj][m][1][e]; } \
                    _Pragma("unroll") for (int e = 0; e < 8; ++e) { float x = v[e]; EXPR_; asm("" : "+v"(x)); v[e] = x; } \
                    u32x4 w; w.x = cvtpk(v[0], v[1]); w.y = cvtpk(v[2], v[3]); w.z = cvtpk(v[4], v[5]); w.w = cvtpk(v[6], v[7]); \
                    *(u32x4*)(rowp + bj * 128) = w; } } } while (0)
            if (mode == 0) EPI_BODY(x = x * sc);
            else if (mode == 1) EPI_BODY({ float e_ = __builtin_amdgcn_exp2f(x * c2); asm("" : "+v"(e_)); e_ = __builtin_amdgcn_rcpf(1.f + e_); asm("" : "+v"(e_)); x = x * sc; asm("" : "+v"(x)); x = x * e_; });
            else EPI_BODY({ float e_ = __builtin_amdgcn_exp2f(x * c2); asm("" : "+v"(e_)); x = __builtin_amdgcn_rcpf(1.f + e_); });
#undef EPI_BODY
        } else {
#pragma unroll
            for (int ai = 0; ai < 2; ++ai)
#pragma unroll
                for (int m = 0; m < 4; ++m) {
                    const size_t row = (size_t)(row0 + ai * 128 + m * 16);
                    {
                        const f32x4 a = acc[ai][0][m][0], b = acc[ai][0][m][1];
                        u32x4 w; w.x = cvtpk(a[0], a[1]); w.y = cvtpk(a[2], a[3]); w.z = cvtpk(b[0], b[1]); w.w = cvtpk(b[2], b[3]);
                        if (wc < 2) {
                            u32x2 w8; w8.x = pk4_fp8(a[0], a[1], a[2], a[3]); w8.y = pk4_fp8(b[0], b[1], b[2], b[3]);
                            *(u32x2*)((fp8_t*)KB + row * 64 + fq * 16 + wc * 8) = w8;
                        } else {
                            u32x2 w8; w8.x = pk4_fp8(a[0], a[1], a[2], a[3]); w8.y = pk4_fp8(b[0], b[1], b[2], b[3]);
                            *(u32x2*)((fp8_t*)VB + row * 64 + (wc - 2) * 32 + 8 * fq) = w8;
                        }
                    }
                    {
                        const f32x4 a = acc[ai][1][m][0], b = acc[ai][1][m][1];
                        if (wc < 2) {
                            u32x4 w; w.x = cvtpk(a[0], a[1]); w.y = cvtpk(a[2], a[3]); w.z = cvtpk(b[0], b[1]); w.w = cvtpk(b[2], b[3]);
                            *(u32x4*)(KI + row * 64 + wc * 32 + 8 * fq) = w;
                        } else if (wc == 2 && fq == 0) {
                            *(f32x4*)(WI + row * 8) = a * IDX_SCALE; *(f32x4*)(WI + row * 8 + 4) = b * IDX_SCALE;
                        }
                    }
                }
        }
    }
};

__device__ __forceinline__ u32x4 buf_load16(__amdgpu_buffer_rsrc_t r, unsigned voff, unsigned soff) { return __builtin_bit_cast(u32x4, __builtin_amdgcn_raw_buffer_load_b128(r, (int)voff, (int)soff, 0)); }
__device__ __forceinline__ void buf_store16(__amdgpu_buffer_rsrc_t r, unsigned voff, unsigned soff, u32x4 v) { __builtin_amdgcn_raw_buffer_store_b128(v, r, (int)voff, (int)soff, 0); }
struct EpiMerge {
    static constexpr bool PERM = true;
    const bf16_t* P; fp8_t* MG;
    __device__ __forceinline__ void mid(f32x4 (&acc)[2][2][4][2], const pg8::Unit& u, int wr, int wc, int fr, int fq) const {
        { int l_ = (int)(threadIdx.x & 63u); asm volatile("" : "+v"(l_)); fr = l_ & 15; fq = l_ >> 4; }
        const __amdgpu_buffer_rsrc_t rp = __builtin_amdgcn_make_buffer_rsrc((void*)P, (short)0, (int)((size_t)NTOK * PW * 2), 0x00020000);
        const unsigned voff = (unsigned)(fr * PW + 8 * fq) * 2u;
#pragma unroll
        for (int ai = 0; ai < 2; ++ai) {
            u32x4 sa[4][2], sb[4][2];
#pragma unroll
            for (int m = 0; m < 4; ++m) {
                const unsigned soff = ((unsigned)(u.pm * 256 + wr * 64 + ai * 128 + m * 16) * (unsigned)PW + (unsigned)(u.pn * 256 + wc * 32)) * 2u;
#pragma unroll
                for (int bj = 0; bj < 2; ++bj) { sa[m][bj] = buf_load16(rp, voff, soff + (C_GA + bj * 128) * 2); sb[m][bj] = buf_load16(rp, voff, soff + (C_GB + bj * 128) * 2); }
            }
#pragma unroll
            for (int m = 0; m < 4; ++m)
#pragma unroll
                for (int bj = 0; bj < 2; ++bj)
#pragma unroll
                    for (int e = 0; e < 4; ++e) {
                        const float r0 = bf_lo(sa[m][bj][e]) * __builtin_amdgcn_rcpf(bf_lo(sb[m][bj][e])), r1 = bf_hi(sa[m][bj][e]) * __builtin_amdgcn_rcpf(bf_hi(sb[m][bj][e]));
                        acc[ai][bj][m][e >> 1][(e & 1) * 2] *= r0; acc[ai][bj][m][e >> 1][(e & 1) * 2 + 1] *= r1;
                    }
            asm volatile("" ::: "memory");
        }
    }
    __device__ __forceinline__ void operator()(const f32x4 (&acc)[2][2][4][2], const pg8::Unit& u, int wr, int wc, int fr, int fq) const {
        { int l_ = (int)(threadIdx.x & 63u); asm volatile("" : "+v"(l_)); fr = l_ & 15; fq = l_ >> 4; }
        const __amdgpu_buffer_rsrc_t rp = __builtin_amdgcn_make_buffer_rsrc((void*)P, (short)0, (int)((size_t)NTOK * PW * 2), 0x00020000);
        const __amdgpu_buffer_rsrc_t ro = __builtin_amdgcn_make_buffer_rsrc((void*)MG, (short)0, (int)((size_t)NTOK * DM), 0x00020000);
        const unsigned voff = (unsigned)(fr * PW + 8 * fq) * 2u, voffo = (unsigned)(fr * DM + 8 * fq);
        constexpr float c8 = Y8_SCALE * ACC8_UNSCALE;
#pragma unroll
        for (int ai = 0; ai < 2; ++ai) {
            u32x4 sb[4][2];
#pragma unroll
            for (int m = 0; m < 4; ++m) {
                const unsigned soff = ((unsigned)(u.pm * 256 + wr * 64 + ai * 128 + m * 16) * (unsigned)PW + (unsigned)(u.pn * 256 + wc * 32)) * 2u;
#pragma unroll
                for (int bj = 0; bj < 2; ++bj) sb[m][bj] = buf_load16(rp, voff, soff + (C_GB + bj * 128) * 2);
            }
#pragma unroll
            for (int m = 0; m < 4; ++m) {
                const unsigned soffo = (unsigned)(u.pm * 256 + wr * 64 + ai * 128 + m * 16) * (unsigned)DM + (unsigned)(u.pn * 256 + wc * 32);
#pragma unroll
                for (int bj = 0; bj < 2; ++bj) {
                    const f32x4 a = acc[ai][bj][m][0], b = acc[ai][bj][m][1];
                    const u32x4 g = sb[m][bj];
                    u32x2 w;
                    w.x = pk4_fp8(a[0] * bf_lo(g.x) * c8, a[1] * bf_hi(g.x) * c8, a[2] * bf_lo(g.y) * c8, a[3] * bf_hi(g.y) * c8);
                    w.y = pk4_fp8(b[0] * bf_lo(g.z) * c8, b[1] * bf_hi(g.z) * c8, b[2] * bf_lo(g.w) * c8, b[3] * bf_hi(g.w) * c8);
                    __builtin_amdgcn_raw_buffer_store_b64(w, ro, (int)voffo, (int)(soffo + bj * 128), 0);
                }
            }
            asm volatile("" ::: "memory");
        }
    }
};

struct EpiOut {
    static constexpr bool PERM = false;
    const bf16_t* XN; const float* RSX; float* O; float* RSS; const float* G; unsigned* CNT;
    __device__ __forceinline__ void mid(f32x4 (&)[2][2][4][2], const pg8::Unit&, int, int, int, int) const {}
    __device__ __forceinline__ void operator()(f32x4 (&acc)[2][2][4][2], const pg8::Unit& u, int wr, int wc, int fr, int fq) const {
        { int l_ = (int)(threadIdx.x & 63u); asm volatile("" : "+v"(l_)); fr = l_ & 15; fq = l_ >> 4; }
        const int col0 = u.pn * 256 + wc * 32 + 4 * fq;
#pragma unroll
        for (int ai = 0; ai < 2; ++ai) {
            u32x2 xv[4][2][2]; float rx[4];
#pragma unroll
            for (int m = 0; m < 4; ++m) {
                const int row = u.pm * 256 + ai * 128 + wr * 64 + m * 16 + fr;
                const size_t off = (size_t)row * DM + col0;
                rx[m] = RSX[row];
#pragma unroll
                for (int bj = 0; bj < 2; ++bj)
#pragma unroll
                    for (int n = 0; n < 2; ++n) xv[m][bj][n] = *(const u32x2*)(XN + off + bj * 128 + n * 16);
            }
#pragma unroll
            for (int m = 0; m < 4; ++m) {
                const int row = u.pm * 256 + ai * 128 + wr * 64 + m * 16 + fr;
                float ss = 0.f;
#pragma unroll
                for (int bj = 0; bj < 2; ++bj)
#pragma unroll
                    for (int n = 0; n < 2; ++n) {
                        const u32x2 xb = xv[m][bj][n];
                        const f32x4 hv = (f32x4){bf_lo(xb.x), bf_hi(xb.x), bf_lo(xb.y), bf_hi(xb.y)} * rx[m] + acc[ai][bj][m][n] * ACC8_UNSCALE;
                        ss += (hv[0] * hv[0] + hv[1] * hv[1]) + (hv[2] * hv[2] + hv[3] * hv[3]);
                        acc[ai][bj][m][n] = hv;
                    }
                ss += __shfl_xor(ss, 16); ss += __shfl_xor(ss, 32);
                if (fq == 0) atomicAdd(RSS + row, ss);
            }
            asm volatile("" ::: "memory");
        }
        asm volatile("s_waitcnt vmcnt(0)" ::: "memory");
        unsigned* cnt = CNT + 16 * u.pm;
        if ((threadIdx.x & 63) == 0) (void)__hip_atomic_fetch_add(cnt, 1u, __ATOMIC_RELAXED, __HIP_MEMORY_SCOPE_AGENT);
        for (unsigned sp = 0; sp < (1u << 22); ++sp) {
            const unsigned c = (unsigned)__builtin_amdgcn_readfirstlane((int)__hip_atomic_load(cnt, __ATOMIC_RELAXED, __HIP_MEMORY_SCOPE_AGENT));
            if (c >= 32u) break;
            __builtin_amdgcn_s_sleep(1);
        }
        float tot[2][4];
#pragma unroll
        for (int ai = 0; ai < 2; ++ai)
#pragma unroll
            for (int m = 0; m < 4; ++m) {
                const int row = u.pm * 256 + ai * 128 + wr * 64 + m * 16 + fr;
                tot[ai][m] = 0.f;
                if (fq == 0) tot[ai][m] = __hip_atomic_fetch_add(RSS + row, 0.f, __ATOMIC_RELAXED, __HIP_MEMORY_SCOPE_AGENT);
            }
        f32x4 gg[2][2];
#pragma unroll
        for (int bj = 0; bj < 2; ++bj)
#pragma unroll
            for (int n = 0; n < 2; ++n) gg[bj][n] = *(const f32x4*)(G + col0 + bj * 128 + n * 16);
#pragma unroll
        for (int ai = 0; ai < 2; ++ai)
#pragma unroll
            for (int m = 0; m < 4; ++m) {
                const int row = u.pm * 256 + ai * 128 + wr * 64 + m * 16 + fr;
                const size_t off = (size_t)row * DM + col0;
                const float t = __shfl(tot[ai][m], fr);
                const float rs = __builtin_amdgcn_rsqf(t * (1.f / DM) + EPS);
#pragma unroll
                for (int bj = 0; bj < 2; ++bj)
#pragma unroll
                    for (int n = 0; n < 2; ++n) *(f32x4*)(O + off + bj * 128 + n * 16) = acc[ai][bj][m][n] * rs * gg[bj][n];
            }
    }
};

struct Ctx {
    LAS unsigned char* lds;
    int tid, lane, wave, G, bid;
    const float *x, *norm_gain, *w_in, *a_rel, *t5, *w_a, *w_b, *w_o, *fgain;
    float* out;
    bf16_t *WT1, *KB, *VB, *KI, *XN, *P;
    fp8_t *WAT, *WBT, *WOT, *Y8, *MG8, *WT18, *XN8;
    float *WI, *RSS, *RSX;
    unsigned long long dbg;
};

__device__ __forceinline__ int proj_src_col(int d0, int& nvalid) {
    nvalid = 32;
    if (d0 < 2560) return d0;
    if (d0 < 3072) return d0 - 2560 + 2688;
    if (d0 < 3584) return d0 - 3072 + 3200;
    if (d0 < 5632) return d0 - 3584 + 3784;
    if (d0 < 5760) return d0 - 5632 + 2560;
    if (d0 < 5824) return d0 - 5760 + 3712;
    if (d0 == 5824) { nvalid = 8; return 3776; }
    nvalid = 0; return 0;
}
__device__ __forceinline__ void transpose_item(const float* W, int ldw, int src_n0, int nvalid, const float* gain, bf16_t* WT, int K, int dst_row0, int k0, LAS float* scr, int lane) {
#pragma unroll 8
    for (int i = 0; i < 32; ++i) {
        const int kk = 2 * i + (lane >> 5), col = lane & 31;
        float v = 0.f;
        if (col < nvalid) { v = W[(size_t)(k0 + kk) * ldw + src_n0 + col]; if (gain) v *= gain[k0 + kk]; }
        scr[kk * 33 + col] = v;
    }
    asm volatile("s_waitcnt lgkmcnt(0)" ::: "memory");
    const int c = lane & 7;
#pragma unroll
    for (int j = 0; j < 4; ++j) {
        const int n = (lane >> 3) + 8 * j; const LAS float* s = scr + (8 * c) * 33 + n;
        u32x4 o; o.x = cvtpk(s[0 * 33], s[1 * 33]); o.y = cvtpk(s[2 * 33], s[3 * 33]); o.z = cvtpk(s[4 * 33], s[5 * 33]); o.w = cvtpk(s[6 * 33], s[7 * 33]);
        *(u32x4*)(WT + (size_t)(dst_row0 + n) * K + k0 + 8 * c) = o;
    }
    asm volatile("s_waitcnt lgkmcnt(0)" ::: "memory");
}
__device__ __forceinline__ void transpose_item8(const float* W, int ldw, int src_n0, const float* gain, fp8_t* WT, int K, int dst_row0, int k0, LAS float* scr, int lane) {
#pragma unroll 8
    for (int i = 0; i < 32; ++i) {
        const int kk = 2 * i + (lane >> 5), col = lane & 31;
        float v = W[(size_t)(k0 + kk) * ldw + src_n0 + col] * W8_SCALE; if (gain) v *= gain[k0 + kk];
        scr[kk * 33 + col] = v;
    }
    asm volatile("s_waitcnt lgkmcnt(0)" ::: "memory");
    const int c = lane & 7;
#pragma unroll
    for (int j = 0; j < 4; ++j) {
        const int n = (lane >> 3) + 8 * j; const LAS float* s = scr + (8 * c) * 33 + n;
        u32x2 o; o.x = pk4_fp8(s[0 * 33], s[1 * 33], s[2 * 33], s[3 * 33]); o.y = pk4_fp8(s[4 * 33], s[5 * 33], s[6 * 33], s[7 * 33]);
        *(u32x2*)(WT + (size_t)(dst_row0 + n) * K + k0 + 8 * c) = o;
    }
    asm volatile("s_waitcnt lgkmcnt(0)" ::: "memory");
}
__device__ __forceinline__ void p0_prologue(Ctx& C) {
    LAS float* scr = (LAS float*)(C.lds + C.wave * 16384);
    const int gw = C.bid * NWAVES + C.wave, NGW = C.G * NWAVES;
    constexpr int I_IN = 16 * (NW1 / 32), I_A = 8 * 32, I_O = 16 * 32, NITEMS = I_IN + 2 * I_A + I_O;
    for (int it = gw; it < NITEMS; it += NGW) {
        int r = it;
        if (r < I_IN) { const int kb = r / (NW1 / 32), nb = r % (NW1 / 32); int nv; const int sc = proj_src_col(nb * 32, nv);
            const int dt = nb >> 3, drow = (nb & 7) * 32;
            if (dt == 12 || dt == 13 || dt == 22) transpose_item(C.w_in, IN_COLS, sc, nv, C.norm_gain, C.WT1, DM, (dt == 22 ? 512 : (dt - 12) * 256) + drow, kb * 64, scr, C.lane);
            else transpose_item8(C.w_in, IN_COLS, sc, C.norm_gain, C.WT18, DM, (dt < 12 ? dt : dt - 2) * 256 + drow, kb * 64, scr, C.lane);
            continue; }
        r -= I_IN;
        if (r < I_A) { transpose_item8(C.w_a, DM, (r % 32) * 32, nullptr, C.WAT, 512, (r % 32) * 32, (r / 32) * 64, scr, C.lane); continue; }
        r -= I_A;
        if (r < I_A) { transpose_item8(C.w_b, DM, (r % 32) * 32, nullptr, C.WBT, 512, (r % 32) * 32, (r / 32) * 64, scr, C.lane); continue; }
        r -= I_A;
        transpose_item8(C.w_o, DM, (r % 32) * 32, nullptr, C.WOT, DM, (r % 32) * 32, (r / 32) * 64, scr, C.lane);
    }
    for (int m0 = gw * 4; m0 < NTOK; m0 += NGW * 4) {
        f32x4 v[4][4]; float s[4];
#pragma unroll
        for (int r = 0; r < 4; ++r) {
            const f32x4* xr = (const f32x4*)(C.x + (size_t)(m0 + r) * DM) + C.lane;
            s[r] = 0.f;
#pragma unroll
            for (int j = 0; j < 4; ++j) v[r][j] = __builtin_nontemporal_load(xr + 64 * j);
        }
#pragma unroll
        for (int r = 0; r < 4; ++r) {
#pragma unroll
            for (int j = 0; j < 4; ++j) s[r] += (v[r][j].x * v[r][j].x + v[r][j].y * v[r][j].y) + (v[r][j].z * v[r][j].z + v[r][j].w * v[r][j].w);
            float t = s[r];
            t += __uint_as_float(dpp_u<0x111, 0xf>(0u, __float_as_uint(t))); t += __uint_as_float(dpp_u<0x112, 0xf>(0u, __float_as_uint(t)));
            t += __uint_as_float(dpp_u<0x114, 0xf>(0u, __float_as_uint(t))); t += __uint_as_float(dpp_u<0x118, 0xf>(0u, __float_as_uint(t)));
            t += __uint_as_float(dpp_u<0x142, 0xa>(0u, __float_as_uint(t))); t += __uint_as_float(dpp_u<0x143, 0xc>(0u, __float_as_uint(t)));
            s[r] = __uint_as_float((unsigned)__builtin_amdgcn_readlane((int)__float_as_uint(t), 63));
        }
#pragma unroll
        for (int r = 0; r < 4; ++r) {
            const float rstd = __builtin_amdgcn_rsqf(s[r] * (1.f / DM) + EPS);
            if (C.lane == 0) C.RSX[m0 + r] = __builtin_amdgcn_sqrtf(s[r] * (1.f / DM) + EPS);
            u32x2* o8 = (u32x2*)(C.XN + (size_t)(m0 + r) * DM) + C.lane;
            unsigned* o4 = (unsigned*)(C.XN8 + (size_t)(m0 + r) * DM) + C.lane;
#pragma unroll
            for (int j = 0; j < 4; ++j) {
                const f32x4 y = v[r][j] * rstd;
                u32x2 w; w.x = cvtpk(y.x, y.y); w.y = cvtpk(y.z, y.w); o8[64 * j] = w;
                o4[64 * j] = pk4_fp8(y.x, y.y, y.z, y.w);
            }
        }
    }
    for (int i = C.bid * 512 + C.tid; i < NTOK; i += C.G * 512) { C.RSS[i] = 0.f;
    }
}

constexpr int A_WAVE_LDS = 1280 + 4096 + 9216;
__device__ __forceinline__ s16x4 tr_read(LAS unsigned char* p) { return __builtin_bit_cast(s16x4, __builtin_amdgcn_ds_read_tr16_b64_v4i16((LAS s16x4*)p)); }
template <int VAR> __device__ __forceinline__ void mixerA_unit(Ctx& C, int b, int c, fp8_t* outp, int opitch) {
    const int lane = C.lane, h = C.wave, r32 = lane & 31, hi = lane >> 5;
    LAS unsigned char* wl = C.lds + h * A_WAVE_LDS;
    LAS float* btab = (LAS float*)wl;
    LAS unsigned char* vimg = wl + 1280;
    LAS bf16_t* ost = (LAS bf16_t*)(wl + 1280 + 4096);
    for (int i = lane; i < 320; i += 64) btab[i] = C.a_rel[h * 513 + i + 193] * LOG2E;
    const size_t tok0 = (size_t)b * SEQ + (size_t)c * 64;
    const bf16_t* Qp = C.P + tok0 * PW + C_QA + h * 64;
    bf16x8 qf[2][4];
#pragma unroll
    for (int qg = 0; qg < 2; ++qg)
#pragma unroll
        for (int ks = 0; ks < 4; ++ks) qf[qg][ks] = *(const bf16x8*)(Qp + (size_t)(32 * qg + r32) * PW + 16 * ks + 8 * hi);
    f32x16 o[2][2];
#pragma unroll
    for (int a = 0; a < 2; ++a)
#pragma unroll
        for (int q = 0; q < 2; ++q)
#pragma unroll
            for (int i = 0; i < 16; ++i) o[a][q][i] = 0.f;
    float mrun[2] = {-1e30f, -1e30f}, lrun[2] = {0.f, 0.f};
    const float bfar = C.a_rel[h * 513 + 512] * LOG2E;
    const int t0 = c < 8 ? (8 - c) * 2 : 0;
    const long kbase = (long)b * SEQ + (long)(c - 8) * 64;
    const int i16 = lane & 15, qq = i16 >> 2, pp = i16 & 3, blk = (lane >> 4) & 1;
    asm volatile("s_waitcnt lgkmcnt(0)" ::: "memory");
    bf16x8 kfn[4]; u32x4 vn[4];
#define MA_LOAD(t_) do { const int j0_ = (t_) * 32; const bf16_t* Kp = C.P + (size_t)(kbase + j0_ + r32) * PW + C_KA + h * 64 + 8 * hi; \
        _Pragma("unroll") for (int ks = 0; ks < 4; ++ks) kfn[ks] = *(const bf16x8*)(Kp + 16 * ks); \
        _Pragma("unroll") for (int r = 0; r < 4; ++r) { const int pc = lane + 64 * r, key = pc >> 3, ch = pc & 7; \
            vn[r] = *(const u32x4*)(C.P + (size_t)(kbase + j0_ + key) * PW + C_VA + h * 64 + ch * 8); } } while (0)
    MA_LOAD(t0);
#pragma unroll 1
    for (int t = t0; t < 18; ++t) {
        const int j0 = t * 32;
        bf16x8 kf[4];
#pragma unroll
        for (int ks = 0; ks < 4; ++ks) kf[ks] = kfn[ks];
        if (VAR != 1)
#pragma unroll
        for (int r = 0; r < 4; ++r) {
            const int pc = lane + 64 * r, key = pc >> 3, ch = pc & 7;
            *(LAS u32x4*)(vimg + (ch >> 2) * 2048 + key * 64 + (ch & 3) * 16) = vn[r];
        }
        if (VAR == 1) { o[0][0][0] += __uint_as_float(vn[0].x ^ vn[3].w); }
        if (t + 1 < 18) MA_LOAD(t + 1);
        const bool far = (t < 8);
        const float cinit = far ? bfar : 0.f;
        f32x16 s[2];
        __builtin_amdgcn_s_setprio(1);
#pragma unroll
        for (int qg = 0; qg < 2; ++qg) {
#pragma unroll
            for (int i = 0; i < 16; ++i) s[qg][i] = cinit;
#pragma unroll
            for (int ks = 0; ks < 4; ++ks) s[qg] = __builtin_amdgcn_mfma_f32_32x32x16_bf16(kf[ks], qf[qg][ks], s[qg], 0, 0, 0);
        }
        __builtin_amdgcn_s_setprio(0);
        float tmax[2];
#pragma unroll
        for (int qg = 0; qg < 2; ++qg) {
            const int q = 32 * qg + r32;
            float tm = -1e30f;
            if (!far && VAR != 2) {
                if (t < 10) {
#pragma unroll
                    for (int i = 0; i < 16; ++i) {
                        const int j = j0 + crow(i, hi); const int rel = 512 + q - j; const int bi = (rel < 256 ? rel : 256) + 63;
                        s[qg][i] += btab[bi];
                    }
                } else {
                    const LAS float* bp = btab + (575 - 27 + q - j0 - 4 * hi);
#pragma unroll
                    for (int i = 0; i < 16; ++i) s[qg][i] += bp[27 - ((i & 3) + 8 * (i >> 2))];
                }
            }
#pragma unroll
            for (int i = 0; i < 16; ++i) tm = fmaxf(tm, s[qg][i]);
            tmax[qg] = xmax32(tm);
        }
        if (__any((tmax[0] > mrun[0] + 8.f) || (tmax[1] > mrun[1] + 8.f))) {
#pragma unroll
            for (int qg = 0; qg < 2; ++qg) {
                const float mn = fmaxf(mrun[qg], tmax[qg]), alpha = __builtin_amdgcn_exp2f(mrun[qg] - mn); mrun[qg] = mn;
                lrun[qg] *= alpha;
#pragma unroll
                for (int dt = 0; dt < 2; ++dt)
#pragma unroll
                    for (int i = 0; i < 16; ++i) o[dt][qg][i] *= alpha;
            }
        }
        bf16x8 pk[2][2];
#pragma unroll
        for (int qg = 0; qg < 2; ++qg) {
            const float mn = mrun[qg];
            float ps = 0.f;
#pragma unroll
            for (int i = 0; i < 16; ++i) { const float p = (VAR == 2) ? s[qg][i] : __builtin_amdgcn_exp2f(s[qg][i] - mn); s[qg][i] = p; ps += p; }
            lrun[qg] += ps;
#pragma unroll
            for (int st = 0; st < 2; ++st) {
                u32x4 w; w.x = cvtpk(s[qg][8 * st + 0], s[qg][8 * st + 1]); w.y = cvtpk(s[qg][8 * st + 2], s[qg][8 * st + 3]);
                w.z = cvtpk(s[qg][8 * st + 4], s[qg][8 * st + 5]); w.w = cvtpk(s[qg][8 * st + 6], s[qg][8 * st + 7]);
                pk[qg][st] = __builtin_bit_cast(bf16x8, w);
            }
        }
        asm volatile("s_waitcnt lgkmcnt(0)" ::: "memory");
        if (VAR == 1) { o[0][0][1] += __uint_as_float(__builtin_bit_cast(u32x4, pk[0][0]).x ^ __builtin_bit_cast(u32x4, pk[1][1]).w ^ __builtin_bit_cast(u32x4, pk[0][1]).y ^ __builtin_bit_cast(u32x4, pk[1][0]).z); } else
#pragma unroll
        for (int dt = 0; dt < 2; ++dt)
#pragma unroll
            for (int st = 0; st < 2; ++st) {
                LAS unsigned char* pb = vimg + dt * 2048 + (16 * st + 4 * hi + qq) * 64 + (16 * blk + 4 * pp) * 2;
                const s16x4 lo = tr_read(pb), hi4 = tr_read(pb + 8 * 64);
                const bf16x8 vf = __builtin_shufflevector(lo, hi4, 0, 1, 2, 3, 4, 5, 6, 7);
                __builtin_amdgcn_s_setprio(1);
#pragma unroll
                for (int qg = 0; qg < 2; ++qg) o[dt][qg] = __builtin_amdgcn_mfma_f32_32x32x16_bf16(vf, pk[qg][st], o[dt][qg], 0, 0, 0);
                __builtin_amdgcn_s_setprio(0);
            }
        asm volatile("s_waitcnt lgkmcnt(0)" ::: "memory");
    }
#undef MA_LOAD
#pragma unroll
    for (int qg = 0; qg < 2; ++qg) {
        const float lt = xsum32(lrun[qg]); const float inv = __builtin_amdgcn_rcpf(lt);
#pragma unroll
        for (int dt = 0; dt < 2; ++dt)
#pragma unroll
            for (int i = 0; i < 16; ++i) ost[(32 * qg + r32) * 72 + 32 * dt + crow(i, hi)] = f2bf(o[dt][qg][i] * inv);
    }
    asm volatile("s_waitcnt lgkmcnt(0)" ::: "memory");
    u32x4 zv8[8];
#pragma unroll
    for (int r = 0; r < 8; ++r) { const int row = (lane >> 3) + 8 * r, ch = lane & 7; zv8[r] = *(const u32x4*)(C.P + (tok0 + row) * PW + h * 64 + ch * 8 + C_ZA); }
#pragma unroll
    for (int r = 0; r < 8; ++r) {
        const int row = (lane >> 3) + 8 * r, ch = lane & 7;
        const u32x4 ov = *(const LAS u32x4*)(ost + row * 72 + ch * 8);
        const u32x4 zv = zv8[r];
        u32x2 w;
        w.x = pk4_fp8(bf_lo(ov[0]) * bf_lo(zv[0]) * Y8_SCALE, bf_hi(ov[0]) * bf_hi(zv[0]) * Y8_SCALE, bf_lo(ov[1]) * bf_lo(zv[1]) * Y8_SCALE, bf_hi(ov[1]) * bf_hi(zv[1]) * Y8_SCALE);
        w.y = pk4_fp8(bf_lo(ov[2]) * bf_lo(zv[2]) * Y8_SCALE, bf_hi(ov[2]) * bf_hi(zv[2]) * Y8_SCALE, bf_lo(ov[3]) * bf_lo(zv[3]) * Y8_SCALE, bf_hi(ov[3]) * bf_hi(zv[3]) * Y8_SCALE);
        *(u32x2*)(outp + (tok0 + row) * (size_t)opitch + h * 64 + ch * 8) = w;
    }
    asm volatile("s_waitcnt lgkmcnt(0)" ::: "memory");
}

__device__ __forceinline__ int t5_bucket(int rel) {
    const int n = rel < 0 ? -rel : rel;
    int bkt = n < 8 ? n : 8 + (n >= 12) + (n >= 16) + (n >= 23) + (n >= 32) + (n >= 46) + (n >= 64) + (n >= 91);
    return bkt + (rel > 0 ? 16 : 0);
}
constexpr int BF_STRIDE = 580;
constexpr int BF_LIST = 0;
constexpr int BF_CNT = 64 * BF_STRIDE * 4;
constexpr int BF_THRF = BF_CNT + 512;
constexpr int BF_PEND = BF_THRF + 256;
constexpr int BF_HIST = BF_PEND + 768;
constexpr int BF_T5 = BF_HIST + 8192;
constexpr int BF_PBAR = BF_T5 + 1024;
constexpr int BF_END = BF_PBAR + 64;
constexpr int BF_CAP = 576;
constexpr int BF_SEL = 0;
constexpr int BF_VIMG = 65536;
static_assert(BF_END <= LDS_BYTES - 64 && BF_VIMG + 8 * 8320 <= BF_CNT, "LDS map");

constexpr int NV = 9;
__device__ __forceinline__ unsigned pack_key(float s, unsigned idxinv) { const int b = __float_as_int(s); const unsigned u = (unsigned)b ^ ((unsigned)(b >> 31) | 0x80000000u); return (u & 0xFFFFE000u) | idxinv; }
__device__ __forceinline__ float key_lower_float(unsigned T) { const unsigned u = T & 0xFFFFE000u; const unsigned bits = (u & 0x80000000u) ? (u & 0x7FFFFFFFu) : ~u; return __uint_as_float(bits); }
__device__ __forceinline__ unsigned wave_prefix_sum(unsigned v) {
    v += dpp_u<0x111, 0xf>(0u, v); v += dpp_u<0x112, 0xf>(0u, v); v += dpp_u<0x114, 0xf>(0u, v); v += dpp_u<0x118, 0xf>(0u, v);
    v += dpp_u<0x142, 0xa>(0u, v); v += dpp_u<0x143, 0xc>(0u, v); return v;
}
__device__ __forceinline__ unsigned wave_max_u(unsigned v) {
    unsigned t;
    t = dpp_u<0x111, 0xf>(0u, v); v = v > t ? v : t; t = dpp_u<0x112, 0xf>(0u, v); v = v > t ? v : t;
    t = dpp_u<0x114, 0xf>(0u, v); v = v > t ? v : t; t = dpp_u<0x118, 0xf>(0u, v); v = v > t ? v : t;
    t = dpp_u<0x142, 0xa>(0u, v); v = v > t ? v : t; t = dpp_u<0x143, 0xc>(0u, v); v = v > t ? v : t;
    return (unsigned)__builtin_amdgcn_readlane((int)v, 63);
}
__device__ __forceinline__ unsigned wave_min_u(unsigned v) {
    unsigned t;
    t = dpp_u<0x111, 0xf>(0xFFFFFFFFu, v); v = v < t ? v : t; t = dpp_u<0x112, 0xf>(0xFFFFFFFFu, v); v = v < t ? v : t;
    t = dpp_u<0x114, 0xf>(0xFFFFFFFFu, v); v = v < t ? v : t; t = dpp_u<0x118, 0xf>(0xFFFFFFFFu, v); v = v < t ? v : t;
    t = dpp_u<0x142, 0xa>(0xFFFFFFFFu, v); v = v < t ? v : t; t = dpp_u<0x143, 0xc>(0xFFFFFFFFu, v); v = v < t ? v : t;
    return (unsigned)__builtin_amdgcn_readlane((int)v, 63);
}
__device__ __forceinline__ int mbcnt64(unsigned long long m) { return __builtin_amdgcn_mbcnt_hi((unsigned)(m >> 32), __builtin_amdgcn_mbcnt_lo((unsigned)m, 0u)); }
#define LDS_BARRIER() do { asm volatile("s_waitcnt lgkmcnt(0)" ::: "memory"); __builtin_amdgcn_s_barrier(); asm volatile("" ::: "memory"); } while (0)

__device__ __forceinline__ void select_query(LAS unsigned* lq, LAS unsigned* cntp, LAS float* thrp, LAS unsigned* hist, const int cn, bool exact, const int lane) {
    unsigned v[NV];
#pragma unroll
    for (int i = 0; i < NV; ++i) v[i] = lq[i * 64 + lane];
    unsigned mx = 0u, mn = 0xFFFFFFFFu;
#pragma unroll
    for (int i = 0; i < NV; ++i) { if (i * 64 + lane >= cn) v[i] = 0u; mx = v[i] > mx ? v[i] : mx; const unsigned w = v[i] ? v[i] : 0xFFFFFFFFu; mn = w < mn ? w : mn; }
    mx = wave_max_u(mx); mn = wave_min_u(mn);
    int need = 256;
    unsigned base = mn;
    const unsigned range = mx - mn;
    int sh = range >= 256u ? (24 - __builtin_clz(range)) : 0;
    unsigned T = 0u;
    for (;;) {
        *(LAS u32x4*)(hist + lane * 4) = (u32x4){0u, 0u, 0u, 0u};
        asm volatile("s_waitcnt lgkmcnt(0)" ::: "memory");
#pragma unroll
        for (int i = 0; i < NV; ++i) {
            const unsigned dgt = (v[i] - base) >> sh;
            const bool in = (v[i] != 0u) && (v[i] >= base) && (dgt < 256u);
            if (in) (void)__hip_atomic_fetch_add(hist + (255u - dgt), 1u, __ATOMIC_RELAXED, __HIP_MEMORY_SCOPE_WORKGROUP);
        }
        asm volatile("s_waitcnt lgkmcnt(0)" ::: "memory");
        const u32x4 hb = *(const LAS u32x4*)(hist + lane * 4);
        const unsigned S = hb.x + hb.y + hb.z + hb.w;
        const unsigned incl = wave_prefix_sum(S);
        const unsigned excl = incl - S;
        int phys; unsigned popl, abvl;
        {
            unsigned cacc = excl;
            if (cacc + hb.x >= (unsigned)need) { phys = 0; popl = hb.x; abvl = cacc; }
            else { cacc += hb.x;
                if (cacc + hb.y >= (unsigned)need) { phys = 1; popl = hb.y; abvl = cacc; }
                else { cacc += hb.y;
                    if (cacc + hb.z >= (unsigned)need) { phys = 2; popl = hb.z; abvl = cacc; }
                    else { cacc += hb.z; phys = 3; popl = hb.w; abvl = cacc; } } }
            phys += 4 * lane;
        }
        const unsigned long long cm = __ballot(incl >= (unsigned)need);
        const int src = __ffsll((long long)cm) - 1;
        const int bin = 255 - __builtin_amdgcn_readlane(phys, src);
        const int pop = __builtin_amdgcn_readlane((int)popl, src), above = __builtin_amdgcn_readlane((int)abvl, src);
        const unsigned newbase = base + ((unsigned)bin << sh);
        const int kept = (256 - need) + above + pop;
        if (!exact) {
            if (kept <= 288 || sh == 0) { T = newbase; break; }
            exact = true;
        }
        need -= above;
        if (pop <= 64 || sh == 0) {
            int pos = 0;
#pragma unroll
            for (int i = 0; i < NV; ++i) {
                const bool in = (v[i] != 0u) && (v[i] >= newbase) && (((v[i] - newbase) >> sh) == 0u);
                const unsigned long long mk = __ballot(in);
                if (in) hist[pos + mbcnt64(mk)] = v[i];
                pos += __popcll(mk);
            }
            asm volatile("s_waitcnt lgkmcnt(0)" ::: "memory");
            const unsigned e = (lane < pop) ? hist[lane] : 0u;
            int rk = 0;
            for (int k = 0; k < pop; ++k) rk += (hist[k] > e) ? 1 : 0;
            const bool isT = (lane < pop) && (rk == need - 1);
            const unsigned long long tm = __ballot(isT);
            T = (unsigned)__builtin_amdgcn_readlane((int)e, __ffsll((long long)tm) - 1);
            break;
        }
        base = newbase; sh = sh > 8 ? sh - 8 : 0;
    }
    int pos = 0;
#pragma unroll
    for (int i = 0; i < NV; ++i) {
        const bool k = (v[i] != 0u) && (v[i] >= T);
        const unsigned long long mk = __ballot(k);
        if (k) lq[pos + mbcnt64(mk)] = v[i];
        pos += __popcll(mk);
    }
    if (lane == 0) { *cntp = (unsigned)pos; *thrp = key_lower_float(T); }
    asm volatile("s_waitcnt lgkmcnt(0)" ::: "memory");
}

#define PRUNE_MASKS(T_) asm("v_cmp_le_u32_e64 %0, %9, %10\n\tv_cmp_le_u32_e64 %1, %9, %11\n\tv_cmp_le_u32_e64 %2, %9, %12\n\tv_cmp_le_u32_e64 %3, %9, %13\n\tv_cmp_le_u32_e64 %4, %9, %14\n\t" \
            "v_cmp_le_u32_e64 %5, %9, %15\n\tv_cmp_le_u32_e64 %6, %9, %16\n\tv_cmp_le_u32_e64 %7, %9, %17\n\tv_cmp_le_u32_e64 %8, %9, %18" \
            : "=&s"(m0), "=&s"(m1), "=&s"(m2), "=&s"(m3), "=&s"(m4), "=&s"(m5), "=&s"(m6), "=&s"(m7), "=&s"(m8) \
            : "s"(T_), "v"(v[0]), "v"(v[1]), "v"(v[2]), "v"(v[3]), "v"(v[4]), "v"(v[5]), "v"(v[6]), "v"(v[7]), "v"(v[8]))
__device__ __forceinline__ void prune_query(LAS unsigned* lq, LAS unsigned* cntp, LAS float* thrp, const int cn, const int lane) {
    __builtin_amdgcn_s_setprio(3);
    unsigned v[NV];
#pragma unroll
    for (int i = 0; i < NV; ++i) v[i] = lq[i * 64 + lane];
    const float thr_old = __uint_as_float((unsigned)__builtin_amdgcn_readfirstlane((int)__float_as_uint(*thrp)));
    if (7 * 64 + lane >= cn) v[7] = 0u;
    if (8 * 64 + lane >= cn) v[8] = 0u;
    unsigned mx = v[0];
#pragma unroll
    for (int i = 1; i < NV; ++i) mx = v[i] > mx ? v[i] : mx;
    unsigned hi = wave_max_u(mx), lo;
    if (thr_old == -INFINITY) {
        unsigned mn = v[0];
#pragma unroll
        for (int i = 1; i < 7; ++i) mn = v[i] < mn ? v[i] : mn;
        const unsigned w7 = v[7] ? v[7] : 0xFFFFFFFFu, w8 = v[8] ? v[8] : 0xFFFFFFFFu;
        mn = w7 < mn ? w7 : mn; mn = w8 < mn ? w8 : mn;
        lo = wave_min_u(mn);
    } else lo = pack_key(thr_old, 0u);
    unsigned long long m0, m1, m2, m3, m4, m5, m6, m7, m8;
    bool have = false;
    for (;;) {
        if (hi == lo) break;
        const unsigned T = lo + ((hi - lo + 1u) >> 1);
        PRUNE_MASKS(T);
        const int c = __popcll(m0) + __popcll(m1) + __popcll(m2) + __popcll(m3) + __popcll(m4) + __popcll(m5) + __popcll(m6) + __popcll(m7) + __popcll(m8);
        if (c >= 256) { lo = T; if (c <= 288) { have = true; break; } } else hi = T - 1u;
    }
    if (!have) PRUNE_MASKS(lo);
    int pos = 0;
#define PRUNE_PUT(i_, m_) do { if (__builtin_amdgcn_inverse_ballot_w64(m_)) lq[pos + mbcnt64(m_)] = v[i_]; pos += __popcll(m_); } while (0)
    PRUNE_PUT(0, m0); PRUNE_PUT(1, m1); PRUNE_PUT(2, m2); PRUNE_PUT(3, m3); PRUNE_PUT(4, m4); PRUNE_PUT(5, m5); PRUNE_PUT(6, m6); PRUNE_PUT(7, m7); PRUNE_PUT(8, m8);
#undef PRUNE_PUT
    if (lane == 0) { *cntp = (unsigned)pos; *thrp = key_lower_float(lo); }
    asm volatile("s_waitcnt lgkmcnt(0)" ::: "memory");
    __builtin_amdgcn_s_setprio(0);
}
#undef PRUNE_MASKS

__device__ __forceinline__ void b2_loadK(u32x4 (&Kf)[4], const LAS unsigned* sq, int ci, const fp8_t* KBb, int lane) {
    const int g = lane >> 4;
#pragma unroll
    for (int tt = 0; tt < 4; ++tt) {
        const int key = (int)(sq[64 * ci + 16 * tt + (lane & 15)] & 0xffffu);
        Kf[tt] = *(const u32x4*)(KBb + (size_t)key * 64 + 16 * g);
    }
}
__device__ __forceinline__ void b2_loadV(u32x4 (&Vf)[4], const LAS unsigned* sq, int ci, const fp8_t* VBb, int lane) {
#pragma unroll
    for (int r = 0; r < 4; ++r) {
        const int pc = lane + 64 * r, row = pc >> 2, dt = pc & 3;
        const int key = (int)(sq[64 * ci + row] & 0xffffu);
        Vf[r] = *(const u32x4*)(VBb + (size_t)key * 64 + dt * 16);
    }
}
struct B2State { f32x4 o[4]; float mrun, lrun; long qb[2]; u32x4 qbn[2]; u32x2 zz[4]; };
template <int VAR> __device__ __forceinline__ void b2_step(Ctx& C, B2State& st, const u32x4 (&Kf)[4], const u32x4 (&Vf)[4], const LAS unsigned* sq, const LAS float* t5L, LAS unsigned char* vimg,
                                        int ci, int nchunk, int ns, size_t tok, int pos, fp8_t* outp, int opitch, int lane, bool haveNext) {
    const int hd = lane & 15, g = lane >> 4, hd7 = hd & 7;
    const int qq4 = hd >> 2, pp = hd & 3;
    if (ci == 0) {
#pragma unroll
        for (int d = 0; d < 4; ++d) st.o[d] = (f32x4){0.f, 0.f, 0.f, 0.f};
        st.mrun = -1e30f; st.lrun = 0.f;
#pragma unroll
        for (int ks = 0; ks < 2; ++ks) {
            const u32x4 t = st.qbn[ks];
            u32x2 q8; q8.x = pk4_fp8(bf_lo(t.x) * 8.f, bf_hi(t.x) * 8.f, bf_lo(t.y) * 8.f, bf_hi(t.y) * 8.f); q8.y = pk4_fp8(bf_lo(t.z) * 8.f, bf_hi(t.z) * 8.f, bf_lo(t.w) * 8.f, bf_hi(t.w) * 8.f);
            if (hd >= 8) q8 = (u32x2){0u, 0u};
            st.qb[ks] = __builtin_bit_cast(long, q8);
        }
#pragma unroll
        for (int d = 0; d < 4; ++d) st.zz[d] = *(const u32x2*)(C.P + tok * PW + hd7 * 64 + 4 * g + C_ZB + 16 * d);
        if (haveNext) {
#pragma unroll
            for (int ks = 0; ks < 2; ++ks) st.qbn[ks] = *(const u32x4*)(C.P + (tok + 1) * PW + C_QB + hd7 * 64 + 32 * ks + 8 * g);
        }
    }
#pragma unroll
    for (int r = 0; r < 4; ++r) {
        const int pc = lane + 64 * r, row = pc >> 2, dt = pc & 3;
        const int pos = (row & 32) + 8 * ((row >> 2) & 3) + 4 * ((row >> 4) & 1) + (row & 3);
        *(LAS u32x4*)(vimg + dt * 1024 + pos * 16) = Vf[r];
    }
    const int hup = hd >> 3;
    u32x4 kk[2];
#pragma unroll
    for (int p = 0; p < 2; ++p) kk[p] = *(const LAS u32x4*)(sq + 16 * (4 * ci + 2 * p + hup) + 4 * g);
    float bias[2][4];
#pragma unroll
    for (int p = 0; p < 2; ++p)
#pragma unroll
        for (int i = 0; i < 4; ++i) bias[p][i] = t5L[(kk[p][i] >> 16) * 8 + hd7];
    f32x4 acc4[4];
#pragma unroll
    for (int tt = 0; tt < 4; ++tt) {
        f32x4 a = (f32x4){0.f, 0.f, 0.f, 0.f};
        a = __builtin_amdgcn_mfma_f32_16x16x32_fp8_fp8(__builtin_bit_cast(long, (u32x2){Kf[tt].x, Kf[tt].y}), st.qb[0], a, 0, 0, 0);
        acc4[tt] = __builtin_amdgcn_mfma_f32_16x16x32_fp8_fp8(__builtin_bit_cast(long, (u32x2){Kf[tt].z, Kf[tt].w}), st.qb[1], a, 0, 0, 0);
    }
    float lg[2][4];
    float cmax = -1e30f;
#pragma unroll
    for (int p = 0; p < 2; ++p)
#pragma unroll
        for (int i = 0; i < 4; ++i) {
            const float f = __uint_as_float((unsigned)__builtin_amdgcn_update_dpp((int)__float_as_uint(acc4[2 * p][i]), (int)__float_as_uint(acc4[2 * p + 1][i]), 0x128, 0xf, 0xc, false));
            const float x = __builtin_fmaf(f, 0.125f, bias[p][i]);
            lg[p][i] = x; cmax = fmaxf(cmax, x);
        }
    cmax = xmax32(xmax16(cmax));
    cmax = fmaxf(cmax, __uint_as_float(dpp_u<0x128, 0xf>(0u, __float_as_uint(cmax))));
    const float mn = fmaxf(st.mrun, cmax); const float alpha = __builtin_amdgcn_exp2f(st.mrun - mn); st.mrun = mn;
    float ps = 0.f;
#pragma unroll
    for (int p = 0; p < 2; ++p)
#pragma unroll
        for (int i = 0; i < 4; ++i) { const float e = __builtin_amdgcn_exp2f(lg[p][i] - mn); lg[p][i] = e; ps += e; }
    st.lrun = st.lrun * alpha + ps;
#pragma unroll
    for (int d = 0; d < 4; ++d) st.o[d] = st.o[d] * alpha;
    asm volatile("s_waitcnt lgkmcnt(0)" ::: "memory");
    {
        long vf[2][4];
#pragma unroll
        for (int ul = 0; ul < 2; ++ul)
#pragma unroll
            for (int d = 0; d < 4; ++d) {
                LAS unsigned char* pa = vimg + d * 1024 + (32 * ul + 8 * g + (hd >> 1)) * 16 + 8 * (hd & 1);
                vf[ul][d] = __builtin_bit_cast(long, __builtin_amdgcn_ds_read_tr8_b64_v2i32((LAS i32x2*)pa));
            }
#pragma unroll
        for (int ul = 0; ul < 2; ++ul) {
            u32x2 w;
            w.x = pk4_fp8_raw(lg[ul][0], lg[ul][1], lg[ul][2], lg[ul][3]);
            w.y = dpp_u<0x128, 0xf>(0u, w.x);
            const long pb = __builtin_bit_cast(long, w);
#pragma unroll
            for (int d = 0; d < 4; ++d) st.o[d] = __builtin_amdgcn_mfma_f32_16x16x32_fp8_fp8(vf[ul][d], pb, st.o[d], 0, 0, 0);
        }
    }
    asm volatile("s_waitcnt lgkmcnt(0)" ::: "memory");
    if (ci == nchunk - 1) {
        float l = xsum32(xsum16(st.lrun));
        l += __uint_as_float(dpp_u<0x128, 0xf>(0u, __float_as_uint(l)));
        const float inv = __builtin_amdgcn_rcpf(l);
        if (hd < 8) {
            fp8_t* op = outp + tok * (size_t)opitch + hd * 64 + 4 * g;
            const float inv8 = inv * Y8_SCALE;
#pragma unroll
            for (int d = 0; d < 4; ++d) {
                const u32x2 z = st.zz[d];
                *(unsigned*)(op + 16 * d) = pk4_fp8(st.o[d][0] * inv8 * bf_lo(z.x), st.o[d][1] * inv8 * bf_hi(z.x), st.o[d][2] * inv8 * bf_lo(z.y), st.o[d][3] * inv8 * bf_hi(z.y));
            }
        }
    }
}

template <int MODE> __device__ __forceinline__ void mixerB_unit(Ctx& C, int b, int c, fp8_t* outp, int opitch) {
    int lane = C.lane; const int wave = C.wave;
    asm volatile("" : "+v"(lane));
    LAS unsigned* listL = (LAS unsigned*)(C.lds + BF_LIST);
    LAS unsigned* cntL = (LAS unsigned*)(C.lds + BF_CNT);
    LAS float* thrL = (LAS float*)(C.lds + BF_THRF);
    LAS unsigned* histL = (LAS unsigned*)(C.lds + BF_HIST + wave * 1024);
    LAS float* t5L = (LAS float*)(C.lds + BF_T5);
    const int n = (c + 1) * 64;
    const int nround = (n + 127) >> 7;
    LAS unsigned* cntF = cntL + 64 * (nround & 1);
    const size_t tok0 = (size_t)b * SEQ + (size_t)c * 64;
    __syncthreads();
    if (C.tid < 64) { cntL[C.tid] = 0u; thrL[C.tid] = -INFINITY; }
    if (C.tid < 192) ((LAS unsigned*)(C.lds + BF_PEND))[C.tid] = 0u;
    if (C.tid < 4) ((LAS unsigned*)(C.lds + BF_PBAR))[C.tid] = 0u;
    for (int i = C.tid; i < 256; i += NWAVES * 64) t5L[i] = C.t5[i] * LOG2E;
    __syncthreads();
    if (MODE < 4) {
        const int qg4 = wave >> 1, kw = wave & 1;
        const int ql = lane & 15, g = lane >> 4;
        const int q = 16 * qg4 + ql;
        bf16x8 qf[8][2];
        const bf16_t* Qp = C.P + (tok0 + q) * PW + C_QI + 8 * g;
#pragma unroll
        for (int h = 0; h < 8; ++h)
#pragma unroll
            for (int ks = 0; ks < 2; ++ks) qf[h][ks] = *(const bf16x8*)(Qp + h * 64 + 32 * ks);
        float wv[8];
        { const f32x4 w0 = *(const f32x4*)(C.WI + (tok0 + q) * 8), w1 = *(const f32x4*)(C.WI + (tok0 + q) * 8 + 4);
          wv[0] = 0.5f * w0.x; wv[1] = 0.5f * w0.y; wv[2] = 0.5f * w0.z; wv[3] = 0.5f * w0.w; wv[4] = 0.5f * w1.x; wv[5] = 0.5f * w1.y; wv[6] = 0.5f * w1.z; wv[7] = 0.5f * w1.w; }
        bf16x8 qhi[2], qlo[2];
#pragma unroll
        for (int ks = 0; ks < 2; ++ks) {
            float acc8[8];
#pragma unroll
            for (int e = 0; e < 8; ++e) acc8[e] = 0.f;
#pragma unroll
            for (int h = 0; h < 8; ++h) {
                const u32x4 t = __builtin_bit_cast(u32x4, qf[h][ks]);
#pragma unroll
                for (int e = 0; e < 4; ++e) { acc8[2 * e] += wv[h] * bf_lo(t[e]); acc8[2 * e + 1] += wv[h] * bf_hi(t[e]); }
            }
            u32x4 hi_, lo_;
#pragma unroll
            for (int e = 0; e < 4; ++e) {
                const unsigned hp = cvtpk(acc8[2 * e], acc8[2 * e + 1]);
                hi_[e] = hp; lo_[e] = cvtpk(acc8[2 * e] - bf_lo(hp), acc8[2 * e + 1] - bf_hi(hp));
            }
            qhi[ks] = __builtin_bit_cast(bf16x8, hi_); qlo[ks] = __builtin_bit_cast(bf16x8, lo_);
        }
        const char* KIbase = (const char*)(C.KI + (size_t)b * SEQ * 64);
        const unsigned kvoff = (unsigned)(ql * 128 + 16 * g);
        LAS unsigned* lq = listL + q * BF_STRIDE;
        LAS unsigned* pendL = (LAS unsigned*)(C.lds + BF_PEND);
        int p3 = 0;
        LAS unsigned* pbar = (LAS unsigned*)(C.lds + BF_PBAR) + qg4;
        unsigned psync = 0u;
        bf16x8 kc[4][2];
#define B1_LOADKT(tt_, k0_) do { const char* Kp_ = KIbase + (size_t)((k0_) + 16 * (tt_)) * 128; kc[tt_][0] = *(const bf16x8*)(Kp_ + kvoff); kc[tt_][1] = *(const bf16x8*)(Kp_ + kvoff + 64); } while (0)
        if (64 * kw < n) {
#pragma unroll
            for (int tt = 0; tt < 4; ++tt) B1_LOADKT(tt, 64 * kw);
        }
#pragma unroll 1
        for (int r = 0; r < nround; ++r) {
            const int k0 = 128 * r + 64 * kw;
#define PAIR_SYNC() do { asm volatile("s_waitcnt lgkmcnt(0)" ::: "memory"); ++psync; \
                if (lane == 0) (void)__hip_atomic_fetch_add(pbar, 1u, __ATOMIC_RELAXED, __HIP_MEMORY_SCOPE_WORKGROUP); \
                for (unsigned sp_ = 0; sp_ < (1u << 24); ++sp_) { \
                    const unsigned pv_ = (unsigned)__builtin_amdgcn_readfirstlane((int)__hip_atomic_load(pbar, __ATOMIC_RELAXED, __HIP_MEMORY_SCOPE_WORKGROUP)); \
                    if (pv_ >= 2u * psync) break; __builtin_amdgcn_s_sleep(0); } \
                asm volatile("" ::: "memory"); } while (0)
            f32x4 sc[4];
            if (k0 < n) {
                f32x4 hacc[3];
                __builtin_amdgcn_s_setprio(2);
#pragma unroll
                for (int m = 0; m < 34; ++m) {
                    if (m < 32) {
                        const int tt = m >> 3, h = m & 7;
                        if (h == 0) {
                            f32x4 sacc = (f32x4){0.f, 0.f, 0.f, 0.f};
                            sacc = __builtin_amdgcn_mfma_f32_16x16x32_bf16(kc[tt][0], qhi[0], sacc, 0, 0, 0);
                            sacc = __builtin_amdgcn_mfma_f32_16x16x32_bf16(kc[tt][1], qhi[1], sacc, 0, 0, 0);
                            sacc = __builtin_amdgcn_mfma_f32_16x16x32_bf16(kc[tt][0], qlo[0], sacc, 0, 0, 0);
                            sacc = __builtin_amdgcn_mfma_f32_16x16x32_bf16(kc[tt][1], qlo[1], sacc, 0, 0, 0);
                            sc[tt] = sacc;
                        }
                        f32x4 a = (f32x4){0.f, 0.f, 0.f, 0.f};
                        a = __builtin_amdgcn_mfma_f32_16x16x32_bf16(kc[tt][0], qf[h][0], a, 0, 0, 0);
                        hacc[m % 3] = __builtin_amdgcn_mfma_f32_16x16x32_bf16(kc[tt][1], qf[h][1], a, 0, 0, 0);
                        if (h == 7 && k0 + 128 < n) B1_LOADKT(tt, k0 + 128);
                    }
                    __builtin_amdgcn_sched_barrier(0);
                    if (m >= 2) {
                        const int mm = m - 2, tt = mm >> 3, h = mm & 7;
#pragma unroll
                        for (int i = 0; i < 4; ++i) { sc[tt][i] = __builtin_fmaf(wv[h], __builtin_fabsf(hacc[mm % 3][i]), sc[tt][i]); asm volatile("" : "+v"(sc[tt][i])); }
                    }
                    __builtin_amdgcn_sched_barrier(0);
                }
                __builtin_amdgcn_s_setprio(0);
            }
            LAS unsigned* cur = cntL + 64 * (r & 1);
            LAS unsigned* nxt = cntL + 64 * ((r + 1) & 1);
            LAS unsigned* pendR = pendL + 64 * p3;
            LAS unsigned* pendZ = pendL + 64 * (p3 == 0 ? 2 : p3 - 1);
            p3 = (p3 == 2) ? 0 : p3 + 1;
            float thr = thrL[q];
            int np = 0;
            if (k0 < n) {
#pragma unroll
                for (int tt = 0; tt < 4; ++tt)
#pragma unroll
                    for (int i = 0; i < 4; ++i) np += (sc[tt][i] >= thr) ? 1 : 0;
            }
            unsigned base = 0u;
            if (np > 0) base = __hip_atomic_fetch_add(pendR + q, (unsigned)np, __ATOMIC_RELAXED, __HIP_MEMORY_SCOPE_WORKGROUP);
            PAIR_SYNC();
            {
                const int cmine = (int)cur[q], pmine = (int)pendR[q];
                if (g == 0) pendZ[q] = 0u;
                const unsigned pm = (unsigned)__ballot(cmine + pmine > BF_CAP) & 0xFFFFu;
                const bool mine = (pm >> ql) & 1u;
                if (kw == 0 && g == 0 && !mine) nxt[q] = (unsigned)(cmine + pmine);
                base += (unsigned)cmine;
                if (pm) {
                    unsigned pw = pm;
                    int idx = 0;
                    while (pw) {
                        const int j = __builtin_ctz(pw); pw &= pw - 1u;
                        if ((idx & 1) == kw) {
                            const int qq = 16 * qg4 + j;
                            const int cn = __builtin_amdgcn_readlane(cmine, j);
                            prune_query(listL + qq * BF_STRIDE, nxt + qq, thrL + qq, cn, lane);
                        }
                        ++idx;
                    }
                    PAIR_SYNC();
                    if (mine) {
                        thr = thrL[q];
                        np = 0;
                        if (k0 < n) {
#pragma unroll
                            for (int tt = 0; tt < 4; ++tt)
#pragma unroll
                                for (int i = 0; i < 4; ++i) np += (sc[tt][i] >= thr) ? 1 : 0;
                        }
                        if (np > 0) base = __hip_atomic_fetch_add(nxt + q, (unsigned)np, __ATOMIC_RELAXED, __HIP_MEMORY_SCOPE_WORKGROUP);
                    }
                }
            }
            if (np > 0) {
                unsigned slot = base;
#pragma unroll
                for (int tt = 0; tt < 4; ++tt) {
                    const unsigned kbi = (unsigned)(8191 - (k0 + 16 * tt + 4 * g));
#pragma unroll
                    for (int i = 0; i < 4; ++i)
                        if (sc[tt][i] >= thr) { lq[slot] = pack_key(sc[tt][i], kbi - (unsigned)i); ++slot; }
                }
            }
        }
        PAIR_SYNC();
#undef B1_LOADKT
#undef PAIR_SYNC
    }
    if (MODE >= 4) { if (C.tid < 64) cntF[C.tid] = (unsigned)(n < 256 ? n : 256); __syncthreads(); }
#pragma unroll 1
    for (int j = 0; j < 8; ++j) {
        const int qq = 8 * wave + j;
        const int cn = __builtin_amdgcn_readfirstlane((int)cntF[qq]);
        if (MODE < 2 && cn > 256) select_query(listL + qq * BF_STRIDE, cntF + qq, thrL + qq, histL, cn, true, lane);
    }
    asm volatile("s_waitcnt lgkmcnt(0)" ::: "memory");
    unsigned selp[8][4];
#pragma unroll
    for (int j = 0; j < 8; ++j) {
        const int qq = 8 * wave + j;
        const int cq = __builtin_amdgcn_readfirstlane((int)cntF[qq]);
        const u32x4 v = *(const LAS u32x4*)(listL + qq * BF_STRIDE + lane * 4);
#pragma unroll
        for (int k = 0; k < 4; ++k) {
            int id = (int)(8191u - (v[k] & 0x1FFFu));
            if (MODE == 4 || MODE >= 6) id = (lane * 4 + k) & 63;
            if (MODE == 5) id = (int)(((unsigned)(lane * 4 + k) * 2654435761u + (unsigned)qq * 40503u) >> 7) % n;
            selp[j][k] = (lane * 4 + k < cq) ? ((unsigned)id | ((unsigned)t5_bucket(id - (c * 64 + qq)) << 16)) : 0u;
        }
    }
    __syncthreads();
    LAS unsigned* selL = (LAS unsigned*)(C.lds + BF_SEL);
#pragma unroll
    for (int j = 0; j < 8; ++j) { const int qq = 8 * wave + j; *(LAS u32x4*)(selL + qq * 256 + lane * 4) = (u32x4){selp[j][0], selp[j][1], selp[j][2], selp[j][3]}; }
    __syncthreads();
    if (MODE >= 1 && MODE < 4) { if (lane < 8) outp[(tok0 + 8 * wave + lane) * (size_t)opitch + 1] = (fp8_t)selL[(8 * wave + lane) * 256 + 3]; __syncthreads(); return; }
    {
        asm volatile("" : "+v"(lane));
        LAS unsigned char* vimg = C.lds + BF_VIMG + wave * 8320;
        const fp8_t* KBb = (const fp8_t*)C.KB + (size_t)b * SEQ * 64;
        const fp8_t* VBb = (const fp8_t*)C.VB + (size_t)b * SEQ * 64;
        const int nsu = n < 256 ? n : 256, nchunk = nsu >> 6, nsteps = 8 * nchunk;
        u32x4 KA[4], KBf[4]; u32x4 VA[4], VBf[4];
        B2State st;
        int jj = 0, ci = 0, jn = 0, cnx = 0;
#define B2_ADV(j_, c_) do { if (++(c_) == nchunk) { (c_) = 0; ++(j_); } } while (0)
#define B2_STEP(Kf_, Vf_, Kn_, Vn_, more_) do { const int qq_ = 8 * wave + jj; const int ns_ = __builtin_amdgcn_readfirstlane((int)cntF[qq_]); \
        if (more_) { b2_loadK(Kn_, selL + (8 * wave + jn) * 256, cnx, KBb, lane); b2_loadV(Vn_, selL + (8 * wave + jn) * 256, cnx, VBb, lane); B2_ADV(jn, cnx); } \
        b2_step<(MODE == 6 ? 1 : MODE == 7 ? 2 : 0)>(C, st, Kf_, Vf_, selL + qq_ * 256, t5L, vimg, ci, nchunk, ns_, tok0 + qq_, c * 64 + qq_, outp, opitch, lane, jj < 7); B2_ADV(jj, ci); } while (0)
        b2_loadK(KA, selL + (8 * wave + jn) * 256, cnx, KBb, lane); b2_loadV(VA, selL + (8 * wave + jn) * 256, cnx, VBb, lane); B2_ADV(jn, cnx);
        { const int hd7_ = lane & 7, g_ = lane >> 4;
#pragma unroll
          for (int ks = 0; ks < 2; ++ks) st.qbn[ks] = *(const u32x4*)(C.P + (tok0 + 8 * wave) * PW + C_QB + hd7_ * 64 + 32 * ks + 8 * g_); }
#pragma unroll 1
        for (int s = 0; s < nsteps; s += 2) {
            B2_STEP(KA, VA, KBf, VBf, true);
            B2_STEP(KBf, VBf, KA, VA, (s + 2 < nsteps));
        }
#undef B2_ADV
#undef B2_STEP
    }
    __syncthreads();
}

#define XB_TMO      128
#define XB_XCNT(j)  (256  + 64 * (j))
#define XB_XSUB(j)  (1280 + 64 * (j))
#define XB_XGEN(j)  (2304 + 64 * (j))
#define XB_TOP      3328
#define XB_TOPGEN   3392
#define XCD_BAR_WORDS 3456
#define XB_SPIN_CAP (1u << 18)
__device__ __forceinline__ unsigned xb_ld(unsigned* p)              { return __hip_atomic_load(p, __ATOMIC_RELAXED, __HIP_MEMORY_SCOPE_AGENT); }
__device__ __forceinline__ unsigned xb_add(unsigned* p, unsigned v) { return __hip_atomic_fetch_add(p, v, __ATOMIC_RELAXED, __HIP_MEMORY_SCOPE_AGENT); }
__device__ __forceinline__ unsigned xb_xcc_id() { return (unsigned)__builtin_amdgcn_s_getreg((3 << 11) | 20) & 0xFu; }
#define XB_SPIN(cond, bar) do { unsigned _sp = 0; while (cond) { __builtin_amdgcn_s_sleep(1); \
    if ((++_sp & 255u) == 0u) { if (xb_ld(&(bar)[XB_TMO])) break; if (_sp > XB_SPIN_CAP) { atomicAdd(&(bar)[XB_TMO], 1u); break; } } } } while (0)
struct XcdBarrier { unsigned* bar; unsigned x; volatile LAS unsigned* st; };
__device__ __forceinline__ XcdBarrier xcd_barrier_post(unsigned* bar, volatile LAS unsigned* st) {
    XcdBarrier b; b.bar = bar; b.x = xb_xcc_id(); b.st = st;
    if (threadIdx.x == 0) (void)xb_add(&bar[XB_XCNT(b.x)], 1u);
    return b;
}
__device__ __forceinline__ void xcd_barrier_complete(unsigned* bar, unsigned x, unsigned& nloc, unsigned& nx) {
    const unsigned G = gridDim.x * gridDim.y * gridDim.z;
    unsigned sum, cnt, mine, sp = 0u;
    for (;;) {
        sum = 0u; cnt = 0u; mine = 0u;
#pragma unroll
        for (unsigned j = 0; j < 16; ++j) { const unsigned c = xb_ld(&bar[XB_XCNT(j)]); sum += c; cnt += (c > 0u) ? 1u : 0u; mine = (j == x) ? c : mine; }
        if (sum == G) break;
        __builtin_amdgcn_s_sleep(1);
        if ((++sp & 255u) == 0u) { if (xb_ld(&bar[XB_TMO])) break; if (sp > XB_SPIN_CAP) { atomicAdd(&bar[XB_TMO], 1u); break; } }
    }
    nloc = mine > 0u ? mine : 1u; nx = cnt > 0u ? cnt : 1u;
}
__device__ __forceinline__ void xcd_barrier(const XcdBarrier& b) {
    asm volatile("s_waitcnt vmcnt(0)" ::: "memory");
    __syncthreads();
    if (threadIdx.x == 0) {
        unsigned* bar = b.bar;
        __builtin_amdgcn_s_waitcnt(0);
        unsigned nloc = b.st[0], nx = b.st[1];
        if (nloc == 0u) { xcd_barrier_complete(bar, b.x, nloc, nx); b.st[0] = nloc; b.st[1] = nx; }
        const unsigned old = xb_add(&bar[XB_XSUB(b.x)], 1u);
        const unsigned gen = old / nloc;
        if (old + 1u == (gen + 1u) * nloc) {
            __builtin_amdgcn_fence(__ATOMIC_RELEASE, "agent");
            asm volatile("s_waitcnt vmcnt(0)" ::: "memory");
            const unsigned og = xb_add(&bar[XB_TOP], 1u);
            const unsigned tg = og / nx;
            if (og + 1u == (tg + 1u) * nx) xb_add(&bar[XB_TOPGEN], 1u);
            else XB_SPIN(xb_ld(&bar[XB_TOPGEN]) == tg, bar);
            __builtin_amdgcn_fence(__ATOMIC_ACQUIRE, "agent");
            xb_add(&bar[XB_XGEN(b.x)], 1u);
            asm volatile("s_waitcnt vmcnt(0)" ::: "memory");
        } else {
            XB_SPIN(xb_ld(&bar[XB_XGEN(b.x)]) == gen, bar);
            __builtin_amdgcn_fence(__ATOMIC_ACQUIRE, "agent");
            asm volatile("s_waitcnt vmcnt(0)" ::: "memory");
        }
    }
    __syncthreads();
}

struct Args { const float* in[9]; float* out; unsigned char* ws; int ph_lo, ph_hi; };
__global__ void __launch_bounds__(NWAVES * 64, 2) fwd_kernel(Args args) {
    extern __shared__ __attribute__((aligned(16))) unsigned char lds_raw[];
    Ctx C;
    C.lds = (LAS unsigned char*)lds_raw;
    C.tid = threadIdx.x; C.lane = C.tid & 63; C.wave = __builtin_amdgcn_readfirstlane(C.tid >> 6);
    C.G = gridDim.x; C.bid = blockIdx.x; C.dbg = 0ull;
    C.x = args.in[0]; C.norm_gain = args.in[1]; C.w_in = args.in[2]; C.a_rel = args.in[3]; C.t5 = args.in[4];
    C.w_a = args.in[5]; C.w_b = args.in[6]; C.w_o = args.in[7]; C.fgain = args.in[8]; C.out = args.out;
    unsigned char* ws = args.ws;
    C.WT1 = (bf16_t*)(ws + WS_WT1); C.WAT = (fp8_t*)(ws + WS_WAT); C.WBT = (fp8_t*)(ws + WS_WBT); C.WOT = (fp8_t*)(ws + WS_WOT);
    C.Y8 = (fp8_t*)(ws + WS_Y8); C.MG8 = (fp8_t*)(ws + WS_XN8); C.WT18 = (fp8_t*)(ws + WS_WT18); C.XN8 = (fp8_t*)(ws + WS_XN8);
    C.KB = (bf16_t*)(ws + WS_KB); C.VB = (bf16_t*)(ws + WS_VB); C.KI = (bf16_t*)(ws + WS_KI); C.XN = (bf16_t*)(ws + WS_XN); C.P = (bf16_t*)(ws + WS_P);
    C.WI = (float*)(ws + WS_WI); C.RSS = (float*)(ws + WS_RSS); C.RSX = (float*)(ws + WS_RSX);
    const int lo = args.ph_lo, hi = args.ph_hi;
#if MK_ONE_LAUNCH
    volatile LAS unsigned* MISC = (volatile LAS unsigned*)(C.lds + LDS_BYTES - 64);
    if (C.tid < 16) MISC[C.tid] = 0u;
    __syncthreads();
    const XcdBarrier xbar = xcd_barrier_post((unsigned*)(ws + WS_CTL) + 1024, MISC);
#define GRID_SYNC() xcd_barrier(xbar)
#else
#define GRID_SYNC() do {} while (0)
#endif
#ifndef PH_ENABLE
#define PH_ENABLE 63
#endif
#define IN(k) (((PH_ENABLE >> (k)) & 1) && lo <= (k) && (k) < hi)
#define BOTH(k) (IN(k) && IN((k) + 1))

    if (IN(0)) {
        p0_prologue(C); if (BOTH(0)) GRID_SYNC(); }

    if (IN(1)) {
        if ((C.bid >> 3) & 1) { __builtin_amdgcn_s_sleep(127); __builtin_amdgcn_s_sleep(127); }
        {
            pg8::Gemm g{C.XN, C.WT1, C.XN, C.WT1, 2 * DM, 2 * DM, NTOK, 768, 2 * DM, 2 * DM};
            pg8::StaticOrder S; S.init(NTOK, 768, C.G, C.bid);
            EpiProj E{C.P, C.KB, C.VB, C.KI, C.WI, 0, 1.f};
            pg8::gemm_phase<EpiProj, pg8::StaticOrder, true>(C.lds, g, S, E);
        }
        {
            pg8::Gemm g{C.XN8, C.WT18, C.XN8, C.WT18, DM, DM, NTOK, 5120, DM, DM};
            pg8::SplitOrder S; S.init(NTOK, 5120, C.G, C.bid);
            EpiProj E{C.P, C.KB, C.VB, C.KI, C.WI, 1, 1.f / W8_SCALE};
            pg8::gemm_phase<EpiProj, pg8::SplitOrder, true, true>(C.lds, g, S, E);
        }
        if (BOTH(1)) GRID_SYNC();
    }

    if (IN(2)) {
        for (int u = C.bid; u < BATCH * 64; u += C.G) { const int bb = (u & 7) >> 1, pi = (u >> 3) + 32 * (u & 1); mixerB_unit<0>(C, bb, 127 - pi, C.Y8 + 512, 1024); mixerB_unit<0>(C, bb, pi, C.Y8 + 512, 1024); }
        {
            unsigned* actr = (unsigned*)(ws + WS_CTL) + 12288;
            volatile LAS unsigned* slot = (volatile LAS unsigned*)(C.lds + LDS_BYTES - 128);
            for (int li = 0; li < 8; ++li) {
                const int x = (C.bid + li) & 7;
                for (;;) {
                    __syncthreads();
                    if (C.tid == 0) *slot = __hip_atomic_fetch_add(actr + 16 * x, 1u, __ATOMIC_RELAXED, __HIP_MEMORY_SCOPE_AGENT);
                    __syncthreads();
                    const unsigned idx = *slot;
                    if (idx >= 64u) break;
                    const int u = x + 8 * (int)idx, uu = u & 255;
                    mixerA_unit<0>(C, (uu & 7) >> 1, 64 * (uu & 1) + (uu >> 3) + 32 * (u >> 8), C.Y8, 1024);
                }
            }
            __syncthreads();
        }
        if (BOTH(2)) GRID_SYNC();
    }

    if (IN(3)) {
        pg8::Gemm g{C.Y8, C.WAT, C.Y8 + 512, C.WBT, 1024, 512, NTOK, DM, 1024, 512};
        pg8::StaticOrder S; S.init(NTOK, DM, C.G, C.bid);
        if ((C.bid >> 3) & 1) __builtin_amdgcn_s_sleep(127);
        EpiMerge E{C.P, C.MG8};
        pg8::gemm_phase<EpiMerge, pg8::StaticOrder, true, true>(C.lds, g, S, E);
        if (BOTH(3)) GRID_SYNC();
    }

    if (IN(4)) {
        pg8::Gemm g{C.MG8, C.WOT, C.MG8, C.WOT, DM, DM, NTOK, DM, DM, DM};
        pg8::StaticOrder S; S.init(NTOK, DM, C.G, C.bid);
        EpiOut E{C.XN, C.RSX, C.out, C.RSS, C.fgain, (unsigned*)(ws + WS_CTL) + 8192};
        pg8::gemm_phase<EpiOut, pg8::StaticOrder, true, true>(C.lds, g, S, E);
    }
#undef IN
#undef BOTH
}

extern "C" void kernel_launch(void* const* d_in, const int* in_sizes, int n_in, void* d_out, int out_size, void* d_ws, size_t ws_size, hipStream_t stream) {
    static int grid = 0;
    if (grid == 0) {
        if (n_in != 9 || in_sizes[0] != NTOK * DM || out_size != NTOK * DM || ws_size < WS_END) {
            fprintf(stderr, "kernel_launch: unexpected shapes (n_in %d, in0 %d, out %d, ws %zu)\n", n_in, n_in > 0 ? in_sizes[0] : -1, out_size, ws_size); grid = -1; return; }
        int dev = 0, cus = 0, per_cu = 0;
        if (hipGetDevice(&dev) != hipSuccess || hipDeviceGetAttribute(&cus, hipDeviceAttributeMultiprocessorCount, dev) != hipSuccess) { grid = -1; return; }
        if (hipFuncSetAttribute((const void*)fwd_kernel, hipFuncAttributeMaxDynamicSharedMemorySize, LDS_BYTES) != hipSuccess) { fprintf(stderr, "kernel_launch: hipFuncSetAttribute failed\n"); grid = -1; return; }
        if (hipOccupancyMaxActiveBlocksPerMultiprocessor(&per_cu, (const void*)fwd_kernel, NWAVES * 64, LDS_BYTES) != hipSuccess || per_cu < 1) { fprintf(stderr, "kernel_launch: occupancy query gives %d\n", per_cu); per_cu = 1; }
        (void)hipGetLastError();
        grid = cus;
    }
    if (grid < 0) return;
    Args a{};
    for (int i = 0; i < 9; ++i) a.in[i] = (const float*)d_in[i];
    a.out = (float*)d_out; a.ws = (unsigned char*)d_ws;
#if MK_ONE_LAUNCH
    a.ph_lo = 0; a.ph_hi = 5;
    if (hipMemsetAsync((char*)d_ws + WS_CTL, 0, 65536, stream) != hipSuccess) { fprintf(stderr, "kernel_launch: hipMemsetAsync failed\n"); return; }
    hipLaunchKernelGGL(fwd_kernel, dim3(grid), dim3(NWAVES * 64), LDS_BYTES, stream, a);
#else
    for (int ph = 0; ph < 5; ++ph) {
        a.ph_lo = ph; a.ph_hi = ph + 1;
        hipLaunchKernelGGL(fwd_kernel, dim3(grid), dim3(NWAVES * 64), LDS_BYTES, stream, a);
    }
#endif
}
```

```cpp
#include <hip/hip_runtime.h>
#include <cstdio>
#include <cstdint>

#ifndef MK_ONE_LAUNCH
#define MK_ONE_LAUNCH 1
#endif


#define LAS __attribute__((address_space(3)))
typedef unsigned short bf16_t;
typedef short bf16x8 __attribute__((ext_vector_type(8)));
typedef short s16x4 __attribute__((ext_vector_type(4)));
typedef float f32x4 __attribute__((ext_vector_type(4)));
typedef float f32x2 __attribute__((ext_vector_type(2)));
typedef int i32x4 __attribute__((ext_vector_type(4)));
typedef int i32x2 __attribute__((ext_vector_type(2)));
typedef float f32x16 __attribute__((ext_vector_type(16)));
typedef unsigned u32x4 __attribute__((ext_vector_type(4)));
typedef unsigned u32x2 __attribute__((ext_vector_type(2)));
typedef __bf16 bf16x2_t __attribute__((ext_vector_type(2)));

constexpr int BATCH = 4, SEQ = 8192, DM = 1024, NTOK = BATCH * SEQ;
constexpr int IN_COLS = 5832;
constexpr int PW = 5632;
constexpr int NW1 = 5888;
constexpr int C_QA = 0, C_KA = 512, C_VA = 1024, C_ZA = 1536, C_QB = 2048, C_ZB = 2560, C_QI = 3072, C_GA = 3584, C_GB = 4608;
constexpr float LOG2E = 1.4426950408889634f;
constexpr float QSC = 0.125f * LOG2E;
constexpr float IDX_SCALE = 0.04419417382415922f;
constexpr float EPS = 1e-6f;

constexpr size_t MiB = 1u << 20;
constexpr size_t WS_CTL = 0;
constexpr size_t WS_WT1 = 2 * MiB;
constexpr size_t WS_WT18 = 4 * MiB;
constexpr size_t WS_WAT = 14 * MiB;
constexpr size_t WS_WBT = 15 * MiB;
constexpr size_t WS_WOT = 16 * MiB;
constexpr size_t WS_KB = 18 * MiB;
constexpr size_t WS_VB = 22 * MiB;
constexpr size_t WS_KI = 26 * MiB;
constexpr size_t WS_WI = 30 * MiB;
constexpr size_t WS_RSS = 31 * MiB;
constexpr size_t WS_RSX = 31 * MiB + 512 * 1024;
constexpr size_t WS_XN = 32 * MiB;
constexpr size_t WS_P = 96 * MiB;
constexpr size_t WS_Y8 = 448 * MiB;
constexpr size_t WS_XN8 = 480 * MiB;
constexpr size_t WS_END = 512 * MiB;

constexpr int NWAVES = 8;
constexpr int LDS_BYTES = 163840;

__device__ __forceinline__ unsigned cvtpk(float lo, float hi) { f32x2 v = {lo, hi}; bf16x2_t b = __builtin_convertvector(v, bf16x2_t); return __builtin_bit_cast(unsigned, b); }
__device__ __forceinline__ float bf_lo(unsigned u) { return __uint_as_float(u << 16); }
__device__ __forceinline__ float bf_hi(unsigned u) { return __uint_as_float(u & 0xffff0000u); }
__device__ __forceinline__ float bf2f(bf16_t b) { return __uint_as_float((unsigned)b << 16); }
__device__ __forceinline__ bf16_t f2bf(float f) { return (bf16_t)(cvtpk(f, 0.f) & 0xffffu); }
__device__ __forceinline__ float fast_sigmoid(float x) { return __builtin_amdgcn_rcpf(1.f + __builtin_amdgcn_exp2f(-x * LOG2E)); }
typedef int i32x8 __attribute__((ext_vector_type(8)));
typedef unsigned char fp8_t;
constexpr float Y8_SCALE = 64.f, W8_SCALE = 32.f;
constexpr float ACC8_UNSCALE = 1.f / (64.f * 32.f);
__device__ __forceinline__ unsigned pk4_fp8_raw(float a, float b, float c, float d) { int p = __builtin_amdgcn_cvt_pk_fp8_f32(a, b, 0, false); p = __builtin_amdgcn_cvt_pk_fp8_f32(c, d, p, true); return (unsigned)p; }
__device__ __forceinline__ float sat8(float x) { return __builtin_amdgcn_fmed3f(x, -448.f, 448.f); }
__device__ __forceinline__ unsigned pk4_fp8(float a, float b, float c, float d) { return pk4_fp8_raw(sat8(a), sat8(b), sat8(c), sat8(d)); }
__device__ __forceinline__ float wave_sum(float v) {
#pragma unroll
    for (int o = 32; o >= 1; o >>= 1) v += __shfl_xor(v, o);
    return v;
}
__device__ __forceinline__ float wave_max(float v) {
#pragma unroll
    for (int o = 32; o >= 1; o >>= 1) v = fmaxf(v, __shfl_xor(v, o));
    return v;
}
__device__ __forceinline__ int wave_sum_i(int v) {
#pragma unroll
    for (int o = 32; o >= 1; o >>= 1) v += __shfl_xor(v, o);
    return v;
}
__device__ __forceinline__ float xmax16(float m) { auto r = __builtin_amdgcn_permlane16_swap(__float_as_uint(m), __float_as_uint(m), false, false); return fmaxf(__uint_as_float(r[0]), __uint_as_float(r[1])); }
__device__ __forceinline__ float xmax32(float m) { auto r = __builtin_amdgcn_permlane32_swap(__float_as_uint(m), __float_as_uint(m), false, false); return fmaxf(__uint_as_float(r[0]), __uint_as_float(r[1])); }
__device__ __forceinline__ float xsum16(float m) { auto r = __builtin_amdgcn_permlane16_swap(__float_as_uint(m), __float_as_uint(m), false, false); return __uint_as_float(r[0]) + __uint_as_float(r[1]); }
__device__ __forceinline__ float xsum32(float m) { auto r = __builtin_amdgcn_permlane32_swap(__float_as_uint(m), __float_as_uint(m), false, false); return __uint_as_float(r[0]) + __uint_as_float(r[1]); }
template <int CTRL, int ROWMASK> __device__ __forceinline__ unsigned dpp_u(unsigned old, unsigned src) { return (unsigned)__builtin_amdgcn_update_dpp((int)old, (int)src, CTRL, ROWMASK, 0xf, false); }
__device__ __forceinline__ int crow(int r, int hi) { return (r & 3) + 8 * (r >> 2) + 4 * hi; }

namespace pg8 {
constexpr int BM = 256, BK = 64, HALF = 128, HTB = HALF * BK * 2, STAGE_BYTES = 8 * HTB, NXCD = 8, WGM = 8;
__host__ __device__ __forceinline__ int lds_byte(int r, int c) { const int st = (r >> 4) * 2 + (c >> 5), rr = r & 15, cc = c & 31, ob = rr * 64 + cc * 2; return st * 1024 + (ob ^ (((ob >> 9) & 1) << 5)); }
__host__ __device__ __forceinline__ void stage_rc(int b, int& R, int& C) { const int st = b / 1024, sb = b % 1024, swz = sb ^ (((sb >> 9) & 1) << 5); R = (st >> 1) * 16 + swz / 64; C = (st & 1) * 32 + (swz % 64) / 2; }
__host__ __device__ __forceinline__ int perm32(int rho) { const int n = rho >> 4, i = rho & 15; return 8 * (i >> 2) + 4 * n + (i & 3); }

struct Unit { int pm, pn; };
struct Gemm { const void* A; const void* Bt; const void* A2; const void* Bt2; int lda, ldb, M, N, K, K1; };

struct StaticOrder {
    int nM, nN, nwg, G, c;
    __host__ __device__ __forceinline__ void init(int M, int N, int G_, int c_) { nM = M / BM; nN = N / BM; nwg = nM * nN; G = G_; c = c_; }
    __host__ __device__ __forceinline__ bool next(int i, Unit& u) const { const long L = (long)i * G + c; if (L >= nwg) return false; map((int)L, u); return true; }
    __host__ __device__ __forceinline__ void map(int L, Unit& u) const {
        int wgid = L; { const int q = nwg / NXCD, r = nwg % NXCD, xcd = wgid % NXCD, off = wgid / NXCD; wgid = (xcd < r ? xcd * (q + 1) : r * (q + 1) + (xcd - r) * q) + off; }
        const int nig = WGM * nN, gid = wgid / nig, fm = gid * WGM, gsz = (nM - fm) < WGM ? (nM - fm) : WGM;
        u.pm = fm + ((wgid % nig) % gsz); u.pn = (wgid % nig) / gsz;
    }
};
struct SplitOrder {
    StaticOrder so;
    __host__ __device__ __forceinline__ void init(int M, int N, int G_, int c_) { so.init(M, N, G_, c_); }
    __host__ __device__ __forceinline__ bool next(int i, Unit& u) const {
        if (so.G != 256 || so.nwg != 2560) return so.next(i, u);
        int L;
        if (i < 9) L = i * 256 + so.c;
        else if (so.c >= 128 && i < 11) L = 2304 + (i - 9) * 128 + (so.c - 128);
        else return false;
        so.map(L, u); return true;
    }
};

template <class Epi, class Sched, bool ALIGN_EPI, bool FP8 = false>
__device__ __forceinline__ void gemm_phase(LAS unsigned char* lds, const Gemm g, const Sched& S, const Epi& E) {
    const int tid = threadIdx.x, wid = __builtin_amdgcn_readfirstlane(tid >> 6), lane = tid & 63, wr = wid >> 2, wc = wid & 3, fr = lane & 15, fq = lane >> 4;
    const int nt = g.K / (2 * BK), nt1 = g.K1 / (2 * BK);
    unsigned voffA[2], voffB[2];
#pragma unroll
    for (int i = 0; i < 2; ++i) { int R, C; stage_rc(tid * 16 + i * 8192, R, C); const int Rb = Epi::PERM ? ((R & ~31) + perm32(R & 31)) : R;
        voffA[i] = (unsigned)(R * g.lda + 2 * C); voffB[i] = (unsigned)(Rb * g.ldb + 2 * C); }
    const size_t kstep = (size_t)(BK * 2);
    const size_t hstepA = (size_t)HALF * g.lda, hstepB = (size_t)HALF * g.ldb;
    const size_t tstepA = 2 * hstepA, tstepB = 2 * hstepB;
    const unsigned ldsw = (unsigned)wid * 1024u;
    const int aoff = lds_byte(wr * 64 + fr, fq * 8), boff = lds_byte(wc * 32 + fr, fq * 8);
#define PG8_SA(b, h) (((b) * 2 + (h)) * HTB)
#define PG8_SB(b, h) ((4 + (b) * 2 + (h)) * HTB)
#define PG8_STAGE(bufoff, gbase, voff) do { _Pragma("unroll") for (int _i = 0; _i < 2; ++_i) \
        __builtin_amdgcn_global_load_lds((const unsigned*)((const char*)(gbase) + (voff)[_i]), (LAS unsigned*)(lds + (bufoff) + ldsw + _i * 8192), 16, 0, 0); } while (0)
#define PG8_LD8(addr_) __builtin_shufflevector(*(const LAS i32x4*)(addr_), *(const LAS i32x4*)((addr_) + 1024), 0, 1, 2, 3, 4, 5, 6, 7)
#define PG8_LDA(dst, b, h) do { _Pragma("unroll") for (int m = 0; m < 4; ++m) dst[m] = PG8_LD8(lds + PG8_SA(b, h) + aoff + m * 2048); } while (0)
#define PG8_LDB(dst, b, h) do { _Pragma("unroll") for (int n = 0; n < 2; ++n) dst[n] = PG8_LD8(lds + PG8_SB(b, h) + boff + n * 2048); } while (0)
#define PG8_LO(x_) __builtin_bit_cast(bf16x8, __builtin_shufflevector((x_), (x_), 0, 1, 2, 3))
#define PG8_HI(x_) __builtin_bit_cast(bf16x8, __builtin_shufflevector((x_), (x_), 4, 5, 6, 7))
#define PG8_MMA(ai, bj, At, Bt) do { __builtin_amdgcn_s_setprio(1); \
        if constexpr (FP8) { asm volatile("s_nop 1"); _Pragma("unroll") for (int m = 0; m < 4; ++m) _Pragma("unroll") for (int n = 0; n < 2; ++n) \
            asm volatile("v_mfma_f32_16x16x128_f8f6f4 %0, %1, %2, %0" : "+v"(acc[ai][bj][m][n]) : "v"(Bt[n]), "v"(At[m])); }   \
        else { _Pragma("unroll") for (int m = 0; m < 4; ++m) _Pragma("unroll") for (int n = 0; n < 2; ++n) { \
            acc[ai][bj][m][n] = __builtin_amdgcn_mfma_f32_16x16x32_bf16(PG8_LO(Bt[n]), PG8_LO(At[m]), acc[ai][bj][m][n], 0, 0, 0); \
            acc[ai][bj][m][n] = __builtin_amdgcn_mfma_f32_16x16x32_bf16(PG8_HI(Bt[n]), PG8_HI(At[m]), acc[ai][bj][m][n], 0, 0, 0); } } \
        __builtin_amdgcn_s_setprio(0); } while (0)
#define PG8_WAIT_V(n) asm volatile("s_waitcnt vmcnt(" #n ")" ::: "memory")
#define PG8_WAIT_L(n) asm volatile("s_waitcnt lgkmcnt(" #n ")" ::: "memory")
#define PG8_BAR __builtin_amdgcn_s_barrier()
#define PG8_SCHED __builtin_amdgcn_sched_barrier(0)
#define PG8_KT(b1, b2, t) ((t) < nt1 ? (b1) + (size_t)(t) * kstep : (b2) + (size_t)((t) - nt1) * kstep)
    Unit cur, nxt; int ui = 0;
    if (!S.next(0, cur)) return;
    f32x4 acc[2][2][4][2];
#pragma unroll
    for (int a = 0; a < 2; ++a)
#pragma unroll
        for (int b = 0; b < 2; ++b)
#pragma unroll
            for (int m = 0; m < 4; ++m)
#pragma unroll
                for (int n = 0; n < 2; ++n) acc[a][b][m][n] = (f32x4){0.f, 0.f, 0.f, 0.f};
    i32x8 At[4], B0[2], B1[2];
    const char* cA = (const char*)g.A + (size_t)cur.pm * tstepA; const char* cB = (const char*)g.Bt + (size_t)cur.pn * tstepB;
    const char* cA2 = (const char*)g.A2 + (size_t)cur.pm * tstepA; const char* cB2 = (const char*)g.Bt2 + (size_t)cur.pn * tstepB;
    PG8_STAGE(PG8_SB(0, 0), cB, voffB); PG8_STAGE(PG8_SB(0, 1), cB + hstepB, voffB); PG8_STAGE(PG8_SA(0, 0), cA, voffA); PG8_STAGE(PG8_SA(0, 1), cA + hstepA, voffA);
    if (wr == 1) PG8_BAR;
    PG8_WAIT_V(2); PG8_BAR;
    PG8_STAGE(PG8_SB(1, 0), cB + kstep, voffB); PG8_STAGE(PG8_SA(1, 0), cA + kstep, voffA); PG8_STAGE(PG8_SB(1, 1), cB + hstepB + kstep, voffB);
    PG8_WAIT_V(6); PG8_BAR;
    for (;;) {
        const bool has_next = S.next(ui + 1, nxt);
        const char* nA = has_next ? (const char*)g.A + (size_t)nxt.pm * tstepA : cA; const char* nB = has_next ? (const char*)g.Bt + (size_t)nxt.pn * tstepB : cB;
        for (int seg = 0; seg < 2; ++seg) {
        const int tb = seg ? nt1 : 0, te = seg ? nt : nt1;
        if (seg && tb < te) { PG8_SCHED; if constexpr (FP8) asm volatile("s_nop 15\n\ts_nop 15" ::: "memory"); E.mid(acc, cur, wr, wc, fr, fq); PG8_SCHED; }
        for (int t = tb; t < te; t += 2) {
            const bool last = (t == nt - 2);
            const char* a1 = PG8_KT(cA, cA2, t + 1);
            const char* a2 = last ? nA : PG8_KT(cA, cA2, t + 2); const char* b2 = last ? nB : PG8_KT(cB, cB2, t + 2);
            const char* a3 = a2 + kstep; const char* b3 = b2 + kstep;
            PG8_LDB(B0, 0, 0); PG8_LDB(B1, 0, 1); PG8_SCHED; PG8_LDA(At, 0, 0); PG8_STAGE(PG8_SA(1, 1), a1 + hstepA, voffA);
            PG8_WAIT_V(8); PG8_WAIT_L(0); PG8_BAR; PG8_MMA(0, 0, At, B0); PG8_MMA(0, 1, At, B1); PG8_BAR; PG8_SCHED;
            PG8_LDA(At, 0, 1); PG8_STAGE(PG8_SB(0, 0), b2, voffB); PG8_STAGE(PG8_SB(0, 1), b2 + hstepB, voffB); PG8_STAGE(PG8_SA(0, 0), a2, voffA);
            PG8_WAIT_V(8); PG8_WAIT_L(0); PG8_BAR; PG8_MMA(1, 0, At, B0); PG8_MMA(1, 1, At, B1); PG8_BAR; PG8_SCHED;
            PG8_LDB(B0, 1, 0); PG8_LDB(B1, 1, 1); PG8_SCHED; PG8_LDA(At, 1, 0); PG8_STAGE(PG8_SA(0, 1), a2 + hstepA, voffA);
            PG8_WAIT_V(8); PG8_WAIT_L(0); PG8_BAR; PG8_MMA(0, 0, At, B0); PG8_MMA(0, 1, At, B1); PG8_BAR; PG8_SCHED;
            PG8_LDA(At, 1, 1); PG8_STAGE(PG8_SB(1, 0), b3, voffB); PG8_STAGE(PG8_SB(1, 1), b3 + hstepB, voffB); PG8_STAGE(PG8_SA(1, 0), a3, voffA);
            PG8_WAIT_V(8); PG8_WAIT_L(0); PG8_BAR; PG8_MMA(1, 0, At, B0); PG8_MMA(1, 1, At, B1); PG8_BAR; PG8_SCHED;
        }
        }
        if constexpr (ALIGN_EPI) { if (wr == 0) PG8_BAR; }
        if constexpr (FP8) asm volatile("s_nop 15\n\ts_nop 15" ::: "memory");
        E(acc, cur, wr, wc, fr, fq);
        if (!has_next) break;
#pragma unroll
        for (int a = 0; a < 2; ++a)
#pragma unroll
            for (int b = 0; b < 2; ++b)
#pragma unroll
                for (int m = 0; m < 4; ++m)
#pragma unroll
                    for (int n = 0; n < 2; ++n) { float z_ = 0.f; asm volatile("" : "+v"(z_)); acc[a][b][m][n] = (f32x4){z_, z_, z_, z_}; }
        cur = nxt; cA = nA; cB = nB; ++ui;
        cA2 = (const char*)g.A2 + (size_t)cur.pm * tstepA; cB2 = (const char*)g.Bt2 + (size_t)cur.pn * tstepB;
        if constexpr (ALIGN_EPI) { if (wr == 1) PG8_BAR; }
    }
    PG8_WAIT_V(0);
    if constexpr (!ALIGN_EPI) { if (wr == 0) PG8_BAR; }
    PG8_BAR;
#undef PG8_SA
#undef PG8_SB
#undef PG8_STAGE
#undef PG8_LDA
#undef PG8_LDB
#undef PG8_MMA
#undef PG8_LD8
#undef PG8_LO
#undef PG8_HI
#undef PG8_WAIT_V
#undef PG8_WAIT_L
#undef PG8_BAR
#undef PG8_SCHED
#undef PG8_KT
}
}

struct EpiProj {
    static constexpr bool PERM = true;
    bf16_t* P; bf16_t* KB; bf16_t* VB; bf16_t* KI; float* WI; int part; float ascale;
    __device__ __forceinline__ void mid(f32x4 (&)[2][2][4][2], const pg8::Unit&, int, int, int, int) const {}
    __device__ __forceinline__ void operator()(const f32x4 (&acc)[2][2][4][2], const pg8::Unit& u, int wr, int wc, int fr, int fq) const {
        const int row0 = u.pm * 256 + wr * 64 + fr;
        const int pn = part ? (u.pn < 12 ? u.pn : u.pn + 2) : (u.pn < 2 ? 12 + u.pn : 22);
        if (pn < 22) {
            int mode = 0; float sc = ascale;
            if (pn < 2 || pn == 8 || pn == 9) sc = QSC * ascale;
            else if (pn == 6 || pn == 7 || pn == 10 || pn == 11) mode = 1;
            else if (pn >= 14) mode = 2;
            const int col0 = pn * 256 + wc * 32 + 8 * fq;
            const float c2 = -sc * LOG2E;
#define EPI_BODY(EXPR_) do { _Pragma("unroll") for (int ai = 0; ai < 2; ++ai) _Pragma("unroll") for (int m = 0; m < 4; ++m) { \
                bf16_t* rowp = P + (size_t)(row0 + ai * 128 + m * 16) * PW + col0; \
                _Pragma("unroll") for (int bj = 0; bj < 2; ++bj) { float v[8]; \
                    _Pragma("unroll") for (int e = 0; e < 4; ++e) { v[e] = acc[ai][bj][m][0][e]; v[4 + e] = acc[ai][bj][m][1][e]; } \
                    _Pragma("unroll") for (int e = 0; e < 8; ++e) { float x = v[e]; EXPR_; asm("" : "+v"(x)); v[e] = x; } \
                    u32x4 w; w.x = cvtpk(v[0], v[1]); w.y = cvtpk(v[2], v[3]); w.z = cvtpk(v[4], v[5]); w.w = cvtpk(v[6], v[7]); \
                    *(u32x4*)(rowp + bj * 128) = w; } } } while (0)
            if (mode == 0) EPI_BODY(x = x * sc);
            else if (mode == 1) EPI_BODY({ float e_ = __builtin_amdgcn_exp2f(x * c2); asm("" : "+v"(e_)); e_ = __builtin_amdgcn_rcpf(1.f + e_); asm("" : "+v"(e_)); x = x * sc; asm("" : "+v"(x)); x = x * e_; });
            else EPI_BODY({ float e_ = __builtin_amdgcn_exp2f(x * c2); asm("" : "+v"(e_)); x = __builtin_amdgcn_rcpf(1.f + e_); });
#undef EPI_BODY
        } else {
#pragma unroll
            for (int ai = 0; ai < 2; ++ai)
#pragma unroll
                for (int m = 0; m < 4; ++m) {
                    const size_t row = (size_t)(row0 + ai * 128 + m * 16);
                    {
                        const f32x4 a = acc[ai][0][m][0], b = acc[ai][0][m][1];
                        u32x4 w; w.x = cvtpk(a[0], a[1]); w.y = cvtpk(a[2], a[3]); w.z = cvtpk(b[0], b[1]); w.w = cvtpk(b[2], b[3]);
                        if (wc < 2) {
                            u32x2 w8; w8.x = pk4_fp8(a[0], a[1], a[2], a[3]); w8.y = pk4_fp8(b[0], b[1], b[2], b[3]);
                            *(u32x2*)((fp8_t*)KB + row * 64 + fq * 16 + wc * 8) = w8;
                        } else {
                            u32x2 w8; w8.x = pk4_fp8(a[0], a[1], a[2], a[3]); w8.y = pk4_fp8(b[0], b[1], b[2], b[3]);
                            *(u32x2*)((fp8_t*)VB + row * 64 + (wc - 2) * 32 + 8 * fq) = w8;
                        }
                    }
                    {
                        const f32x4 a = acc[ai][1][m][0], b = acc[ai][1][m][1];
                        if (wc < 2) {
                            u32x4 w; w.x = cvtpk(a[0], a[1]); w.y = cvtpk(a[2], a[3]); w.z = cvtpk(b[0], b[1]); w.w = cvtpk(b[2], b[3]);
                            *(u32x4*)(KI + row * 64 + wc * 32 + 8 * fq) = w;
                        } else if (wc == 2 && fq == 0) {
                            *(f32x4*)(WI + row * 8) = a * IDX_SCALE; *(f32x4*)(WI + row * 8 + 4) = b * IDX_SCALE;
                        }
                    }
                }
        }
    }
};

__device__ __forceinline__ u32x4 buf_load16(__amdgpu_buffer_rsrc_t r, unsigned voff, unsigned soff) { return __builtin_bit_cast(u32x4, __builtin_amdgcn_raw_buffer_load_b128(r, (int)voff, (int)soff, 0)); }
__device__ __forceinline__ void buf_store16(__amdgpu_buffer_rsrc_t r, unsigned voff, unsigned soff, u32x4 v) { __builtin_amdgcn_raw_buffer_store_b128(v, r, (int)voff, (int)soff, 0); }
struct EpiMerge {
    static constexpr bool PERM = true;
    const bf16_t* P; fp8_t* MG;
    __device__ __forceinline__ void mid(f32x4 (&acc)[2][2][4][2], const pg8::Unit& u, int wr, int wc, int fr, int fq) const {
        { int l_ = (int)(threadIdx.x & 63u); asm volatile("" : "+v"(l_)); fr = l_ & 15; fq = l_ >> 4; }
        const __amdgpu_buffer_rsrc_t rp = __builtin_amdgcn_make_buffer_rsrc((void*)P, (short)0, (int)((size_t)NTOK * PW * 2), 0x00020000);
        const unsigned voff = (unsigned)(fr * PW + 8 * fq) * 2u;
#pragma unroll
        for (int ai = 0; ai < 2; ++ai) {
            u32x4 sa[4][2], sb[4][2];
#pragma unroll
            for (int m = 0; m < 4; ++m) {
                const unsigned soff = ((unsigned)(u.pm * 256 + wr * 64 + ai * 128 + m * 16) * (unsigned)PW + (unsigned)(u.pn * 256 + wc * 32)) * 2u;
#pragma unroll
                for (int bj = 0; bj < 2; ++bj) { sa[m][bj] = buf_load16(rp, voff, soff + (C_GA + bj * 128) * 2); sb[m][bj] = buf_load16(rp, voff, soff + (C_GB + bj * 128) * 2); }
            }
#pragma unroll
            for (int m = 0; m < 4; ++m)
#pragma unroll
                for (int bj = 0; bj < 2; ++bj)
#pragma unroll
                    for (int e = 0; e < 4; ++e) {
                        const float r0 = bf_lo(sa[m][bj][e]) * __builtin_amdgcn_rcpf(bf_lo(sb[m][bj][e])), r1 = bf_hi(sa[m][bj][e]) * __builtin_amdgcn_rcpf(bf_hi(sb[m][bj][e]));
                        acc[ai][bj][m][e >> 1][(e & 1) * 2] *= r0; acc[ai][bj][m][e >> 1][(e & 1) * 2 + 1] *= r1;
                    }
            asm volatile("" ::: "memory");
        }
    }
    __device__ __forceinline__ void operator()(const f32x4 (&acc)[2][2][4][2], const pg8::Unit& u, int wr, int wc, int fr, int fq) const {
        { int l_ = (int)(threadIdx.x & 63u); asm volatile("" : "+v"(l_)); fr = l_ & 15; fq = l_ >> 4; }
        const __amdgpu_buffer_rsrc_t rp = __builtin_amdgcn_make_buffer_rsrc((void*)P, (short)0, (int)((size_t)NTOK * PW * 2), 0x00020000);
        const __amdgpu_buffer_rsrc_t ro = __builtin_amdgcn_make_buffer_rsrc((void*)MG, (short)0, (int)((size_t)NTOK * DM), 0x00020000);
        const unsigned voff = (unsigned)(fr * PW + 8 * fq) * 2u, voffo = (unsigned)(fr * DM + 8 * fq);
        constexpr float c8 = Y8_SCALE * ACC8_UNSCALE;
#pragma unroll
        for (int ai = 0; ai < 2; ++ai) {
            u32x4 sb[4][2];
#pragma unroll
            for (int m = 0; m < 4; ++m) {
                const unsigned soff = ((unsigned)(u.pm * 256 + wr * 64 + ai * 128 + m * 16) * (unsigned)PW + (unsigned)(u.pn * 256 + wc * 32)) * 2u;
#pragma unroll
                for (int bj = 0; bj < 2; ++bj) sb[m][bj] = buf_load16(rp, voff, soff + (C_GB + bj * 128) * 2);
            }
#pragma unroll
            for (int m = 0; m < 4; ++m) {
                const unsigned soffo = (unsigned)(u.pm * 256 + wr * 64 + ai * 128 + m * 16) * (unsigned)DM + (unsigned)(u.pn * 256 + wc * 32);
#pragma unroll
                for (int bj = 0; bj < 2; ++bj) {
                    const f32x4 a = acc[ai][bj][m][0], b = acc[ai][bj][m][1];
                    const u32x4 g = sb[m][bj];
                    u32x2 w;
                    w.x = pk4_fp8(a[0] * bf_lo(g.x) * c8, a[1] * bf_hi(g.x) * c8, a[2] * bf_lo(g.y) * c8, a[3] * bf_hi(g.y) * c8);
                    w.y = pk4_fp8(b[0] * bf_lo(g.z) * c8, b[1] * bf_hi(g.z) * c8, b[2] * bf_lo(g.w) * c8, b[3] * bf_hi(g.w) * c8);
                    __builtin_amdgcn_raw_buffer_store_b64(w, ro, (int)voffo, (int)(soffo + bj * 128), 0);
                }
            }
            asm volatile("" ::: "memory");
        }
    }
};

struct EpiOut {
    static constexpr bool PERM = false;
    const bf16_t* XN; const float* RSX; float* O; float* RSS; const float* G; unsigned* CNT;
    __device__ __forceinline__ void mid(f32x4 (&)[2][2][4][2], const pg8::Unit&, int, int, int, int) const {}
    __device__ __forceinline__ void operator()(f32x4 (&acc)[2][2][4][2], const pg8::Unit& u, int wr, int wc, int fr, int fq) const {
        { int l_ = (int)(threadIdx.x & 63u); asm volatile("" : "+v"(l_)); fr = l_ & 15; fq = l_ >> 4; }
        const int col0 = u.pn * 256 + wc * 32 + 4 * fq;
#pragma unroll
        for (int ai = 0; ai < 2; ++ai) {
            u32x2 xv[4][2][2]; float rx[4];
#pragma unroll
            for (int m = 0; m < 4; ++m) {
                const int row = u.pm * 256 + ai * 128 + wr * 64 + m * 16 + fr;
                const size_t off = (size_t)row * DM + col0;
                rx[m] = RSX[row];
#pragma unroll
                for (int bj = 0; bj < 2; ++bj)
#pragma unroll
                    for (int n = 0; n < 2; ++n) xv[m][bj][n] = *(const u32x2*)(XN + off + bj * 128 + n * 16);
            }
#pragma unroll
            for (int m = 0; m < 4; ++m) {
                const int row = u.pm * 256 + ai * 128 + wr * 64 + m * 16 + fr;
                float ss = 0.f;
#pragma unroll
                for (int bj = 0; bj < 2; ++bj)
#pragma unroll
                    for (int n = 0; n < 2; ++n) {
                        const u32x2 xb = xv[m][bj][n];
                        const f32x4 hv = (f32x4){bf_lo(xb.x), bf_hi(xb.x), bf_lo(xb.y), bf_hi(xb.y)} * rx[m] + acc[ai][bj][m][n] * ACC8_UNSCALE;
                        ss += (hv[0] * hv[0] + hv[1] * hv[1]) + (hv[2] * hv[2] + hv[3] * hv[3]);
                        acc[ai][bj][m][n] = hv;
                    }
                ss += __shfl_xor(ss, 16); ss += __shfl_xor(ss, 32);
                if (fq == 0) atomicAdd(RSS + row, ss);
            }
            asm volatile("" ::: "memory");
        }
        asm volatile("s_waitcnt vmcnt(0)" ::: "memory");
        unsigned* cnt = CNT + 16 * u.pm;
        if ((threadIdx.x & 63) == 0) (void)__hip_atomic_fetch_add(cnt, 1u, __ATOMIC_RELAXED, __HIP_MEMORY_SCOPE_AGENT);
        for (unsigned sp = 0; sp < (1u << 22); ++sp) {
            const unsigned c = (unsigned)__builtin_amdgcn_readfirstlane((int)__hip_atomic_load(cnt, __ATOMIC_RELAXED, __HIP_MEMORY_SCOPE_AGENT));
            if (c >= 32u) break;
            __builtin_amdgcn_s_sleep(1);
        }
        float tot[2][4];
#pragma unroll
        for (int ai = 0; ai < 2; ++ai)
#pragma unroll
            for (int m = 0; m < 4; ++m) {
                const int row = u.pm * 256 + ai * 128 + wr * 64 + m * 16 + fr;
                tot[ai][m] = 0.f;
                if (fq == 0) tot[ai][m] = __hip_atomic_fetch_add(RSS + row, 0.f, __ATOMIC_RELAXED, __HIP_MEMORY_SCOPE_AGENT);
            }
        f32x4 gg[2][2];
#pragma unroll
        for (int bj = 0; bj < 2; ++bj)
#pragma unroll
            for (int n = 0; n < 2; ++n) gg[bj][n] = *(const f32x4*)(G + col0 + bj * 128 + n * 16);
#pragma unroll
        for (int ai = 0; ai < 2; ++ai)
#pragma unroll
            for (int m = 0; m < 4; ++m) {
                const int row = u.pm * 256 + ai * 128 + wr * 64 + m * 16 + fr;
                const size_t off = (size_t)row * DM + col0;
                const float t = __shfl(tot[ai][m], fr);
                const float rs = __builtin_amdgcn_rsqf(t * (1.f / DM) + EPS);
#pragma unroll
                for (int bj = 0; bj < 2; ++bj)
#pragma unroll
                    for (int n = 0; n < 2; ++n) *(f32x4*)(O + off + bj * 128 + n * 16) = acc[ai][bj][m][n] * rs * gg[bj][n];
            }
    }
};

struct Ctx {
    LAS unsigned char* lds;
    int tid, lane, wave, G, bid;
    const float *x, *norm_gain, *w_in, *a_rel, *t5, *w_a, *w_b, *w_o, *fgain;
    float* out;
    bf16_t *WT1, *KB, *VB, *KI, *XN, *P;
    fp8_t *WAT, *WBT, *WOT, *Y8, *MG8, *WT18, *XN8;
    float *WI, *RSS, *RSX;
    unsigned long long dbg;
};

__device__ __forceinline__ int proj_src_col(int d0, int& nvalid) {
    nvalid = 32;
    if (d0 < 2560) return d0;
    if (d0 < 3072) return d0 - 2560 + 2688;
    if (d0 < 3584) return d0 - 3072 + 3200;
    if (d0 < 5632) return d0 - 3584 + 3784;
    if (d0 < 5760) return d0 - 5632 + 2560;
    if (d0 < 5824) return d0 - 5760 + 3712;
    if (d0 == 5824) { nvalid = 8; return 3776; }
    nvalid = 0; return 0;
}
__device__ __forceinline__ void transpose_item(const float* W, int ldw, int src_n0, int nvalid, const float* gain, bf16_t* WT, int K, int dst_row0, int k0, LAS float* scr, int lane) {
#pragma unroll 8
    for (int i = 0; i < 32; ++i) {
        const int kk = 2 * i + (lane >> 5), col = lane & 31;
        float v = 0.f;
        if (col < nvalid) { v = W[(size_t)(k0 + kk) * ldw + src_n0 + col]; if (gain) v *= gain[k0 + kk]; }
        scr[kk * 33 + col] = v;
    }
    asm volatile("s_waitcnt lgkmcnt(0)" ::: "memory");
    const int c = lane & 7;
#pragma unroll
    for (int j = 0; j < 4; ++j) {
        const int n = (lane >> 3) + 8 * j; const LAS float* s = scr + (8 * c) * 33 + n;
        u32x4 o; o.x = cvtpk(s[0 * 33], s[1 * 33]); o.y = cvtpk(s[2 * 33], s[3 * 33]); o.z = cvtpk(s[4 * 33], s[5 * 33]); o.w = cvtpk(s[6 * 33], s[7 * 33]);
        *(u32x4*)(WT + (size_t)(dst_row0 + n) * K + k0 + 8 * c) = o;
    }
    asm volatile("s_waitcnt lgkmcnt(0)" ::: "memory");
}
__device__ __forceinline__ void transpose_item8(const float* W, int ldw, int src_n0, const float* gain, fp8_t* WT, int K, int dst_row0, int k0, LAS float* scr, int lane) {
#pragma unroll 8
    for (int i = 0; i < 32; ++i) {
        const int kk = 2 * i + (lane >> 5), col = lane & 31;
        float v = W[(size_t)(k0 + kk) * ldw + src_n0 + col] * W8_SCALE; if (gain) v *= gain[k0 + kk];
        scr[kk * 33 + col] = v;
    }
    asm volatile("s_waitcnt lgkmcnt(0)" ::: "memory");
    const int c = lane & 7;
#pragma unroll
    for (int j = 0; j < 4; ++j) {
        const int n = (lane >> 3) + 8 * j; const LAS float* s = scr + (8 * c) * 33 + n;
        u32x2 o; o.x = pk4_fp8(s[0 * 33], s[1 * 33], s[2 * 33], s[3 * 33]); o.y = pk4_fp8(s[4 * 33], s[5 * 33], s[6 * 33], s[7 * 33]);
        *(u32x2*)(WT + (size_t)(dst_row0 + n) * K + k0 + 8 * c) = o;
    }
    asm volatile("s_waitcnt lgkmcnt(0)" ::: "memory");
}
__device__ __forceinline__ void p0_prologue(Ctx& C) {
    LAS float* scr = (LAS float*)(C.lds + C.wave * 16384);
    const int gw = C.bid * NWAVES + C.wave, NGW = C.G * NWAVES;
    constexpr int I_IN = 16 * (NW1 / 32), I_A = 8 * 32, I_O = 16 * 32, NITEMS = I_IN + 2 * I_A + I_O;
    for (int it = gw; it < NITEMS; it += NGW) {
        int r = it;
        if (r < I_IN) { const int kb = r / (NW1 / 32), nb = r % (NW1 / 32); int nv; const int sc = proj_src_col(nb * 32, nv);
            const int dt = nb >> 3, drow = (nb & 7) * 32;
            if (dt == 12 || dt == 13 || dt == 22) transpose_item(C.w_in, IN_COLS, sc, nv, C.norm_gain, C.WT1, DM, (dt == 22 ? 512 : (dt - 12) * 256) + drow, kb * 64, scr, C.lane);
            else transpose_item8(C.w_in, IN_COLS, sc, C.norm_gain, C.WT18, DM, (dt < 12 ? dt : dt - 2) * 256 + drow, kb * 64, scr, C.lane);
            continue; }
        r -= I_IN;
        if (r < I_A) { transpose_item8(C.w_a, DM, (r % 32) * 32, nullptr, C.WAT, 512, (r % 32) * 32, (r / 32) * 64, scr, C.lane); continue; }
        r -= I_A;
        if (r < I_A) { transpose_item8(C.w_b, DM, (r % 32) * 32, nullptr, C.WBT, 512, (r % 32) * 32, (r / 32) * 64, scr, C.lane); continue; }
        r -= I_A;
        transpose_item8(C.w_o, DM, (r % 32) * 32, nullptr, C.WOT, DM, (r % 32) * 32, (r / 32) * 64, scr, C.lane);
    }
    for (int m0 = gw * 4; m0 < NTOK; m0 += NGW * 4) {
        f32x4 v[4][4]; float s[4];
#pragma unroll
        for (int r = 0; r < 4; ++r) {
            const f32x4* xr = (const f32x4*)(C.x + (size_t)(m0 + r) * DM) + C.lane;
            s[r] = 0.f;
#pragma unroll
            for (int j = 0; j < 4; ++j) v[r][j] = __builtin_nontemporal_load(xr + 64 * j);
        }
#pragma unroll
        for (int r = 0; r < 4; ++r) {
#pragma unroll
            for (int j = 0; j < 4; ++j) s[r] += (v[r][j].x * v[r][j].x + v[r][j].y * v[r][j].y) + (v[r][j].z * v[r][j].z + v[r][j].w * v[r][j].w);
            float t = s[r];
            t += __uint_as_float(dpp_u<0x111, 0xf>(0u, __float_as_uint(t))); t += __uint_as_float(dpp_u<0x112, 0xf>(0u, __float_as_uint(t)));
            t += __uint_as_float(dpp_u<0x114, 0xf>(0u, __float_as_uint(t))); t += __uint_as_float(dpp_u<0x118, 0xf>(0u, __float_as_uint(t)));
            t += __uint_as_float(dpp_u<0x142, 0xa>(0u, __float_as_uint(t))); t += __uint_as_float(dpp_u<0x143, 0xc>(0u, __float_as_uint(t)));
            s[r] = __uint_as_float((unsigned)__builtin_amdgcn_readlane((int)__float_as_uint(t), 63));
        }
#pragma unroll
        for (int r = 0; r < 4; ++r) {
            const float rstd = __builtin_amdgcn_rsqf(s[r] * (1.f / DM) + EPS);
            if (C.lane == 0) C.RSX[m0 + r] = __builtin_amdgcn_sqrtf(s[r] * (1.f / DM) + EPS);
            u32x2* o8 = (u32x2*)(C.XN + (size_t)(m0 + r) * DM) + C.lane;
            unsigned* o4 = (unsigned*)(C.XN8 + (size_t)(m0 + r) * DM) + C.lane;
#pragma unroll
            for (int j = 0; j < 4; ++j) {
                const f32x4 y = v[r][j] * rstd;
                u32x2 w; w.x = cvtpk(y.x, y.y); w.y = cvtpk(y.z, y.w); o8[64 * j] = w;
                o4[64 * j] = pk4_fp8(y.x, y.y, y.z, y.w);
            }
        }
    }
    for (int i = C.bid * 512 + C.tid; i < NTOK; i += C.G * 512) { C.RSS[i] = 0.f;
    }
}

constexpr int A_WAVE_LDS = 1280 + 4096 + 9216;
__device__ __forceinline__ s16x4 tr_read(LAS unsigned char* p) { return __builtin_bit_cast(s16x4, __builtin_amdgcn_ds_read_tr16_b64_v4i16((LAS s16x4*)p)); }
template <int VAR> __device__ __forceinline__ void mixerA_unit(Ctx& C, int b, int c, fp8_t* outp, int opitch) {
    const int lane = C.lane, h = C.wave, r32 = lane & 31, hi = lane >> 5;
    LAS unsigned char* wl = C.lds + h * A_WAVE_LDS;
    LAS float* btab = (LAS float*)wl;
    LAS unsigned char* vimg = wl + 1280;
    LAS bf16_t* ost = (LAS bf16_t*)(wl + 1280 + 4096);
    for (int i = lane; i < 320; i += 64) btab[i] = C.a_rel[h * 513 + i + 193] * LOG2E;
    const size_t tok0 = (size_t)b * SEQ + (size_t)c * 64;
    const bf16_t* Qp = C.P + tok0 * PW + C_QA + h * 64;
    bf16x8 qf[2][4];
#pragma unroll
    for (int qg = 0; qg < 2; ++qg)
#pragma unroll
        for (int ks = 0; ks < 4; ++ks) qf[qg][ks] = *(const bf16x8*)(Qp + (size_t)(32 * qg + r32) * PW + 16 * ks + 8 * hi);
    f32x16 o[2][2];
#pragma unroll
    for (int a = 0; a < 2; ++a)
#pragma unroll
        for (int q = 0; q < 2; ++q)
#pragma unroll
            for (int i = 0; i < 16; ++i) o[a][q][i] = 0.f;
    float mrun[2] = {-1e30f, -1e30f}, lrun[2] = {0.f, 0.f};
    const float bfar = C.a_rel[h * 513 + 512] * LOG2E;
    const int t0 = c < 8 ? (8 - c) * 2 : 0;
    const long kbase = (long)b * SEQ + (long)(c - 8) * 64;
    const int i16 = lane & 15, qq = i16 >> 2, pp = i16 & 3, blk = (lane >> 4) & 1;
    asm volatile("s_waitcnt lgkmcnt(0)" ::: "memory");
    bf16x8 kfn[4]; u32x4 vn[4];
#define MA_LOAD(t_) do { const int j0_ = (t_) * 32; const bf16_t* Kp = C.P + (size_t)(kbase + j0_ + r32) * PW + C_KA + h * 64 + 8 * hi; \
        _Pragma("unroll") for (int ks = 0; ks < 4; ++ks) kfn[ks] = *(const bf16x8*)(Kp + 16 * ks); \
        _Pragma("unroll") for (int r = 0; r < 4; ++r) { const int pc = lane + 64 * r, key = pc >> 3, ch = pc & 7; \
            vn[r] = *(const u32x4*)(C.P + (size_t)(kbase + j0_ + key) * PW + C_VA + h * 64 + ch * 8); } } while (0)
    MA_LOAD(t0);
#pragma unroll 1
    for (int t = t0; t < 18; ++t) {
        const int j0 = t * 32;
        bf16x8 kf[4];
#pragma unroll
        for (int ks = 0; ks < 4; ++ks) kf[ks] = kfn[ks];
        if (VAR != 1)
#pragma unroll
        for (int r = 0; r < 4; ++r) {
            const int pc = lane + 64 * r, key = pc >> 3, ch = pc & 7;
            *(LAS u32x4*)(vimg + (ch >> 2) * 2048 + key * 64 + (ch & 3) * 16) = vn[r];
        }
        if (VAR == 1) { o[0][0][0] += __uint_as_float(vn[0].x ^ vn[3].w); }
        if (t + 1 < 18) MA_LOAD(t + 1);
        const bool far = (t < 8);
        const float cinit = far ? bfar : 0.f;
        f32x16 s[2];
        __builtin_amdgcn_s_setprio(1);
#pragma unroll
        for (int qg = 0; qg < 2; ++qg) {
#pragma unroll
            for (int i = 0; i < 16; ++i) s[qg][i] = cinit;
#pragma unroll
            for (int ks = 0; ks < 4; ++ks) s[qg] = __builtin_amdgcn_mfma_f32_32x32x16_bf16(kf[ks], qf[qg][ks], s[qg], 0, 0, 0);
        }
        __builtin_amdgcn_s_setprio(0);
        float tmax[2];
#pragma unroll
        for (int qg = 0; qg < 2; ++qg) {
            const int q = 32 * qg + r32;
            float tm = -1e30f;
            if (!far && VAR != 2) {
                if (t < 10) {
#pragma unroll
                    for (int i = 0; i < 16; ++i) {
                        const int j = j0 + crow(i, hi); const int rel = 512 + q - j; const int bi = (rel < 256 ? rel : 256) + 63;
                        s[qg][i] += btab[bi];
                    }
                } else {
                    const LAS float* bp = btab + (575 - 27 + q - j0 - 4 * hi);
#pragma unroll
                    for (int i = 0; i < 16; ++i) s[qg][i] += bp[27 - ((i & 3) + 8 * (i >> 2))];
                }
            }
#pragma unroll
            for (int i = 0; i < 16; ++i) tm = fmaxf(tm, s[qg][i]);
            tmax[qg] = xmax32(tm);
        }
        if (__any((tmax[0] > mrun[0] + 8.f) || (tmax[1] > mrun[1] + 8.f))) {
#pragma unroll
            for (int qg = 0; qg < 2; ++qg) {
                const float mn = fmaxf(mrun[qg], tmax[qg]), alpha = __builtin_amdgcn_exp2f(mrun[qg] - mn); mrun[qg] = mn;
                lrun[qg] *= alpha;
#pragma unroll
                for (int dt = 0; dt < 2; ++dt)
#pragma unroll
                    for (int i = 0; i < 16; ++i) o[dt][qg][i] *= alpha;
            }
        }
        bf16x8 pk[2][2];
#pragma unroll
        for (int qg = 0; qg < 2; ++qg) {
            const float mn = mrun[qg];
            float ps = 0.f;
#pragma unroll
            for (int i = 0; i < 16; ++i) { const float p = (VAR == 2) ? s[qg][i] : __builtin_amdgcn_exp2f(s[qg][i] - mn); s[qg][i] = p; ps += p; }
            lrun[qg] += ps;
#pragma unroll
            for (int st = 0; st < 2; ++st) {
                u32x4 w; w.x = cvtpk(s[qg][8 * st + 0], s[qg][8 * st + 1]); w.y = cvtpk(s[qg][8 * st + 2], s[qg][8 * st + 3]);
                w.z = cvtpk(s[qg][8 * st + 4], s[qg][8 * st + 5]); w.w = cvtpk(s[qg][8 * st + 6], s[qg][8 * st + 7]);
                pk[qg][st] = __builtin_bit_cast(bf16x8, w);
            }
        }
        asm volatile("s_waitcnt lgkmcnt(0)" ::: "memory");
        if (VAR == 1) { o[0][0][1] += __uint_as_float(__builtin_bit_cast(u32x4, pk[0][0]).x ^ __builtin_bit_cast(u32x4, pk[1][1]).w ^ __builtin_bit_cast(u32x4, pk[0][1]).y ^ __builtin_bit_cast(u32x4, pk[1][0]).z); } else
#pragma unroll
        for (int dt = 0; dt < 2; ++dt)
#pragma unroll
            for (int st = 0; st < 2; ++st) {
                LAS unsigned char* pb = vimg + dt * 2048 + (16 * st + 4 * hi + qq) * 64 + (16 * blk + 4 * pp) * 2;
                const s16x4 lo = tr_read(pb), hi4 = tr_read(pb + 8 * 64);
                const bf16x8 vf = __builtin_shufflevector(lo, hi4, 0, 1, 2, 3, 4, 5, 6, 7);
                __builtin_amdgcn_s_setprio(1);
#pragma unroll
                for (int qg = 0; qg < 2; ++qg) o[dt][qg] = __builtin_amdgcn_mfma_f32_32x32x16_bf16(vf, pk[qg][st], o[dt][qg], 0, 0, 0);
                __builtin_amdgcn_s_setprio(0);
            }
        asm volatile("s_waitcnt lgkmcnt(0)" ::: "memory");
    }
#undef MA_LOAD
#pragma unroll
    for (int qg = 0; qg < 2; ++qg) {
        const float lt = xsum32(lrun[qg]); const float inv = __builtin_amdgcn_rcpf(lt);
#pragma unroll
        for (int dt = 0; dt < 2; ++dt)
#pragma unroll
            for (int i = 0; i < 16; ++i) ost[(32 * qg + r32) * 72 + 32 * dt + crow(i, hi)] = f2bf(o[dt][qg][i] * inv);
    }
    asm volatile("s_waitcnt lgkmcnt(0)" ::: "memory");
    u32x4 zv8[8];
#pragma unroll
    for (int r = 0; r < 8; ++r) { const int row = (lane >> 3) + 8 * r, ch = lane & 7; zv8[r] = *(const u32x4*)(C.P + (tok0 + row) * PW + h * 64 + ch * 8 + C_ZA); }
#pragma unroll
    for (int r = 0; r < 8; ++r) {
        const int row = (lane >> 3) + 8 * r, ch = lane & 7;
        const u32x4 ov = *(const LAS u32x4*)(ost + row * 72 + ch * 8);
        const u32x4 zv = zv8[r];
        u32x2 w;
        w.x = pk4_fp8(bf_lo(ov[0]) * bf_lo(zv[0]) * Y8_SCALE, bf_hi(ov[0]) * bf_hi(zv[0]) * Y8_SCALE, bf_lo(ov[1]) * bf_lo(zv[1]) * Y8_SCALE, bf_hi(ov[1]) * bf_hi(zv[1]) * Y8_SCALE);
        w.y = pk4_fp8(bf_lo(ov[2]) * bf_lo(zv[2]) * Y8_SCALE, bf_hi(ov[2]) * bf_hi(zv[2]) * Y8_SCALE, bf_lo(ov[3]) * bf_lo(zv[3]) * Y8_SCALE, bf_hi(ov[3]) * bf_hi(zv[3]) * Y8_SCALE);
        *(u32x2*)(outp + (tok0 + row) * (size_t)opitch + h * 64 + ch * 8) = w;
    }
    asm volatile("s_waitcnt lgkmcnt(0)" ::: "memory");
}

__device__ __forceinline__ int t5_bucket(int rel) {
    const int n = rel < 0 ? -rel : rel;
    int bkt = n < 8 ? n : 8 + (n >= 12) + (n >= 16) + (n >= 23) + (n >= 32) + (n >= 46) + (n >= 64) + (n >= 91);
    return bkt + (rel > 0 ? 16 : 0);
}
constexpr int BF_STRIDE = 580;
constexpr int BF_LIST = 0;
constexpr int BF_CNT = 64 * BF_STRIDE * 4;
constexpr int BF_THRF = BF_CNT + 512;
constexpr int BF_PEND = BF_THRF + 256;
constexpr int BF_HIST = BF_PEND + 768;
constexpr int BF_T5 = BF_HIST + 8192;
constexpr int BF_PBAR = BF_T5 + 1024;
constexpr int BF_END = BF_PBAR + 64;
constexpr int BF_CAP = 576;
constexpr int BF_SEL = 0;
constexpr int BF_VIMG = 65536;
static_assert(BF_END <= LDS_BYTES - 64 && BF_VIMG + 8 * 8320 <= BF_CNT, "LDS map");

constexpr int NV = 9;
__device__ __forceinline__ unsigned pack_key(float s, unsigned idxinv) { const int b = __float_as_int(s); const unsigned u = (unsigned)b ^ ((unsigned)(b >> 31) | 0x80000000u); return (u & 0xFFFFE000u) | idxinv; }
__device__ __forceinline__ float key_lower_float(unsigned T) { const unsigned u = T & 0xFFFFE000u; const unsigned bits = (u & 0x80000000u) ? (u & 0x7FFFFFFFu) : ~u; return __uint_as_float(bits); }
__device__ __forceinline__ unsigned wave_prefix_sum(unsigned v) {
    v += dpp_u<0x111, 0xf>(0u, v); v += dpp_u<0x112, 0xf>(0u, v); v += dpp_u<0x114, 0xf>(0u, v); v += dpp_u<0x118, 0xf>(0u, v);
    v += dpp_u<0x142, 0xa>(0u, v); v += dpp_u<0x143, 0xc>(0u, v); return v;
}
__device__ __forceinline__ unsigned wave_max_u(unsigned v) {
    unsigned t;
    t = dpp_u<0x111, 0xf>(0u, v); v = v > t ? v : t; t = dpp_u<0x112, 0xf>(0u, v); v = v > t ? v : t;
    t = dpp_u<0x114, 0xf>(0u, v); v = v > t ? v : t; t = dpp_u<0x118, 0xf>(0u, v); v = v > t ? v : t;
    t = dpp_u<0x142, 0xa>(0u, v); v = v > t ? v : t; t = dpp_u<0x143, 0xc>(0u, v); v = v > t ? v : t;
    return (unsigned)__builtin_amdgcn_readlane((int)v, 63);
}
__device__ __forceinline__ unsigned wave_min_u(unsigned v) {
    unsigned t;
    t = dpp_u<0x111, 0xf>(0xFFFFFFFFu, v); v = v < t ? v : t; t = dpp_u<0x112, 0xf>(0xFFFFFFFFu, v); v = v < t ? v : t;
    t = dpp_u<0x114, 0xf>(0xFFFFFFFFu, v); v = v < t ? v : t; t = dpp_u<0x118, 0xf>(0xFFFFFFFFu, v); v = v < t ? v : t;
    t = dpp_u<0x142, 0xa>(0xFFFFFFFFu, v); v = v < t ? v : t; t = dpp_u<0x143, 0xc>(0xFFFFFFFFu, v); v = v < t ? v : t;
    return (unsigned)__builtin_amdgcn_readlane((int)v, 63);
}
__device__ __forceinline__ int mbcnt64(unsigned long long m) { return __builtin_amdgcn_mbcnt_hi((unsigned)(m >> 32), __builtin_amdgcn_mbcnt_lo((unsigned)m, 0u)); }
#define LDS_BARRIER() do { asm volatile("s_waitcnt lgkmcnt(0)" ::: "memory"); __builtin_amdgcn_s_barrier(); asm volatile("" ::: "memory"); } while (0)

__device__ __forceinline__ void select_query(LAS unsigned* lq, LAS unsigned* cntp, LAS float* thrp, LAS unsigned* hist, const int cn, bool exact, const int lane) {
    unsigned v[NV];
#pragma unroll
    for (int i = 0; i < NV; ++i) v[i] = lq[i * 64 + lane];
    unsigned mx = 0u, mn = 0xFFFFFFFFu;
#pragma unroll
    for (int i = 0; i < NV; ++i) { if (i * 64 + lane >= cn) v[i] = 0u; mx = v[i] > mx ? v[i] : mx; const unsigned w = v[i] ? v[i] : 0xFFFFFFFFu; mn = w < mn ? w : mn; }
    mx = wave_max_u(mx); mn = wave_min_u(mn);
    int need = 256;
    unsigned base = mn;
    const unsigned range = mx - mn;
    int sh = range >= 256u ? (24 - __builtin_clz(range)) : 0;
    unsigned T = 0u;
    for (;;) {
        *(LAS u32x4*)(hist + lane * 4) = (u32x4){0u, 0u, 0u, 0u};
        asm volatile("s_waitcnt lgkmcnt(0)" ::: "memory");
#pragma unroll
        for (int i = 0; i < NV; ++i) {
            const unsigned dgt = (v[i] - base) >> sh;
            const bool in = (v[i] != 0u) && (v[i] >= base) && (dgt < 256u);
            if (in) (void)__hip_atomic_fetch_add(hist + (255u - dgt), 1u, __ATOMIC_RELAXED, __HIP_MEMORY_SCOPE_WORKGROUP);
        }
        asm volatile("s_waitcnt lgkmcnt(0)" ::: "memory");
        const u32x4 hb = *(const LAS u32x4*)(hist + lane * 4);
        const unsigned S = hb.x + hb.y + hb.z + hb.w;
        const unsigned incl = wave_prefix_sum(S);
        const unsigned excl = incl - S;
        int phys; unsigned popl, abvl;
        {
            unsigned cacc = excl;
            if (cacc + hb.x >= (unsigned)need) { phys = 0; popl = hb.x; abvl = cacc; }
            else { cacc += hb.x;
                if (cacc + hb.y >= (unsigned)need) { phys = 1; popl = hb.y; abvl = cacc; }
                else { cacc += hb.y;
                    if (cacc + hb.z >= (unsigned)need) { phys = 2; popl = hb.z; abvl = cacc; }
                    else { cacc += hb.z; phys = 3; popl = hb.w; abvl = cacc; } } }
            phys += 4 * lane;
        }
        const unsigned long long cm = __ballot(incl >= (unsigned)need);
        const int src = __ffsll((long long)cm) - 1;
        const int bin = 255 - __builtin_amdgcn_readlane(phys, src);
        const int pop = __builtin_amdgcn_readlane((int)popl, src), above = __builtin_amdgcn_readlane((int)abvl, src);
        const unsigned newbase = base + ((unsigned)bin << sh);
        const int kept = (256 - need) + above + pop;
        if (!exact) {
            if (kept <= 288 || sh == 0) { T = newbase; break; }
            exact = true;
        }
        need -= above;
        if (pop <= 64 || sh == 0) {
            int pos = 0;
#pragma unroll
            for (int i = 0; i < NV; ++i) {
                const bool in = (v[i] != 0u) && (v[i] >= newbase) && (((v[i] - newbase) >> sh) == 0u);
                const unsigned long long mk = __ballot(in);
                if (in) hist[pos + mbcnt64(mk)] = v[i];
                pos += __popcll(mk);
            }
            asm volatile("s_waitcnt lgkmcnt(0)" ::: "memory");
            const unsigned e = (lane < pop) ? hist[lane] : 0u;
            int rk = 0;
            for (int k = 0; k < pop; ++k) rk += (hist[k] > e) ? 1 : 0;
            const bool isT = (lane < pop) && (rk == need - 1);
            const unsigned long long tm = __ballot(isT);
            T = (unsigned)__builtin_amdgcn_readlane((int)e, __ffsll((long long)tm) - 1);
            break;
        }
        base = newbase; sh = sh > 8 ? sh - 8 : 0;
    }
    int pos = 0;
#pragma unroll
    for (int i = 0; i < NV; ++i) {
        const bool k = (v[i] != 0u) && (v[i] >= T);
        const unsigned long long mk = __ballot(k);
        if (k) lq[pos + mbcnt64(mk)] = v[i];
        pos += __popcll(mk);
    }
    if (lane == 0) { *cntp = (unsigned)pos; *thrp = key_lower_float(T); }
    asm volatile("s_waitcnt lgkmcnt(0)" ::: "memory");
}

#define PRUNE_MASKS(T_) asm("v_cmp_le_u32_e64 %0, %9, %10\n\tv_cmp_le_u32_e64 %1, %9, %11\n\tv_cmp_le_u32_e64 %2, %9, %12\n\tv_cmp_le_u32_e64 %3, %9, %13\n\tv_cmp_le_u32_e64 %4, %9, %14\n\t" \
            "v_cmp_le_u32_e64 %5, %9, %15\n\tv_cmp_le_u32_e64 %6, %9, %16\n\tv_cmp_le_u32_e64 %7, %9, %17\n\tv_cmp_le_u32_e64 %8, %9, %18" \
            : "=&s"(m0), "=&s"(m1), "=&s"(m2), "=&s"(m3), "=&s"(m4), "=&s"(m5), "=&s"(m6), "=&s"(m7), "=&s"(m8) \
            : "s"(T_), "v"(v[0]), "v"(v[1]), "v"(v[2]), "v"(v[3]), "v"(v[4]), "v"(v[5]), "v"(v[6]), "v"(v[7]), "v"(v[8]))
__device__ __forceinline__ void prune_query(LAS unsigned* lq, LAS unsigned* cntp, LAS float* thrp, const int cn, const int lane) {
    __builtin_amdgcn_s_setprio(3);
    unsigned v[NV];
#pragma unroll
    for (int i = 0; i < NV; ++i) v[i] = lq[i * 64 + lane];
    const float thr_old = __uint_as_float((unsigned)__builtin_amdgcn_readfirstlane((int)__float_as_uint(*thrp)));
    if (7 * 64 + lane >= cn) v[7] = 0u;
    if (8 * 64 + lane >= cn) v[8] = 0u;
    unsigned mx = v[0];
#pragma unroll
    for (int i = 1; i < NV; ++i) mx = v[i] > mx ? v[i] : mx;
    unsigned hi = wave_max_u(mx), lo;
    if (thr_old == -INFINITY) {
        unsigned mn = v[0];
#pragma unroll
        for (int i = 1; i < 7; ++i) mn = v[i] < mn ? v[i] : mn;
        const unsigned w7 = v[7] ? v[7] : 0xFFFFFFFFu, w8 = v[8] ? v[8] : 0xFFFFFFFFu;
        mn = w7 < mn ? w7 : mn; mn = w8 < mn ? w8 : mn;
        lo = wave_min_u(mn);
    } else lo = pack_key(thr_old, 0u);
    unsigned long long m0, m1, m2, m3, m4, m5, m6, m7, m8;
    bool have = false;
    for (;;) {
        if (hi == lo) break;
        const unsigned T = lo + ((hi - lo + 1u) >> 1);
        PRUNE_MASKS(T);
        const int c = __popcll(m0) + __popcll(m1) + __popcll(m2) + __popcll(m3) + __popcll(m4) + __popcll(m5) + __popcll(m6) + __popcll(m7) + __popcll(m8);
        if (c >= 256) { lo = T; if (c <= 288) { have = true; break; } } else hi = T - 1u;
    }
    if (!have) PRUNE_MASKS(lo);
    int pos = 0;
#define PRUNE_PUT(i_, m_) do { if (__builtin_amdgcn_inverse_ballot_w64(m_)) lq[pos + mbcnt64(m_)] = v[i_]; pos += __popcll(m_); } while (0)
    PRUNE_PUT(0, m0); PRUNE_PUT(1, m1); PRUNE_PUT(2, m2); PRUNE_PUT(3, m3); PRUNE_PUT(4, m4); PRUNE_PUT(5, m5); PRUNE_PUT(6, m6); PRUNE_PUT(7, m7); PRUNE_PUT(8, m8);
#undef PRUNE_PUT
    if (lane == 0) { *cntp = (unsigned)pos; *thrp = key_lower_float(lo); }
    asm volatile("s_waitcnt lgkmcnt(0)" ::: "memory");
    __builtin_amdgcn_s_setprio(0);
}
#undef PRUNE_MASKS

__device__ __forceinline__ void b2_loadK(u32x4 (&Kf)[4], const LAS unsigned* sq, int ci, const fp8_t* KBb, int lane) {
    const int g = lane >> 4;
#pragma unroll
    for (int tt = 0; tt < 4; ++tt) {
        const int key = (int)(sq[64 * ci + 16 * tt + (lane & 15)] & 0xffffu);
        Kf[tt] = *(const u32x4*)(KBb + (size_t)key * 64 + 16 * g);
    }
}
__device__ __forceinline__ void b2_loadV(u32x4 (&Vf)[4], const LAS unsigned* sq, int ci, const fp8_t* VBb, int lane) {
#pragma unroll
    for (int r = 0; r < 4; ++r) {
        const int pc = lane + 64 * r, row = pc >> 2, dt = pc & 3;
        const int key = (int)(sq[64 * ci + row] & 0xffffu);
        Vf[r] = *(const u32x4*)(VBb + (size_t)key * 64 + dt * 16);
    }
}
struct B2State { f32x4 o[4]; float mrun, lrun; long qb[2]; u32x4 qbn[2]; u32x2 zz[4]; };
template <int VAR> __device__ __forceinline__ void b2_step(Ctx& C, B2State& st, const u32x4 (&Kf)[4], const u32x4 (&Vf)[4], const LAS unsigned* sq, const LAS float* t5L, LAS unsigned char* vimg,
                                        int ci, int nchunk, int ns, size_t tok, int pos, fp8_t* outp, int opitch, int lane, bool haveNext) {
    const int hd = lane & 15, g = lane >> 4, hd7 = hd & 7;
    const int qq4 = hd >> 2, pp = hd & 3;
    if (ci == 0) {
#pragma unroll
        for (int d = 0; d < 4; ++d) st.o[d] = (f32x4){0.f, 0.f, 0.f, 0.f};
        st.mrun = -1e30f; st.lrun = 0.f;
#pragma unroll
        for (int ks = 0; ks < 2; ++ks) {
            const u32x4 t = st.qbn[ks];
            u32x2 q8; q8.x = pk4_fp8(bf_lo(t.x) * 8.f, bf_hi(t.x) * 8.f, bf_lo(t.y) * 8.f, bf_hi(t.y) * 8.f); q8.y = pk4_fp8(bf_lo(t.z) * 8.f, bf_hi(t.z) * 8.f, bf_lo(t.w) * 8.f, bf_hi(t.w) * 8.f);
            if (hd >= 8) q8 = (u32x2){0u, 0u};
            st.qb[ks] = __builtin_bit_cast(long, q8);
        }
#pragma unroll
        for (int d = 0; d < 4; ++d) st.zz[d] = *(const u32x2*)(C.P + tok * PW + hd7 * 64 + 4 * g + C_ZB + 16 * d);
        if (haveNext) {
#pragma unroll
            for (int ks = 0; ks < 2; ++ks) st.qbn[ks] = *(const u32x4*)(C.P + (tok + 1) * PW + C_QB + hd7 * 64 + 32 * ks + 8 * g);
        }
    }
#pragma unroll
    for (int r = 0; r < 4; ++r) {
        const int pc = lane + 64 * r, row = pc >> 2, dt = pc & 3;
        const int pos = (row & 32) + 8 * ((row >> 2) & 3) + 4 * ((row >> 4) & 1) + (row & 3);
        *(LAS u32x4*)(vimg + dt * 1024 + pos * 16) = Vf[r];
    }
    const int hup = hd >> 3;
    u32x4 kk[2];
#pragma unroll
    for (int p = 0; p < 2; ++p) kk[p] = *(const LAS u32x4*)(sq + 16 * (4 * ci + 2 * p + hup) + 4 * g);
    float bias[2][4];
#pragma unroll
    for (int p = 0; p < 2; ++p)
#pragma unroll
        for (int i = 0; i < 4; ++i) bias[p][i] = t5L[(kk[p][i] >> 16) * 8 + hd7];
    f32x4 acc4[4];
#pragma unroll
    for (int tt = 0; tt < 4; ++tt) {
        f32x4 a = (f32x4){0.f, 0.f, 0.f, 0.f};
        a = __builtin_amdgcn_mfma_f32_16x16x32_fp8_fp8(__builtin_bit_cast(long, (u32x2){Kf[tt].x, Kf[tt].y}), st.qb[0], a, 0, 0, 0);
        acc4[tt] = __builtin_amdgcn_mfma_f32_16x16x32_fp8_fp8(__builtin_bit_cast(long, (u32x2){Kf[tt].z, Kf[tt].w}), st.qb[1], a, 0, 0, 0);
    }
    float lg[2][4];
    float cmax = -1e30f;
#pragma unroll
    for (int p = 0; p < 2; ++p)
#pragma unroll
        for (int i = 0; i < 4; ++i) {
            const float f = __uint_as_float((unsigned)__builtin_amdgcn_update_dpp((int)__float_as_uint(acc4[2 * p][i]), (int)__float_as_uint(acc4[2 * p + 1][i]), 0x128, 0xf, 0xc, false));
            const float x = __builtin_fmaf(f, 0.125f, bias[p][i]);
            lg[p][i] = x; cmax = fmaxf(cmax, x);
        }
    cmax = xmax32(xmax16(cmax));
    cmax = fmaxf(cmax, __uint_as_float(dpp_u<0x128, 0xf>(0u, __float_as_uint(cmax))));
    const float mn = fmaxf(st.mrun, cmax); const float alpha = __builtin_amdgcn_exp2f(st.mrun - mn); st.mrun = mn;
    float ps = 0.f;
#pragma unroll
    for (int p = 0; p < 2; ++p)
#pragma unroll
        for (int i = 0; i < 4; ++i) { const float e = __builtin_amdgcn_exp2f(lg[p][i] - mn); lg[p][i] = e; ps += e; }
    st.lrun = st.lrun * alpha + ps;
#pragma unroll
    for (int d = 0; d < 4; ++d) st.o[d] = st.o[d] * alpha;
    asm volatile("s_waitcnt lgkmcnt(0)" ::: "memory");
    {
        long vf[2][4];
#pragma unroll
        for (int ul = 0; ul < 2; ++ul)
#pragma unroll
            for (int d = 0; d < 4; ++d) {
                LAS unsigned char* pa = vimg + d * 1024 + (32 * ul + 8 * g + (hd >> 1)) * 16 + 8 * (hd & 1);
                vf[ul][d] = __builtin_bit_cast(long, __builtin_amdgcn_ds_read_tr8_b64_v2i32((LAS i32x2*)pa));
            }
#pragma unroll
        for (int ul = 0; ul < 2; ++ul) {
            u32x2 w;
            w.x = pk4_fp8_raw(lg[ul][0], lg[ul][1], lg[ul][2], lg[ul][3]);
            w.y = dpp_u<0x128, 0xf>(0u, w.x);
            const long pb = __builtin_bit_cast(long, w);
#pragma unroll
            for (int d = 0; d < 4; ++d) st.o[d] = __builtin_amdgcn_mfma_f32_16x16x32_fp8_fp8(vf[ul][d], pb, st.o[d], 0, 0, 0);
        }
    }
    asm volatile("s_waitcnt lgkmcnt(0)" ::: "memory");
    if (ci == nchunk - 1) {
        float l = xsum32(xsum16(st.lrun));
        l += __uint_as_float(dpp_u<0x128, 0xf>(0u, __float_as_uint(l)));
        const float inv = __builtin_amdgcn_rcpf(l);
        if (hd < 8) {
            fp8_t* op = outp + tok * (size_t)opitch + hd * 64 + 4 * g;
            const float inv8 = inv * Y8_SCALE;
#pragma unroll
            for (int d = 0; d < 4; ++d) {
                const u32x2 z = st.zz[d];
                *(unsigned*)(op + 16 * d) = pk4_fp8(st.o[d][0] * inv8 * bf_lo(z.x), st.o[d][1] * inv8 * bf_hi(z.x), st.o[d][2] * inv8 * bf_lo(z.y), st.o[d][3] * inv8 * bf_hi(z.y));
            }
        }
    }
}

template <int MODE> __device__ __forceinline__ void mixerB_unit(Ctx& C, int b, int c, fp8_t* outp, int opitch) {
    int lane = C.lane; const int wave = C.wave;
    asm volatile("" : "+v"(lane));
    LAS unsigned* listL = (LAS unsigned*)(C.lds + BF_LIST);
    LAS unsigned* cntL = (LAS unsigned*)(C.lds + BF_CNT);
    LAS float* thrL = (LAS float*)(C.lds + BF_THRF);
    LAS unsigned* histL = (LAS unsigned*)(C.lds + BF_HIST + wave * 1024);
    LAS float* t5L = (LAS float*)(C.lds + BF_T5);
    const int n = (c + 1) * 64;
    const int nround = (n + 127) >> 7;
    LAS unsigned* cntF = cntL + 64 * (nround & 1);
    const size_t tok0 = (size_t)b * SEQ + (size_t)c * 64;
    __syncthreads();
    if (C.tid < 64) { cntL[C.tid] = 0u; thrL[C.tid] = -INFINITY; }
    if (C.tid < 192) ((LAS unsigned*)(C.lds + BF_PEND))[C.tid] = 0u;
    if (C.tid < 4) ((LAS unsigned*)(C.lds + BF_PBAR))[C.tid] = 0u;
    for (int i = C.tid; i < 256; i += NWAVES * 64) t5L[i] = C.t5[i] * LOG2E;
    __syncthreads();
    if (MODE < 4) {
        const int qg4 = wave >> 1, kw = wave & 1;
        const int ql = lane & 15, g = lane >> 4;
        const int q = 16 * qg4 + ql;
        bf16x8 qf[8][2];
        const bf16_t* Qp = C.P + (tok0 + q) * PW + C_QI + 8 * g;
#pragma unroll
        for (int h = 0; h < 8; ++h)
#pragma unroll
            for (int ks = 0; ks < 2; ++ks) qf[h][ks] = *(const bf16x8*)(Qp + h * 64 + 32 * ks);
        float wv[8];
        { const f32x4 w0 = *(const f32x4*)(C.WI + (tok0 + q) * 8), w1 = *(const f32x4*)(C.WI + (tok0 + q) * 8 + 4);
          wv[0] = 0.5f * w0.x; wv[1] = 0.5f * w0.y; wv[2] = 0.5f * w0.z; wv[3] = 0.5f * w0.w; wv[4] = 0.5f * w1.x; wv[5] = 0.5f * w1.y; wv[6] = 0.5f * w1.z; wv[7] = 0.5f * w1.w; }
        bf16x8 qhi[2], qlo[2];
#pragma unroll
        for (int ks = 0; ks < 2; ++ks) {
            float acc8[8];
#pragma unroll
            for (int e = 0; e < 8; ++e) acc8[e] = 0.f;
#pragma unroll
            for (int h = 0; h < 8; ++h) {
                const u32x4 t = __builtin_bit_cast(u32x4, qf[h][ks]);
#pragma unroll
                for (int e = 0; e < 4; ++e) { acc8[2 * e] += wv[h] * bf_lo(t[e]); acc8[2 * e + 1] += wv[h] * bf_hi(t[e]); }
            }
            u32x4 hi_, lo_;
#pragma unroll
            for (int e = 0; e < 4; ++e) {
                const unsigned hp = cvtpk(acc8[2 * e], acc8[2 * e + 1]);
                hi_[e] = hp; lo_[e] = cvtpk(acc8[2 * e] - bf_lo(hp), acc8[2 * e + 1] - bf_hi(hp));
            }
            qhi[ks] = __builtin_bit_cast(bf16x8, hi_); qlo[ks] = __builtin_bit_cast(bf16x8, lo_);
        }
        const char* KIbase = (const char*)(C.KI + (size_t)b * SEQ * 64);
        const unsigned kvoff = (unsigned)(ql * 128 + 16 * g);
        LAS unsigned* lq = listL + q * BF_STRIDE;
        LAS unsigned* pendL = (LAS unsigned*)(C.lds + BF_PEND);
        int p3 = 0;
        LAS unsigned* pbar = (LAS unsigned*)(C.lds + BF_PBAR) + qg4;
        unsigned psync = 0u;
        bf16x8 kc[4][2];
#define B1_LOADKT(tt_, k0_) do { const char* Kp_ = KIbase + (size_t)((k0_) + 16 * (tt_)) * 128; kc[tt_][0] = *(const bf16x8*)(Kp_ + kvoff); kc[tt_][1] = *(const bf16x8*)(Kp_ + kvoff + 64); } while (0)
        if (64 * kw < n) {
#pragma unroll
            for (int tt = 0; tt < 4; ++tt) B1_LOADKT(tt, 64 * kw);
        }
#pragma unroll 1
        for (int r = 0; r < nround; ++r) {
            const int k0 = 128 * r + 64 * kw;
#define PAIR_SYNC() do { asm volatile("s_waitcnt lgkmcnt(0)" ::: "memory"); ++psync; \
                if (lane == 0) (void)__hip_atomic_fetch_add(pbar, 1u, __ATOMIC_RELAXED, __HIP_MEMORY_SCOPE_WORKGROUP); \
                for (unsigned sp_ = 0; sp_ < (1u << 24); ++sp_) { \
                    const unsigned pv_ = (unsigned)__builtin_amdgcn_readfirstlane((int)__hip_atomic_load(pbar, __ATOMIC_RELAXED, __HIP_MEMORY_SCOPE_WORKGROUP)); \
                    if (pv_ >= 2u * psync) break; __builtin_amdgcn_s_sleep(0); } \
                asm volatile("" ::: "memory"); } while (0)
            f32x4 sc[4];
            if (k0 < n) {
                f32x4 hacc[3];
                __builtin_amdgcn_s_setprio(2);
#pragma unroll
                for (int m = 0; m < 34; ++m) {
                    if (m < 32) {
                        const int tt = m >> 3, h = m & 7;
                        if (h == 0) {
                            f32x4 sacc = (f32x4){0.f, 0.f, 0.f, 0.f};
                            sacc = __builtin_amdgcn_mfma_f32_16x16x32_bf16(kc[tt][0], qhi[0], sacc, 0, 0, 0);
                            sacc = __builtin_amdgcn_mfma_f32_16x16x32_bf16(kc[tt][1], qhi[1], sacc, 0, 0, 0);
                            sacc = __builtin_amdgcn_mfma_f32_16x16x32_bf16(kc[tt][0], qlo[0], sacc, 0, 0, 0);
                            sacc = __builtin_amdgcn_mfma_f32_16x16x32_bf16(kc[tt][1], qlo[1], sacc, 0, 0, 0);
                            sc[tt] = sacc;
                        }
                        f32x4 a = (f32x4){0.f, 0.f, 0.f, 0.f};
                        a = __builtin_amdgcn_mfma_f32_16x16x32_bf16(kc[tt][0], qf[h][0], a, 0, 0, 0);
                        hacc[m % 3] = __builtin_amdgcn_mfma_f32_16x16x32_bf16(kc[tt][1], qf[h][1], a, 0, 0, 0);
                        if (h == 7 && k0 + 128 < n) B1_LOADKT(tt, k0 + 128);
                    }
                    __builtin_amdgcn_sched_barrier(0);
                    if (m >= 2) {
                        const int mm = m - 2, tt = mm >> 3, h = mm & 7;
#pragma unroll
                        for (int i = 0; i < 4; ++i) { sc[tt][i] = __builtin_fmaf(wv[h], __builtin_fabsf(hacc[mm % 3][i]), sc[tt][i]); asm volatile("" : "+v"(sc[tt][i])); }
                    }
                    __builtin_amdgcn_sched_barrier(0);
                }
                __builtin_amdgcn_s_setprio(0);
            }
            LAS unsigned* cur = cntL + 64 * (r & 1);
            LAS unsigned* nxt = cntL + 64 * ((r + 1) & 1);
            LAS unsigned* pendR = pendL + 64 * p3;
            LAS unsigned* pendZ = pendL + 64 * (p3 == 0 ? 2 : p3 - 1);
            p3 = (p3 == 2) ? 0 : p3 + 1;
            float thr = thrL[q];
            int np = 0;
            if (k0 < n) {
#pragma unroll
                for (int tt = 0; tt < 4; ++tt)
#pragma unroll
                    for (int i = 0; i < 4; ++i) np += (sc[tt][i] >= thr) ? 1 : 0;
            }
            unsigned base = 0u;
            if (np > 0) base = __hip_atomic_fetch_add(pendR + q, (unsigned)np, __ATOMIC_RELAXED, __HIP_MEMORY_SCOPE_WORKGROUP);
            PAIR_SYNC();
            {
                const int cmine = (int)cur[q], pmine = (int)pendR[q];
                if (g == 0) pendZ[q] = 0u;
                const unsigned pm = (unsigned)__ballot(cmine + pmine > BF_CAP) & 0xFFFFu;
                const bool mine = (pm >> ql) & 1u;
                if (kw == 0 && g == 0 && !mine) nxt[q] = (unsigned)(cmine + pmine);
                base += (unsigned)cmine;
                if (pm) {
                    unsigned pw = pm;
                    int idx = 0;
                    while (pw) {
                        const int j = __builtin_ctz(pw); pw &= pw - 1u;
                        if ((idx & 1) == kw) {
                            const int qq = 16 * qg4 + j;
                            const int cn = __builtin_amdgcn_readlane(cmine, j);
                            prune_query(listL + qq * BF_STRIDE, nxt + qq, thrL + qq, cn, lane);
                        }
                        ++idx;
                    }
                    PAIR_SYNC();
                    if (mine) {
                        thr = thrL[q];
                        np = 0;
                        if (k0 < n) {
#pragma unroll
                            for (int tt = 0; tt < 4; ++tt)
#pragma unroll
                                for (int i = 0; i < 4; ++i) np += (sc[tt][i] >= thr) ? 1 : 0;
                        }
                        if (np > 0) base = __hip_atomic_fetch_add(nxt + q, (unsigned)np, __ATOMIC_RELAXED, __HIP_MEMORY_SCOPE_WORKGROUP);
                    }
                }
            }
            if (np > 0) {
                unsigned slot = base;
#pragma unroll
                for (int tt = 0; tt < 4; ++tt) {
                    const unsigned kbi = (unsigned)(8191 - (k0 + 16 * tt + 4 * g));
#pragma unroll
                    for (int i = 0; i < 4; ++i)
                        if (sc[tt][i] >= thr) { lq[slot] = pack_key(sc[tt][i], kbi - (unsigned)i); ++slot; }
                }
            }
        }
        PAIR_SYNC();
#undef B1_LOADKT
#undef PAIR_SYNC
    }
    if (MODE >= 4) { if (C.tid < 64) cntF[C.tid] = (unsigned)(n < 256 ? n : 256); __syncthreads(); }
#pragma unroll 1
    for (int j = 0; j < 8; ++j) {
        const int qq = 8 * wave + j;
        const int cn = __builtin_amdgcn_readfirstlane((int)cntF[qq]);
        if (MODE < 2 && cn > 256) select_query(listL + qq * BF_STRIDE, cntF + qq, thrL + qq, histL, cn, true, lane);
    }
    asm volatile("s_waitcnt lgkmcnt(0)" ::: "memory");
    unsigned selp[8][4];
#pragma unroll
    for (int j = 0; j < 8; ++j) {
        const int qq = 8 * wave + j;
        const int cq = __builtin_amdgcn_readfirstlane((int)cntF[qq]);
        const u32x4 v = *(const LAS u32x4*)(listL + qq * BF_STRIDE + lane * 4);
#pragma unroll
        for (int k = 0; k < 4; ++k) {
            int id = (int)(8191u - (v[k] & 0x1FFFu));
            if (MODE == 4 || MODE >= 6) id = (lane * 4 + k) & 63;
            if (MODE == 5) id = (int)(((unsigned)(lane * 4 + k) * 2654435761u + (unsigned)qq * 40503u) >> 7) % n;
            selp[j][k] = (lane * 4 + k < cq) ? ((unsigned)id | ((unsigned)t5_bucket(id - (c * 64 + qq)) << 16)) : 0u;
        }
    }
    __syncthreads();
    LAS unsigned* selL = (LAS unsigned*)(C.lds + BF_SEL);
#pragma unroll
    for (int j = 0; j < 8; ++j) { const int qq = 8 * wave + j; *(LAS u32x4*)(selL + qq * 256 + lane * 4) = (u32x4){selp[j][0], selp[j][1], selp[j][2], selp[j][3]}; }
    __syncthreads();
    if (MODE >= 1 && MODE < 4) { if (lane < 8) outp[(tok0 + 8 * wave + lane) * (size_t)opitch + 1] = (fp8_t)selL[(8 * wave + lane) * 256 + 3]; __syncthreads(); return; }
    {
        asm volatile("" : "+v"(lane));
        LAS unsigned char* vimg = C.lds + BF_VIMG + wave * 8320;
        const fp8_t* KBb = (const fp8_t*)C.KB + (size_t)b * SEQ * 64;
        const fp8_t* VBb = (const fp8_t*)C.VB + (size_t)b * SEQ * 64;
        const int nsu = n < 256 ? n : 256, nchunk = nsu >> 6, nsteps = 8 * nchunk;
        u32x4 KA[4], KBf[4]; u32x4 VA[4], VBf[4];
        B2State st;
        int jj = 0, ci = 0, jn = 0, cnx = 0;
#define B2_ADV(j_, c_) do { if (++(c_) == nchunk) { (c_) = 0; ++(j_); } } while (0)
#define B2_STEP(Kf_, Vf_, Kn_, Vn_, more_) do { const int qq_ = 8 * wave + jj; const int ns_ = __builtin_amdgcn_readfirstlane((int)cntF[qq_]); \
        if (more_) { b2_loadK(Kn_, selL + (8 * wave + jn) * 256, cnx, KBb, lane); b2_loadV(Vn_, selL + (8 * wave + jn) * 256, cnx, VBb, lane); B2_ADV(jn, cnx); } \
        b2_step<(MODE == 6 ? 1 : MODE == 7 ? 2 : 0)>(C, st, Kf_, Vf_, selL + qq_ * 256, t5L, vimg, ci, nchunk, ns_, tok0 + qq_, c * 64 + qq_, outp, opitch, lane, jj < 7); B2_ADV(jj, ci); } while (0)
        b2_loadK(KA, selL + (8 * wave + jn) * 256, cnx, KBb, lane); b2_loadV(VA, selL + (8 * wave + jn) * 256, cnx, VBb, lane); B2_ADV(jn, cnx);
        { const int hd7_ = lane & 7, g_ = lane >> 4;
#pragma unroll
          for (int ks = 0; ks < 2; ++ks) st.qbn[ks] = *(const u32x4*)(C.P + (tok0 + 8 * wave) * PW + C_QB + hd7_ * 64 + 32 * ks + 8 * g_); }
#pragma unroll 1
        for (int s = 0; s < nsteps; s += 2) {
            B2_STEP(KA, VA, KBf, VBf, true);
            B2_STEP(KBf, VBf, KA, VA, (s + 2 < nsteps));
        }
#undef B2_ADV
#undef B2_STEP
    }
    __syncthreads();
}

#define XB_TMO      128
#define XB_XCNT(j)  (256  + 64 * (j))
#define XB_XSUB(j)  (1280 + 64 * (j))
#define XB_XGEN(j)  (2304 + 64 * (j))
#define XB_TOP      3328
#define XB_TOPGEN   3392
#define XCD_BAR_WORDS 3456
#define XB_SPIN_CAP (1u << 18)
__device__ __forceinline__ unsigned xb_ld(unsigned* p)              { return __hip_atomic_load(p, __ATOMIC_RELAXED, __HIP_MEMORY_SCOPE_AGENT); }
__device__ __forceinline__ unsigned xb_add(unsigned* p, unsigned v) { return __hip_atomic_fetch_add(p, v, __ATOMIC_RELAXED, __HIP_MEMORY_SCOPE_AGENT); }
__device__ __forceinline__ unsigned xb_xcc_id() { return (unsigned)__builtin_amdgcn_s_getreg((3 << 11) | 20) & 0xFu; }
#define XB_SPIN(cond, bar) do { unsigned _sp = 0; while (cond) { __builtin_amdgcn_s_sleep(1); \
    if ((++_sp & 255u) == 0u) { if (xb_ld(&(bar)[XB_TMO])) break; if (_sp > XB_SPIN_CAP) { atomicAdd(&(bar)[XB_TMO], 1u); break; } } } } while (0)
struct XcdBarrier { unsigned* bar; unsigned x; volatile LAS unsigned* st; };
__device__ __forceinline__ XcdBarrier xcd_barrier_post(unsigned* bar, volatile LAS unsigned* st) {
    XcdBarrier b; b.bar = bar; b.x = xb_xcc_id(); b.st = st;
    if (threadIdx.x == 0) (void)xb_add(&bar[XB_XCNT(b.x)], 1u);
    return b;
}
__device__ __forceinline__ void xcd_barrier_complete(unsigned* bar, unsigned x, unsigned& nloc, unsigned& nx) {
    const unsigned G = gridDim.x * gridDim.y * gridDim.z;
    unsigned sum, cnt, mine, sp = 0u;
    for (;;) {
        sum = 0u; cnt = 0u; mine = 0u;
#pragma unroll
        for (unsigned j = 0; j < 16; ++j) { const unsigned c = xb_ld(&bar[XB_XCNT(j)]); sum += c; cnt += (c > 0u) ? 1u : 0u; mine = (j == x) ? c : mine; }
        if (sum == G) break;
        __builtin_amdgcn_s_sleep(1);
        if ((++sp & 255u) == 0u) { if (xb_ld(&bar[XB_TMO])) break; if (sp > XB_SPIN_CAP) { atomicAdd(&bar[XB_TMO], 1u); break; } }
    }
    nloc = mine > 0u ? mine : 1u; nx = cnt > 0u ? cnt : 1u;
}
__device__ __forceinline__ void xcd_barrier(const XcdBarrier& b) {
    asm volatile("s_waitcnt vmcnt(0)" ::: "memory");
    __syncthreads();
    if (threadIdx.x == 0) {
        unsigned* bar = b.bar;
        __builtin_amdgcn_s_waitcnt(0);
        unsigned nloc = b.st[0], nx = b.st[1];
        if (nloc == 0u) { xcd_barrier_complete(bar, b.x, nloc, nx); b.st[0] = nloc; b.st[1] = nx; }
        const unsigned old = xb_add(&bar[XB_XSUB(b.x)], 1u);
        const unsigned gen = old / nloc;
        if (old + 1u == (gen + 1u) * nloc) {
            __builtin_amdgcn_fence(__ATOMIC_RELEASE, "agent");
            asm volatile("s_waitcnt vmcnt(0)" ::: "memory");
            const unsigned og = xb_add(&bar[XB_TOP], 1u);
            const unsigned tg = og / nx;
            if (og + 1u == (tg + 1u) * nx) xb_add(&bar[XB_TOPGEN], 1u);
            else XB_SPIN(xb_ld(&bar[XB_TOPGEN]) == tg, bar);
            __builtin_amdgcn_fence(__ATOMIC_ACQUIRE, "agent");
            xb_add(&bar[XB_XGEN(b.x)], 1u);
            asm volatile("s_waitcnt vmcnt(0)" ::: "memory");
        } else {
            XB_SPIN(xb_ld(&bar[XB_XGEN(b.x)]) == gen, bar);
            __builtin_amdgcn_fence(__ATOMIC_ACQUIRE, "agent");
            asm volatile("s_waitcnt vmcnt(0)" ::: "memory");
        }
    }
    __syncthreads();
}

struct Args { const float* in[9]; float* out; unsigned char* ws; int ph_lo, ph_hi; };
__global__ void __launch_bounds__(NWAVES * 64, 2) fwd_kernel(Args args) {
    extern __shared__ __attribute__((aligned(16))) unsigned char lds_raw[];
    Ctx C;
    C.lds = (LAS unsigned char*)lds_raw;
    C.tid = threadIdx.x; C.lane = C.tid & 63; C.wave = __builtin_amdgcn_readfirstlane(C.tid >> 6);
    C.G = gridDim.x; C.bid = blockIdx.x; C.dbg = 0ull;
    C.x = args.in[0]; C.norm_gain = args.in[1]; C.w_in = args.in[2]; C.a_rel = args.in[3]; C.t5 = args.in[4];
    C.w_a = args.in[5]; C.w_b = args.in[6]; C.w_o = args.in[7]; C.fgain = args.in[8]; C.out = args.out;
    unsigned char* ws = args.ws;
    C.WT1 = (bf16_t*)(ws + WS_WT1); C.WAT = (fp8_t*)(ws + WS_WAT); C.WBT = (fp8_t*)(ws + WS_WBT); C.WOT = (fp8_t*)(ws + WS_WOT);
    C.Y8 = (fp8_t*)(ws + WS_Y8); C.MG8 = (fp8_t*)(ws + WS_XN8); C.WT18 = (fp8_t*)(ws + WS_WT18); C.XN8 = (fp8_t*)(ws + WS_XN8);
    C.KB = (bf16_t*)(ws + WS_KB); C.VB = (bf16_t*)(ws + WS_VB); C.KI = (bf16_t*)(ws + WS_KI); C.XN = (bf16_t*)(ws + WS_XN); C.P = (bf16_t*)(ws + WS_P);
    C.WI = (float*)(ws + WS_WI); C.RSS = (float*)(ws + WS_RSS); C.RSX = (float*)(ws + WS_RSX);
    const int lo = args.ph_lo, hi = args.ph_hi;
#if MK_ONE_LAUNCH
    volatile LAS unsigned* MISC = (volatile LAS unsigned*)(C.lds + LDS_BYTES - 64);
    if (C.tid < 16) MISC[C.tid] = 0u;
    __syncthreads();
    const XcdBarrier xbar = xcd_barrier_post((unsigned*)(ws + WS_CTL) + 1024, MISC);
#define GRID_SYNC() xcd_barrier(xbar)
#else
#define GRID_SYNC() do {} while (0)
#endif
#ifndef PH_ENABLE
#define PH_ENABLE 63
#endif
#define IN(k) (((PH_ENABLE >> (k)) & 1) && lo <= (k) && (k) < hi)
#define BOTH(k) (IN(k) && IN((k) + 1))

    if (IN(0)) {
        p0_prologue(C); if (BOTH(0)) GRID_SYNC(); }

    if (IN(1)) {
        if ((C.bid >> 3) & 1) { __builtin_amdgcn_s_sleep(127); __builtin_amdgcn_s_sleep(127); }
        {
            pg8::Gemm g{C.XN, C.WT1, C.XN, C.WT1, 2 * DM, 2 * DM, NTOK, 768, 2 * DM, 2 * DM};
            pg8::StaticOrder S; S.init(NTOK, 768, C.G, C.bid);
            EpiProj E{C.P, C.KB, C.VB, C.KI, C.WI, 0, 1.f};
            pg8::gemm_phase<EpiProj, pg8::StaticOrder, true>(C.lds, g, S, E);
        }
        {
            pg8::Gemm g{C.XN8, C.WT18, C.XN8, C.WT18, DM, DM, NTOK, 5120, DM, DM};
            pg8::SplitOrder S; S.init(NTOK, 5120, C.G, C.bid);
            EpiProj E{C.P, C.KB, C.VB, C.KI, C.WI, 1, 1.f / W8_SCALE};
            pg8::gemm_phase<EpiProj, pg8::SplitOrder, true, true>(C.lds, g, S, E);
        }
        if (BOTH(1)) GRID_SYNC();
    }

    if (IN(2)) {
        for (int u = C.bid; u < BATCH * 64; u += C.G) { const int bb = (u & 7) >> 1, pi = (u >> 3) + 32 * (u & 1); mixerB_unit<0>(C, bb, 127 - pi, C.Y8 + 512, 1024); mixerB_unit<0>(C, bb, pi, C.Y8 + 512, 1024); }
        {
            unsigned* actr = (unsigned*)(ws + WS_CTL) + 12288;
            volatile LAS unsigned* slot = (volatile LAS unsigned*)(C.lds + LDS_BYTES - 128);
            for (int li = 0; li < 8; ++li) {
                const int x = (C.bid + li) & 7;
                for (;;) {
                    __syncthreads();
                    if (C.tid == 0) *slot = __hip_atomic_fetch_add(actr + 16 * x, 1u, __ATOMIC_RELAXED, __HIP_MEMORY_SCOPE_AGENT);
                    __syncthreads();
                    const unsigned idx = *slot;
                    if (idx >= 64u) break;
                    const int u = x + 8 * (int)idx, uu = u & 255;
                    mixerA_unit<0>(C, (uu & 7) >> 1, 64 * (uu & 1) + (uu >> 3) + 32 * (u >> 8), C.Y8, 1024);
                }
            }
            __syncthreads();
        }
        if (BOTH(2)) GRID_SYNC();
    }

    if (IN(3)) {
        pg8::Gemm g{C.Y8, C.WAT, C.Y8 + 512, C.WBT, 1024, 512, NTOK, DM, 1024, 512};
        pg8::StaticOrder S; S.init(NTOK, DM, C.G, C.bid);
        if ((C.bid >> 3) & 1) __builtin_amdgcn_s_sleep(127);
        EpiMerge E{C.P, C.MG8};
        pg8::gemm_phase<EpiMerge, pg8::StaticOrder, true, true>(C.lds, g, S, E);
        if (BOTH(3)) GRID_SYNC();
    }

    if (IN(4)) {
        pg8::Gemm g{C.MG8, C.WOT, C.MG8, C.WOT, DM, DM, NTOK, DM, DM, DM};
        pg8::StaticOrder S; S.init(NTOK, DM, C.G, C.bid);
        { pg8::Unit u0_; if (S.next(0, u0_) && (u0_.pm & 1)) __builtin_amdgcn_s_sleep(127); }
        EpiOut E{C.XN, C.RSX, C.out, C.RSS, C.fgain, (unsigned*)(ws + WS_CTL) + 8192};
        pg8::gemm_phase<EpiOut, pg8::StaticOrder, true, true>(C.lds, g, S, E);
    }
#undef IN
#undef BOTH
}

extern "C" void kernel_launch(void* const* d_in, const int* in_sizes, int n_in, void* d_out, int out_size, void* d_ws, size_t ws_size, hipStream_t stream) {
    static int grid = 0;
    if (grid == 0) {
        if (n_in != 9 || in_sizes[0] != NTOK * DM || out_size != NTOK * DM || ws_size < WS_END) {
            fprintf(stderr, "kernel_launch: unexpected shapes (n_in %d, in0 %d, out %d, ws %zu)\n", n_in, n_in > 0 ? in_sizes[0] : -1, out_size, ws_size); grid = -1; return; }
        int dev = 0, cus = 0, per_cu = 0;
        if (hipGetDevice(&dev) != hipSuccess || hipDeviceGetAttribute(&cus, hipDeviceAttributeMultiprocessorCount, dev) != hipSuccess) { grid = -1; return; }
        if (hipFuncSetAttribute((const void*)fwd_kernel, hipFuncAttributeMaxDynamicSharedMemorySize, LDS_BYTES) != hipSuccess) { fprintf(stderr, "kernel_launch: hipFuncSetAttribute failed\n"); grid = -1; return; }
        if (hipOccupancyMaxActiveBlocksPerMultiprocessor(&per_cu, (const void*)fwd_kernel, NWAVES * 64, LDS_BYTES) != hipSuccess || per_cu < 1) { fprintf(stderr, "kernel_launch: occupancy query gives %d\n", per_cu); per_cu = 1; }
        (void)hipGetLastError();
        grid = cus;
    }
    if (grid < 0) return;
    Args a{};
    for (int i = 0; i < 9; ++i) a.in[i] = (const float*)d_in[i];
    a.out = (float*)d_out; a.ws = (unsigned char*)d_ws;
#if MK_ONE_LAUNCH
    a.ph_lo = 0; a.ph_hi = 5;
    if (hipMemsetAsync((char*)d_ws + WS_CTL, 0, 65536, stream) != hipSuccess) { fprintf(stderr, "kernel_launch: hipMemsetAsync failed\n"); return; }
    hipLaunchKernelGGL(fwd_kernel, dim3(grid), dim3(NWAVES * 64), LDS_BYTES, stream, a);
#else
    for (int ph = 0; ph < 5; ++ph) {
        a.ph_lo = ph; a.ph_hi = ph + 1;
        hipLaunchKernelGGL(fwd_kernel, dim3(grid), dim3(NWAVES * 64), LDS_BYTES, stream, a);
    }
#endif
}
```

```cpp
#include <hip/hip_runtime.h>
#include <cstdio>
#include <cstdint>

#ifndef MK_ONE_LAUNCH
#define MK_ONE_LAUNCH 1
#endif


#define LAS __attribute__((address_space(3)))
typedef unsigned short bf16_t;
typedef short bf16x8 __attribute__((ext_vector_type(8)));
typedef short s16x4 __attribute__((ext_vector_type(4)));
typedef float f32x4 __attribute__((ext_vector_type(4)));
typedef float f32x2 __attribute__((ext_vector_type(2)));
typedef int i32x4 __attribute__((ext_vector_type(4)));
typedef int i32x2 __attribute__((ext_vector_type(2)));
typedef float f32x16 __attribute__((ext_vector_type(16)));
typedef unsigned u32x4 __attribute__((ext_vector_type(4)));
typedef unsigned u32x2 __attribute__((ext_vector_type(2)));
typedef __bf16 bf16x2_t __attribute__((ext_vector_type(2)));

constexpr int BATCH = 4, SEQ = 8192, DM = 1024, NTOK = BATCH * SEQ;
constexpr int IN_COLS = 5832;
constexpr int PW = 5632;
constexpr int NW1 = 5888;
constexpr int C_QA = 0, C_KA = 512, C_VA = 1024, C_ZA = 1536, C_QB = 2048, C_ZB = 2560, C_QI = 3072, C_GA = 3584, C_GB = 4608;
constexpr float LOG2E = 1.4426950408889634f;
constexpr float QSC = 0.125f * LOG2E;
constexpr float IDX_SCALE = 0.04419417382415922f;
constexpr float EPS = 1e-6f;

constexpr size_t MiB = 1u << 20;
constexpr size_t WS_CTL = 0;
constexpr size_t WS_WT1 = 2 * MiB;
constexpr size_t WS_WT18 = 4 * MiB;
constexpr size_t WS_WAT = 14 * MiB;
constexpr size_t WS_WBT = 15 * MiB;
constexpr size_t WS_WOT = 16 * MiB;
constexpr size_t WS_KB = 18 * MiB;
constexpr size_t WS_VB = 22 * MiB;
constexpr size_t WS_KI = 26 * MiB;
constexpr size_t WS_WI = 30 * MiB;
constexpr size_t WS_RSS = 31 * MiB;
constexpr size_t WS_RSX = 31 * MiB + 512 * 1024;
constexpr size_t WS_XN = 32 * MiB;
constexpr size_t WS_P = 96 * MiB;
constexpr size_t WS_Y8 = 448 * MiB;
constexpr size_t WS_XN8 = 480 * MiB;
constexpr size_t WS_END = 512 * MiB;

constexpr int NWAVES = 8;
constexpr int LDS_BYTES = 163840;

__device__ __forceinline__ unsigned cvtpk(float lo, float hi) { f32x2 v = {lo, hi}; bf16x2_t b = __builtin_convertvector(v, bf16x2_t); return __builtin_bit_cast(unsigned, b); }
__device__ __forceinline__ float bf_lo(unsigned u) { return __uint_as_float(u << 16); }
__device__ __forceinline__ float bf_hi(unsigned u) { return __uint_as_float(u & 0xffff0000u); }
__device__ __forceinline__ float bf2f(bf16_t b) { return __uint_as_float((unsigned)b << 16); }
__device__ __forceinline__ bf16_t f2bf(float f) { return (bf16_t)(cvtpk(f, 0.f) & 0xffffu); }
__device__ __forceinline__ float fast_sigmoid(float x) { return __builtin_amdgcn_rcpf(1.f + __builtin_amdgcn_exp2f(-x * LOG2E)); }
typedef int i32x8 __attribute__((ext_vector_type(8)));
typedef unsigned char fp8_t;
constexpr float Y8_SCALE = 64.f, W8_SCALE = 32.f;
constexpr float ACC8_UNSCALE = 1.f / (64.f * 32.f);
__device__ __forceinline__ unsigned pk4_fp8_raw(float a, float b, float c, float d) { int p = __builtin_amdgcn_cvt_pk_fp8_f32(a, b, 0, false); p = __builtin_amdgcn_cvt_pk_fp8_f32(c, d, p, true); return (unsigned)p; }
__device__ __forceinline__ float sat8(float x) { return __builtin_amdgcn_fmed3f(x, -448.f, 448.f); }
__device__ __forceinline__ unsigned pk4_fp8(float a, float b, float c, float d) { return pk4_fp8_raw(sat8(a), sat8(b), sat8(c), sat8(d)); }
__device__ __forceinline__ float wave_sum(float v) {
#pragma unroll
    for (int o = 32; o >= 1; o >>= 1) v += __shfl_xor(v, o);
    return v;
}
__device__ __forceinline__ float wave_max(float v) {
#pragma unroll
    for (int o = 32; o >= 1; o >>= 1) v = fmaxf(v, __shfl_xor(v, o));
    return v;
}
__device__ __forceinline__ int wave_sum_i(int v) {
#pragma unroll
    for (int o = 32; o >= 1; o >>= 1) v += __shfl_xor(v, o);
    return v;
}
__device__ __forceinline__ float xmax16(float m) { auto r = __builtin_amdgcn_permlane16_swap(__float_as_uint(m), __float_as_uint(m), false, false); return fmaxf(__uint_as_float(r[0]), __uint_as_float(r[1])); }
__device__ __forceinline__ float xmax32(float m) { auto r = __builtin_amdgcn_permlane32_swap(__float_as_uint(m), __float_as_uint(m), false, false); return fmaxf(__uint_as_float(r[0]), __uint_as_float(r[1])); }
__device__ __forceinline__ float xsum16(float m) { auto r = __builtin_amdgcn_permlane16_swap(__float_as_uint(m), __float_as_uint(m), false, false); return __uint_as_float(r[0]) + __uint_as_float(r[1]); }
__device__ __forceinline__ float xsum32(float m) { auto r = __builtin_amdgcn_permlane32_swap(__float_as_uint(m), __float_as_uint(m), false, false); return __uint_as_float(r[0]) + __uint_as_float(r[1]); }
template <int CTRL, int ROWMASK> __device__ __forceinline__ unsigned dpp_u(unsigned old, unsigned src) { return (unsigned)__builtin_amdgcn_update_dpp((int)old, (int)src, CTRL, ROWMASK, 0xf, false); }
__device__ __forceinline__ int crow(int r, int hi) { return (r & 3) + 8 * (r >> 2) + 4 * hi; }

namespace pg8 {
constexpr int BM = 256, BK = 64, HALF = 128, HTB = HALF * BK * 2, STAGE_BYTES = 8 * HTB, NXCD = 8, WGM = 8;
__host__ __device__ __forceinline__ int lds_byte(int r, int c) { const int st = (r >> 4) * 2 + (c >> 5), rr = r & 15, cc = c & 31, ob = rr * 64 + cc * 2; return st * 1024 + (ob ^ (((ob >> 9) & 1) << 5)); }
__host__ __device__ __forceinline__ void stage_rc(int b, int& R, int& C) { const int st = b / 1024, sb = b % 1024, swz = sb ^ (((sb >> 9) & 1) << 5); R = (st >> 1) * 16 + swz / 64; C = (st & 1) * 32 + (swz % 64) / 2; }
__host__ __device__ __forceinline__ int perm32(int rho) { const int n = rho >> 4, i = rho & 15; return 8 * (i >> 2) + 4 * n + (i & 3); }

struct Unit { int pm, pn; };
struct Gemm { const void* A; const void* Bt; const void* A2; const void* Bt2; int lda, ldb, M, N, K, K1; };

struct StaticOrder {
    int nM, nN, nwg, G, c;
    __host__ __device__ void init(int M, int N, int G_, int c_) { nM = M / BM; nN = N / BM; nwg = nM * nN; G = G_; c = c_; }
    __host__ __device__ bool next(int i, Unit& u) const { const long L = (long)i * G + c; if (L >= nwg) return false; map((int)L, u); return true; }
    __host__ __device__ void map(int L, Unit& u) const {
        int wgid = L; { const int q = nwg / NXCD, r = nwg % NXCD, xcd = wgid % NXCD, off = wgid / NXCD; wgid = (xcd < r ? xcd * (q + 1) : r * (q + 1) + (xcd - r) * q) + off; }
        const int nig = WGM * nN, gid = wgid / nig, fm = gid * WGM, gsz = (nM - fm) < WGM ? (nM - fm) : WGM;
        u.pm = fm + ((wgid % nig) % gsz); u.pn = (wgid % nig) / gsz;
    }
};
struct SplitOrder {
    StaticOrder so;
    __host__ __device__ void init(int M, int N, int G_, int c_) { so.init(M, N, G_, c_); }
    __host__ __device__ bool next(int i, Unit& u) const {
        if (so.G != 256 || so.nwg != 2560) return so.next(i, u);
        int L;
        if (i < 9) L = i * 256 + so.c;
        else if (so.c >= 128 && i < 11) L = 2304 + (i - 9) * 128 + (so.c - 128);
        else return false;
        so.map(L, u); return true;
    }
};

template <class Epi, class Sched, bool ALIGN_EPI, bool FP8 = false>
__device__ __forceinline__ void gemm_phase(LAS unsigned char* lds, const Gemm g, const Sched& S, const Epi& E) {
    const int tid = threadIdx.x, wid = __builtin_amdgcn_readfirstlane(tid >> 6), lane = tid & 63, wr = wid >> 2, wc = wid & 3, fr = lane & 15, fq = lane >> 4;
    const int nt = g.K / (2 * BK), nt1 = g.K1 / (2 * BK);
    unsigned voffA[2], voffB[2];
#pragma unroll
    for (int i = 0; i < 2; ++i) { int R, C; stage_rc(tid * 16 + i * 8192, R, C); const int Rb = Epi::PERM ? ((R & ~31) + perm32(R & 31)) : R;
        voffA[i] = (unsigned)(R * g.lda + 2 * C); voffB[i] = (unsigned)(Rb * g.ldb + 2 * C); }
    const size_t kstep = (size_t)(BK * 2);
    const size_t hstepA = (size_t)HALF * g.lda, hstepB = (size_t)HALF * g.ldb;
    const size_t tstepA = 2 * hstepA, tstepB = 2 * hstepB;
    const unsigned ldsw = (unsigned)wid * 1024u;
    const int aoff = lds_byte(wr * 64 + fr, fq * 8), boff = lds_byte(wc * 32 + fr, fq * 8);
#define PG8_SA(b, h) (((b) * 2 + (h)) * HTB)
#define PG8_SB(b, h) ((4 + (b) * 2 + (h)) * HTB)
#define PG8_STAGE(bufoff, gbase, voff) do { _Pragma("unroll") for (int _i = 0; _i < 2; ++_i) \
        __builtin_amdgcn_global_load_lds((const unsigned*)((const char*)(gbase) + (voff)[_i]), (LAS unsigned*)(lds + (bufoff) + ldsw + _i * 8192), 16, 0, 0); } while (0)
#define PG8_LD8(addr_) __builtin_shufflevector(*(const LAS i32x4*)(addr_), *(const LAS i32x4*)((addr_) + 1024), 0, 1, 2, 3, 4, 5, 6, 7)
#define PG8_LDA(dst, b, h) do { _Pragma("unroll") for (int m = 0; m < 4; ++m) dst[m] = PG8_LD8(lds + PG8_SA(b, h) + aoff + m * 2048); } while (0)
#define PG8_LDB(dst, b, h) do { _Pragma("unroll") for (int n = 0; n < 2; ++n) dst[n] = PG8_LD8(lds + PG8_SB(b, h) + boff + n * 2048); } while (0)
#define PG8_LO(x_) __builtin_bit_cast(bf16x8, __builtin_shufflevector((x_), (x_), 0, 1, 2, 3))
#define PG8_HI(x_) __builtin_bit_cast(bf16x8, __builtin_shufflevector((x_), (x_), 4, 5, 6, 7))
#define PG8_MMA(ai, bj, At, Bt) do { __builtin_amdgcn_s_setprio(1); \
        if constexpr (FP8) { asm volatile("s_nop 1"); _Pragma("unroll") for (int m = 0; m < 4; ++m) _Pragma("unroll") for (int n = 0; n < 2; ++n) \
            asm volatile("v_mfma_f32_16x16x128_f8f6f4 %0, %1, %2, %0" : "+v"(acc[ai][bj][m][n]) : "v"(Bt[n]), "v"(At[m])); }   \
        else { _Pragma("unroll") for (int m = 0; m < 4; ++m) _Pragma("unroll") for (int n = 0; n < 2; ++n) { \
            acc[ai][bj][m][n] = __builtin_amdgcn_mfma_f32_16x16x32_bf16(PG8_LO(Bt[n]), PG8_LO(At[m]), acc[ai][bj][m][n], 0, 0, 0); \
            acc[ai][bj][m][n] = __builtin_amdgcn_mfma_f32_16x16x32_bf16(PG8_HI(Bt[n]), PG8_HI(At[m]), acc[ai][bj][m][n], 0, 0, 0); } } \
        __builtin_amdgcn_s_setprio(0); } while (0)
#define PG8_WAIT_V(n) asm volatile("s_waitcnt vmcnt(" #n ")" ::: "memory")
#define PG8_WAIT_L(n) asm volatile("s_waitcnt lgkmcnt(" #n ")" ::: "memory")
#define PG8_BAR __builtin_amdgcn_s_barrier()
#define PG8_SCHED __builtin_amdgcn_sched_barrier(0)
#define PG8_KT(b1, b2, t) ((t) < nt1 ? (b1) + (size_t)(t) * kstep : (b2) + (size_t)((t) - nt1) * kstep)
    Unit cur, nxt; int ui = 0;
    if (!S.next(0, cur)) return;
    f32x4 acc[2][2][4][2];
#pragma unroll
    for (int a = 0; a < 2; ++a)
#pragma unroll
        for (int b = 0; b < 2; ++b)
#pragma unroll
            for (int m = 0; m < 4; ++m)
#pragma unroll
                for (int n = 0; n < 2; ++n) acc[a][b][m][n] = (f32x4){0.f, 0.f, 0.f, 0.f};
    i32x8 At[4], B0[2], B1[2];
    const char* cA = (const char*)g.A + (size_t)cur.pm * tstepA; const char* cB = (const char*)g.Bt + (size_t)cur.pn * tstepB;
    const char* cA2 = (const char*)g.A2 + (size_t)cur.pm * tstepA; const char* cB2 = (const char*)g.Bt2 + (size_t)cur.pn * tstepB;
    PG8_STAGE(PG8_SB(0, 0), cB, voffB); PG8_STAGE(PG8_SB(0, 1), cB + hstepB, voffB); PG8_STAGE(PG8_SA(0, 0), cA, voffA); PG8_STAGE(PG8_SA(0, 1), cA + hstepA, voffA);
    if (wr == 1) PG8_BAR;
    PG8_WAIT_V(2); PG8_BAR;
    PG8_STAGE(PG8_SB(1, 0), cB + kstep, voffB); PG8_STAGE(PG8_SA(1, 0), cA + kstep, voffA); PG8_STAGE(PG8_SB(1, 1), cB + hstepB + kstep, voffB);
    PG8_WAIT_V(6); PG8_BAR;
    for (;;) {
        const bool has_next = S.next(ui + 1, nxt);
        const char* nA = has_next ? (const char*)g.A + (size_t)nxt.pm * tstepA : cA; const char* nB = has_next ? (const char*)g.Bt + (size_t)nxt.pn * tstepB : cB;
        for (int seg = 0; seg < 2; ++seg) {
        const int tb = seg ? nt1 : 0, te = seg ? nt : nt1;
        if (seg && tb < te) { PG8_SCHED; if constexpr (FP8) asm volatile("s_nop 15\n\ts_nop 15" ::: "memory"); E.mid(acc, cur, wr, wc, fr, fq); PG8_SCHED; }
        for (int t = tb; t < te; t += 2) {
            const bool last = (t == nt - 2);
            const char* a1 = PG8_KT(cA, cA2, t + 1);
            const char* a2 = last ? nA : PG8_KT(cA, cA2, t + 2); const char* b2 = last ? nB : PG8_KT(cB, cB2, t + 2);
            const char* a3 = a2 + kstep; const char* b3 = b2 + kstep;
            PG8_LDB(B0, 0, 0); PG8_LDB(B1, 0, 1); PG8_SCHED; PG8_LDA(At, 0, 0); PG8_STAGE(PG8_SA(1, 1), a1 + hstepA, voffA);
            PG8_WAIT_V(8); PG8_WAIT_L(0); PG8_BAR; PG8_MMA(0, 0, At, B0); PG8_MMA(0, 1, At, B1); PG8_BAR; PG8_SCHED;
            PG8_LDA(At, 0, 1); PG8_STAGE(PG8_SB(0, 0), b2, voffB); PG8_STAGE(PG8_SB(0, 1), b2 + hstepB, voffB); PG8_STAGE(PG8_SA(0, 0), a2, voffA);
            PG8_WAIT_V(8); PG8_WAIT_L(0); PG8_BAR; PG8_MMA(1, 0, At, B0); PG8_MMA(1, 1, At, B1); PG8_BAR; PG8_SCHED;
            PG8_LDB(B0, 1, 0); PG8_LDB(B1, 1, 1); PG8_SCHED; PG8_LDA(At, 1, 0); PG8_STAGE(PG8_SA(0, 1), a2 + hstepA, voffA);
            PG8_WAIT_V(8); PG8_WAIT_L(0); PG8_BAR; PG8_MMA(0, 0, At, B0); PG8_MMA(0, 1, At, B1); PG8_BAR; PG8_SCHED;
            PG8_LDA(At, 1, 1); PG8_STAGE(PG8_SB(1, 0), b3, voffB); PG8_STAGE(PG8_SB(1, 1), b3 + hstepB, voffB); PG8_STAGE(PG8_SA(1, 0), a3, voffA);
            PG8_WAIT_V(8); PG8_WAIT_L(0); PG8_BAR; PG8_MMA(1, 0, At, B0); PG8_MMA(1, 1, At, B1); PG8_BAR; PG8_SCHED;
        }
        }
        if constexpr (ALIGN_EPI) { if (wr == 0) PG8_BAR; }
        if constexpr (FP8) asm volatile("s_nop 15\n\ts_nop 15" ::: "memory");
        E(acc, cur, wr, wc, fr, fq);
        if (!has_next) break;
#pragma unroll
        for (int a = 0; a < 2; ++a)
#pragma unroll
            for (int b = 0; b < 2; ++b)
#pragma unroll
                for (int m = 0; m < 4; ++m)
#pragma unroll
                    for (int n = 0; n < 2; ++n) { float z_ = 0.f; asm volatile("" : "+v"(z_)); acc[a][b][m][n] = (f32x4){z_, z_, z_, z_}; }
        cur = nxt; cA = nA; cB = nB; ++ui;
        cA2 = (const char*)g.A2 + (size_t)cur.pm * tstepA; cB2 = (const char*)g.Bt2 + (size_t)cur.pn * tstepB;
        if constexpr (ALIGN_EPI) { if (wr == 1) PG8_BAR; }
    }
    PG8_WAIT_V(0);
    if constexpr (!ALIGN_EPI) { if (wr == 0) PG8_BAR; }
    PG8_BAR;
#undef PG8_SA
#undef PG8_SB
#undef PG8_STAGE
#undef PG8_LDA
#undef PG8_LDB
#undef PG8_MMA
#undef PG8_LD8
#undef PG8_LO
#undef PG8_HI
#undef PG8_WAIT_V
#undef PG8_WAIT_L
#undef PG8_BAR
#undef PG8_SCHED
#undef PG8_KT
}
}

struct EpiProj {
    static constexpr bool PERM = true;
    bf16_t* P; bf16_t* KB; bf16_t* VB; bf16_t* KI; float* WI; int part; float ascale;
    __device__ __forceinline__ void mid(f32x4 (&)[2][2][4][2], const pg8::Unit&, int, int, int, int) const {}
    __device__ __forceinline__ void operator()(const f32x4 (&acc)[2][2][4][2], const pg8::Unit& u, int wr, int wc, int fr, int fq) const {
        const int row0 = u.pm * 256 + wr * 64 + fr;
        const int pn = part ? (u.pn < 12 ? u.pn : u.pn + 2) : (u.pn < 2 ? 12 + u.pn : 22);
        if (pn < 22) {
            int mode = 0; float sc = ascale;
            if (pn < 2 || pn == 8 || pn == 9) sc = QSC * ascale;
            else if (pn == 6 || pn == 7 || pn == 10 || pn == 11) mode = 1;
            else if (pn >= 14) mode = 2;
            const int col0 = pn * 256 + wc * 32 + 8 * fq;
            const float c2 = -sc * LOG2E;
#define EPI_BODY(EXPR_) do { _Pragma("unroll") for (int ai = 0; ai < 2; ++ai) _Pragma("unroll") for (int m = 0; m < 4; ++m) { \
                bf16_t* rowp = P + (size_t)(row0 + ai * 128 + m * 16) * PW + col0; \
                _Pragma("unroll") for (int bj = 0; bj < 2; ++bj) { float v[8]; \
                    _Pragma("unroll") for (int e = 0; e < 4; ++e) { v[e] = acc[ai][bj][m][0][e]; v[4 + e] = acc[ai][bj][m][1][e]; } \
                    _Pragma("unroll") for (int e = 0; e < 8; ++e) { float x = v[e]; EXPR_; asm("" : "+v"(x)); v[e] = x; } \
                    u32x4 w; w.x = cvtpk(v[0], v[1]); w.y = cvtpk(v[2], v[3]); w.z = cvtpk(v[4], v[5]); w.w = cvtpk(v[6], v[7]); \
                    *(u32x4*)(rowp + bj * 128) = w; } } } while (0)
            if (mode == 0) EPI_BODY(x = x * sc);
            else if (mode == 1) EPI_BODY({ float e_ = __builtin_amdgcn_exp2f(x * c2); asm("" : "+v"(e_)); e_ = __builtin_amdgcn_rcpf(1.f + e_); asm("" : "+v"(e_)); x = x * sc; asm("" : "+v"(x)); x = x * e_; });
            else {
                const int gcol0 = (pn - 14) * 256 + wc * 32 + 8 * fq;
#pragma unroll
                for (int ai = 0; ai < 2; ++ai)
#pragma unroll
                    for (int m = 0; m < 4; ++m) {
                        unsigned char* rowp = (unsigned char*)(P + (size_t)(row0 + ai * 128 + m * 16) * PW + C_GA) + gcol0;
#pragma unroll
                        for (int bj = 0; bj < 2; ++bj) {
                            u32x2 w = (u32x2){0u, 0u};
#pragma unroll
                            for (int e = 0; e < 8; ++e) {
                                float x = acc[ai][bj][m][e >> 2][e & 3];
                                float e_ = __builtin_amdgcn_exp2f(x * c2); asm("" : "+v"(e_));
                                x = __builtin_fmaf(__builtin_amdgcn_rcpf(1.f + e_), 254.f, 1.f); asm("" : "+v"(x));
                                if (e < 4) w.x = __builtin_amdgcn_cvt_pk_u8_f32(x, e & 3, w.x); else w.y = __builtin_amdgcn_cvt_pk_u8_f32(x, e & 3, w.y);
                            }
                            *(u32x2*)(rowp + bj * 128) = w;
                        }
                    }
            }
#undef EPI_BODY
        } else {
#pragma unroll
            for (int ai = 0; ai < 2; ++ai)
#pragma unroll
                for (int m = 0; m < 4; ++m) {
                    const size_t row = (size_t)(row0 + ai * 128 + m * 16);
                    {
                        const f32x4 a = acc[ai][0][m][0], b = acc[ai][0][m][1];
                        u32x4 w; w.x = cvtpk(a[0], a[1]); w.y = cvtpk(a[2], a[3]); w.z = cvtpk(b[0], b[1]); w.w = cvtpk(b[2], b[3]);
                        if (wc < 2) {
                            u32x2 w8; w8.x = pk4_fp8(a[0], a[1], a[2], a[3]); w8.y = pk4_fp8(b[0], b[1], b[2], b[3]);
                            *(u32x2*)((fp8_t*)KB + row * 64 + fq * 16 + wc * 8) = w8;
                        } else {
                            u32x2 w8; w8.x = pk4_fp8(a[0], a[1], a[2], a[3]); w8.y = pk4_fp8(b[0], b[1], b[2], b[3]);
                            *(u32x2*)((fp8_t*)VB + row * 64 + (wc - 2) * 32 + 8 * fq) = w8;
                        }
                    }
                    {
                        const f32x4 a = acc[ai][1][m][0], b = acc[ai][1][m][1];
                        if (wc < 2) {
                            u32x4 w; w.x = cvtpk(a[0], a[1]); w.y = cvtpk(a[2], a[3]); w.z = cvtpk(b[0], b[1]); w.w = cvtpk(b[2], b[3]);
                            *(u32x4*)(KI + row * 64 + wc * 32 + 8 * fq) = w;
                        } else if (wc == 2 && fq == 0) {
                            *(f32x4*)(WI + row * 8) = a * IDX_SCALE; *(f32x4*)(WI + row * 8 + 4) = b * IDX_SCALE;
                        }
                    }
                }
        }
    }
};

__device__ __forceinline__ u32x4 buf_load16(__amdgpu_buffer_rsrc_t r, unsigned voff, unsigned soff) { return __builtin_bit_cast(u32x4, __builtin_amdgcn_raw_buffer_load_b128(r, (int)voff, (int)soff, 0)); }
__device__ __forceinline__ void buf_store16(__amdgpu_buffer_rsrc_t r, unsigned voff, unsigned soff, u32x4 v) { __builtin_amdgcn_raw_buffer_store_b128(v, r, (int)voff, (int)soff, 0); }
struct EpiMerge {
    static constexpr bool PERM = true;
    const bf16_t* P; fp8_t* MG;
    static __device__ __forceinline__ float ub(unsigned w, int k) { return (float)((w >> (8 * k)) & 0xffu); }
    __device__ __forceinline__ void mid(f32x4 (&acc)[2][2][4][2], const pg8::Unit& u, int wr, int wc, int fr, int fq) const {
        { int l_ = (int)(threadIdx.x & 63u); asm volatile("" : "+v"(l_)); fr = l_ & 15; fq = l_ >> 4; }
        const __amdgpu_buffer_rsrc_t rp = __builtin_amdgcn_make_buffer_rsrc((void*)P, (short)0, (int)((size_t)NTOK * PW * 2), 0x00020000);
        const unsigned voff = (unsigned)(fr * PW * 2 + 8 * fq);
#pragma unroll
        for (int ai = 0; ai < 2; ++ai) {
            u32x2 sa[4][2], sb[4][2];
#pragma unroll
            for (int m = 0; m < 4; ++m) {
                const unsigned soff = (unsigned)(u.pm * 256 + wr * 64 + ai * 128 + m * 16) * (unsigned)(PW * 2) + (unsigned)(2 * C_GA + u.pn * 256 + wc * 32);
#pragma unroll
                for (int bj = 0; bj < 2; ++bj) {
                    sa[m][bj] = __builtin_bit_cast(u32x2, __builtin_amdgcn_raw_buffer_load_b64(rp, (int)voff, (int)(soff + bj * 128), 0));
                    sb[m][bj] = __builtin_bit_cast(u32x2, __builtin_amdgcn_raw_buffer_load_b64(rp, (int)voff, (int)(soff + 1024 + bj * 128), 0));
                }
            }
#pragma unroll
            for (int m = 0; m < 4; ++m)
#pragma unroll
                for (int bj = 0; bj < 2; ++bj)
#pragma unroll
                    for (int d = 0; d < 2; ++d)
#pragma unroll
                        for (int k = 0; k < 4; ++k) acc[ai][bj][m][d][k] *= ub(sa[m][bj][d], k) * __builtin_amdgcn_rcpf(ub(sb[m][bj][d], k));
            asm volatile("" ::: "memory");
        }
    }
    __device__ __forceinline__ void operator()(const f32x4 (&acc)[2][2][4][2], const pg8::Unit& u, int wr, int wc, int fr, int fq) const {
        { int l_ = (int)(threadIdx.x & 63u); asm volatile("" : "+v"(l_)); fr = l_ & 15; fq = l_ >> 4; }
        const __amdgpu_buffer_rsrc_t rp = __builtin_amdgcn_make_buffer_rsrc((void*)P, (short)0, (int)((size_t)NTOK * PW * 2), 0x00020000);
        const __amdgpu_buffer_rsrc_t ro = __builtin_amdgcn_make_buffer_rsrc((void*)MG, (short)0, (int)((size_t)NTOK * DM), 0x00020000);
        const unsigned voff = (unsigned)(fr * PW * 2 + 8 * fq), voffo = (unsigned)(fr * DM + 8 * fq);
        constexpr float c8 = Y8_SCALE * ACC8_UNSCALE * (1.f / 255.f);
#pragma unroll
        for (int ai = 0; ai < 2; ++ai) {
            u32x2 sb[4][2];
#pragma unroll
            for (int m = 0; m < 4; ++m) {
                const unsigned soff = (unsigned)(u.pm * 256 + wr * 64 + ai * 128 + m * 16) * (unsigned)(PW * 2) + (unsigned)(2 * C_GA + 1024 + u.pn * 256 + wc * 32);
#pragma unroll
                for (int bj = 0; bj < 2; ++bj) sb[m][bj] = __builtin_bit_cast(u32x2, __builtin_amdgcn_raw_buffer_load_b64(rp, (int)voff, (int)(soff + bj * 128), 0));
            }
#pragma unroll
            for (int m = 0; m < 4; ++m) {
                const unsigned soffo = (unsigned)(u.pm * 256 + wr * 64 + ai * 128 + m * 16) * (unsigned)DM + (unsigned)(u.pn * 256 + wc * 32);
#pragma unroll
                for (int bj = 0; bj < 2; ++bj) {
                    const f32x4 a = acc[ai][bj][m][0], b = acc[ai][bj][m][1];
                    const u32x2 g = sb[m][bj];
                    u32x2 w;
                    w.x = pk4_fp8(a[0] * ub(g.x, 0) * c8, a[1] * ub(g.x, 1) * c8, a[2] * ub(g.x, 2) * c8, a[3] * ub(g.x, 3) * c8);
                    w.y = pk4_fp8(b[0] * ub(g.y, 0) * c8, b[1] * ub(g.y, 1) * c8, b[2] * ub(g.y, 2) * c8, b[3] * ub(g.y, 3) * c8);
                    __builtin_amdgcn_raw_buffer_store_b64(w, ro, (int)voffo, (int)(soffo + bj * 128), 0);
                }
            }
            asm volatile("" ::: "memory");
        }
    }
};

struct EpiOut {
    static constexpr bool PERM = false;
    const bf16_t* XN; const float* RSX; float* O; float* RSS; const float* G; unsigned* CNT;
    __device__ __forceinline__ void mid(f32x4 (&)[2][2][4][2], const pg8::Unit&, int, int, int, int) const {}
    __device__ __forceinline__ void operator()(f32x4 (&acc)[2][2][4][2], const pg8::Unit& u, int wr, int wc, int fr, int fq) const {
        { int l_ = (int)(threadIdx.x & 63u); asm volatile("" : "+v"(l_)); fr = l_ & 15; fq = l_ >> 4; }
        const int col0 = u.pn * 256 + wc * 32 + 4 * fq;
#pragma unroll
        for (int ai = 0; ai < 2; ++ai) {
            u32x2 xv[4][2][2]; float rx[4];
#pragma unroll
            for (int m = 0; m < 4; ++m) {
                const int row = u.pm * 256 + ai * 128 + wr * 64 + m * 16 + fr;
                const size_t off = (size_t)row * DM + col0;
                rx[m] = RSX[row];
#pragma unroll
                for (int bj = 0; bj < 2; ++bj)
#pragma unroll
                    for (int n = 0; n < 2; ++n) xv[m][bj][n] = *(const u32x2*)(XN + off + bj * 128 + n * 16);
            }
#pragma unroll
            for (int m = 0; m < 4; ++m) {
                const int row = u.pm * 256 + ai * 128 + wr * 64 + m * 16 + fr;
                float ss = 0.f;
#pragma unroll
                for (int bj = 0; bj < 2; ++bj)
#pragma unroll
                    for (int n = 0; n < 2; ++n) {
                        const u32x2 xb = xv[m][bj][n];
                        const f32x4 hv = (f32x4){bf_lo(xb.x), bf_hi(xb.x), bf_lo(xb.y), bf_hi(xb.y)} * rx[m] + acc[ai][bj][m][n] * ACC8_UNSCALE;
                        ss += (hv[0] * hv[0] + hv[1] * hv[1]) + (hv[2] * hv[2] + hv[3] * hv[3]);
                        acc[ai][bj][m][n] = hv;
                    }
                ss += __shfl_xor(ss, 16); ss += __shfl_xor(ss, 32);
                if (fq == 0) atomicAdd(RSS + row, ss);
            }
            asm volatile("" ::: "memory");
        }
        asm volatile("s_waitcnt vmcnt(0)" ::: "memory");
        unsigned* cnt = CNT + 16 * u.pm;
        if ((threadIdx.x & 63) == 0) (void)__hip_atomic_fetch_add(cnt, 1u, __ATOMIC_RELAXED, __HIP_MEMORY_SCOPE_AGENT);
        for (unsigned sp = 0; sp < (1u << 22); ++sp) {
            const unsigned c = (unsigned)__builtin_amdgcn_readfirstlane((int)__hip_atomic_load(cnt, __ATOMIC_RELAXED, __HIP_MEMORY_SCOPE_AGENT));
            if (c >= 32u) break;
            __builtin_amdgcn_s_sleep(1);
        }
        float tot[2][4];
#pragma unroll
        for (int ai = 0; ai < 2; ++ai)
#pragma unroll
            for (int m = 0; m < 4; ++m) {
                const int row = u.pm * 256 + ai * 128 + wr * 64 + m * 16 + fr;
                tot[ai][m] = 0.f;
                if (fq == 0) tot[ai][m] = __hip_atomic_fetch_add(RSS + row, 0.f, __ATOMIC_RELAXED, __HIP_MEMORY_SCOPE_AGENT);
            }
        f32x4 gg[2][2];
#pragma unroll
        for (int bj = 0; bj < 2; ++bj)
#pragma unroll
            for (int n = 0; n < 2; ++n) gg[bj][n] = *(const f32x4*)(G + col0 + bj * 128 + n * 16);
#pragma unroll
        for (int ai = 0; ai < 2; ++ai)
#pragma unroll
            for (int m = 0; m < 4; ++m) {
                const int row = u.pm * 256 + ai * 128 + wr * 64 + m * 16 + fr;
                const size_t off = (size_t)row * DM + col0;
                const float t = __shfl(tot[ai][m], fr);
                const float rs = __builtin_amdgcn_rsqf(t * (1.f / DM) + EPS);
#pragma unroll
                for (int bj = 0; bj < 2; ++bj)
#pragma unroll
                    for (int n = 0; n < 2; ++n) *(f32x4*)(O + off + bj * 128 + n * 16) = acc[ai][bj][m][n] * rs * gg[bj][n];
            }
    }
};

struct Ctx {
    LAS unsigned char* lds;
    int tid, lane, wave, G, bid;
    const float *x, *norm_gain, *w_in, *a_rel, *t5, *w_a, *w_b, *w_o, *fgain;
    float* out;
    bf16_t *WT1, *KB, *VB, *KI, *XN, *P;
    fp8_t *WAT, *WBT, *WOT, *Y8, *MG8, *WT18, *XN8;
    float *WI, *RSS, *RSX;
    unsigned long long dbg;
};

__device__ __forceinline__ int proj_src_col(int d0, int& nvalid) {
    nvalid = 32;
    if (d0 < 2560) return d0;
    if (d0 < 3072) return d0 - 2560 + 2688;
    if (d0 < 3584) return d0 - 3072 + 3200;
    if (d0 < 5632) return d0 - 3584 + 3784;
    if (d0 < 5760) return d0 - 5632 + 2560;
    if (d0 < 5824) return d0 - 5760 + 3712;
    if (d0 == 5824) { nvalid = 8; return 3776; }
    nvalid = 0; return 0;
}
__device__ __forceinline__ void transpose_item(const float* W, int ldw, int src_n0, int nvalid, const float* gain, bf16_t* WT, int K, int dst_row0, int k0, LAS float* scr, int lane) {
#pragma unroll 8
    for (int i = 0; i < 32; ++i) {
        const int kk = 2 * i + (lane >> 5), col = lane & 31;
        float v = 0.f;
        if (col < nvalid) { v = W[(size_t)(k0 + kk) * ldw + src_n0 + col]; if (gain) v *= gain[k0 + kk]; }
        scr[kk * 33 + col] = v;
    }
    asm volatile("s_waitcnt lgkmcnt(0)" ::: "memory");
    const int c = lane & 7;
#pragma unroll
    for (int j = 0; j < 4; ++j) {
        const int n = (lane >> 3) + 8 * j; const LAS float* s = scr + (8 * c) * 33 + n;
        u32x4 o; o.x = cvtpk(s[0 * 33], s[1 * 33]); o.y = cvtpk(s[2 * 33], s[3 * 33]); o.z = cvtpk(s[4 * 33], s[5 * 33]); o.w = cvtpk(s[6 * 33], s[7 * 33]);
        *(u32x4*)(WT + (size_t)(dst_row0 + n) * K + k0 + 8 * c) = o;
    }
    asm volatile("s_waitcnt lgkmcnt(0)" ::: "memory");
}
__device__ __forceinline__ void transpose_item8(const float* W, int ldw, int src_n0, const float* gain, fp8_t* WT, int K, int dst_row0, int k0, LAS float* scr, int lane) {
#pragma unroll 8
    for (int i = 0; i < 32; ++i) {
        const int kk = 2 * i + (lane >> 5), col = lane & 31;
        float v = W[(size_t)(k0 + kk) * ldw + src_n0 + col] * W8_SCALE; if (gain) v *= gain[k0 + kk];
        scr[kk * 33 + col] = v;
    }
    asm volatile("s_waitcnt lgkmcnt(0)" ::: "memory");
    const int c = lane & 7;
#pragma unroll
    for (int j = 0; j < 4; ++j) {
        const int n = (lane >> 3) + 8 * j; const LAS float* s = scr + (8 * c) * 33 + n;
        u32x2 o; o.x = pk4_fp8(s[0 * 33], s[1 * 33], s[2 * 33], s[3 * 33]); o.y = pk4_fp8(s[4 * 33], s[5 * 33], s[6 * 33], s[7 * 33]);
        *(u32x2*)(WT + (size_t)(dst_row0 + n) * K + k0 + 8 * c) = o;
    }
    asm volatile("s_waitcnt lgkmcnt(0)" ::: "memory");
}
__device__ __forceinline__ void p0_prologue(Ctx& C) {
    LAS float* scr = (LAS float*)(C.lds + C.wave * 16384);
    const int gw = C.bid * NWAVES + C.wave, NGW = C.G * NWAVES;
    constexpr int I_IN = 16 * (NW1 / 32), I_A = 8 * 32, I_O = 16 * 32, NITEMS = I_IN + 2 * I_A + I_O;
    for (int it = gw; it < NITEMS; it += NGW) {
        int r = it;
        if (r < I_IN) { const int kb = r / (NW1 / 32), nb = r % (NW1 / 32); int nv; const int sc = proj_src_col(nb * 32, nv);
            const int dt = nb >> 3, drow = (nb & 7) * 32;
            if (dt == 12 || dt == 13 || dt == 22) transpose_item(C.w_in, IN_COLS, sc, nv, C.norm_gain, C.WT1, DM, (dt == 22 ? 512 : (dt - 12) * 256) + drow, kb * 64, scr, C.lane);
            else transpose_item8(C.w_in, IN_COLS, sc, C.norm_gain, C.WT18, DM, (dt < 12 ? dt : dt - 2) * 256 + drow, kb * 64, scr, C.lane);
            continue; }
        r -= I_IN;
        if (r < I_A) { transpose_item8(C.w_a, DM, (r % 32) * 32, nullptr, C.WAT, 512, (r % 32) * 32, (r / 32) * 64, scr, C.lane); continue; }
        r -= I_A;
        if (r < I_A) { transpose_item8(C.w_b, DM, (r % 32) * 32, nullptr, C.WBT, 512, (r % 32) * 32, (r / 32) * 64, scr, C.lane); continue; }
        r -= I_A;
        transpose_item8(C.w_o, DM, (r % 32) * 32, nullptr, C.WOT, DM, (r % 32) * 32, (r / 32) * 64, scr, C.lane);
    }
    for (int m0 = gw * 4; m0 < NTOK; m0 += NGW * 4) {
        f32x4 v[4][4]; float s[4];
#pragma unroll
        for (int r = 0; r < 4; ++r) {
            const f32x4* xr = (const f32x4*)(C.x + (size_t)(m0 + r) * DM) + C.lane;
            s[r] = 0.f;
#pragma unroll
            for (int j = 0; j < 4; ++j) v[r][j] = __builtin_nontemporal_load(xr + 64 * j);
        }
#pragma unroll
        for (int r = 0; r < 4; ++r) {
#pragma unroll
            for (int j = 0; j < 4; ++j) s[r] += (v[r][j].x * v[r][j].x + v[r][j].y * v[r][j].y) + (v[r][j].z * v[r][j].z + v[r][j].w * v[r][j].w);
            float t = s[r];
            t += __uint_as_float(dpp_u<0x111, 0xf>(0u, __float_as_uint(t))); t += __uint_as_float(dpp_u<0x112, 0xf>(0u, __float_as_uint(t)));
            t += __uint_as_float(dpp_u<0x114, 0xf>(0u, __float_as_uint(t))); t += __uint_as_float(dpp_u<0x118, 0xf>(0u, __float_as_uint(t)));
            t += __uint_as_float(dpp_u<0x142, 0xa>(0u, __float_as_uint(t))); t += __uint_as_float(dpp_u<0x143, 0xc>(0u, __float_as_uint(t)));
            s[r] = __uint_as_float((unsigned)__builtin_amdgcn_readlane((int)__float_as_uint(t), 63));
        }
#pragma unroll
        for (int r = 0; r < 4; ++r) {
            const float rstd = __builtin_amdgcn_rsqf(s[r] * (1.f / DM) + EPS);
            if (C.lane == 0) C.RSX[m0 + r] = __builtin_amdgcn_sqrtf(s[r] * (1.f / DM) + EPS);
            u32x2* o8 = (u32x2*)(C.XN + (size_t)(m0 + r) * DM) + C.lane;
            unsigned* o4 = (unsigned*)(C.XN8 + (size_t)(m0 + r) * DM) + C.lane;
#pragma unroll
            for (int j = 0; j < 4; ++j) {
                const f32x4 y = v[r][j] * rstd;
                u32x2 w; w.x = cvtpk(y.x, y.y); w.y = cvtpk(y.z, y.w); o8[64 * j] = w;
                o4[64 * j] = pk4_fp8(y.x, y.y, y.z, y.w);
            }
        }
    }
    for (int i = C.bid * 512 + C.tid; i < NTOK; i += C.G * 512) { C.RSS[i] = 0.f;
    }
}

constexpr int A_WAVE_LDS = 1280 + 4096 + 9216;
__device__ __forceinline__ s16x4 tr_read(LAS unsigned char* p) { return __builtin_bit_cast(s16x4, __builtin_amdgcn_ds_read_tr16_b64_v4i16((LAS s16x4*)p)); }
template <int VAR> __device__ __forceinline__ void mixerA_unit(Ctx& C, int b, int c, fp8_t* outp, int opitch) {
    const int lane = C.lane, h = C.wave, r32 = lane & 31, hi = lane >> 5;
    LAS unsigned char* wl = C.lds + h * A_WAVE_LDS;
    LAS float* btab = (LAS float*)wl;
    LAS unsigned char* vimg = wl + 1280;
    LAS bf16_t* ost = (LAS bf16_t*)(wl + 1280 + 4096);
    for (int i = lane; i < 320; i += 64) btab[i] = C.a_rel[h * 513 + i + 193] * LOG2E;
    const size_t tok0 = (size_t)b * SEQ + (size_t)c * 64;
    const bf16_t* Qp = C.P + tok0 * PW + C_QA + h * 64;
    bf16x8 qf[2][4];
#pragma unroll
    for (int qg = 0; qg < 2; ++qg)
#pragma unroll
        for (int ks = 0; ks < 4; ++ks) qf[qg][ks] = *(const bf16x8*)(Qp + (size_t)(32 * qg + r32) * PW + 16 * ks + 8 * hi);
    f32x16 o[2][2];
#pragma unroll
    for (int a = 0; a < 2; ++a)
#pragma unroll
        for (int q = 0; q < 2; ++q)
#pragma unroll
            for (int i = 0; i < 16; ++i) o[a][q][i] = 0.f;
    float mrun[2] = {-1e30f, -1e30f}, lrun[2] = {0.f, 0.f};
    const float bfar = C.a_rel[h * 513 + 512] * LOG2E;
    const int t0 = c < 8 ? (8 - c) * 2 : 0;
    const long kbase = (long)b * SEQ + (long)(c - 8) * 64;
    const int i16 = lane & 15, qq = i16 >> 2, pp = i16 & 3, blk = (lane >> 4) & 1;
    asm volatile("s_waitcnt lgkmcnt(0)" ::: "memory");
    bf16x8 kfn[4]; u32x4 vn[4];
#define MA_LOAD(t_) do { const int j0_ = (t_) * 32; const bf16_t* Kp = C.P + (size_t)(kbase + j0_ + r32) * PW + C_KA + h * 64 + 8 * hi; \
        _Pragma("unroll") for (int ks = 0; ks < 4; ++ks) kfn[ks] = *(const bf16x8*)(Kp + 16 * ks); \
        _Pragma("unroll") for (int r = 0; r < 4; ++r) { const int pc = lane + 64 * r, key = pc >> 3, ch = pc & 7; \
            vn[r] = *(const u32x4*)(C.P + (size_t)(kbase + j0_ + key) * PW + C_VA + h * 64 + ch * 8); } } while (0)
    MA_LOAD(t0);
#pragma unroll 1
    for (int t = t0; t < 18; ++t) {
        const int j0 = t * 32;
        bf16x8 kf[4];
#pragma unroll
        for (int ks = 0; ks < 4; ++ks) kf[ks] = kfn[ks];
        if (VAR != 1)
#pragma unroll
        for (int r = 0; r < 4; ++r) {
            const int pc = lane + 64 * r, key = pc >> 3, ch = pc & 7;
            *(LAS u32x4*)(vimg + (ch >> 2) * 2048 + key * 64 + (ch & 3) * 16) = vn[r];
        }
        if (VAR == 1) { o[0][0][0] += __uint_as_float(vn[0].x ^ vn[3].w); }
        if (t + 1 < 18) MA_LOAD(t + 1);
        const bool far = (t < 8);
        const float cinit = far ? bfar : 0.f;
        f32x16 s[2];
        __builtin_amdgcn_s_setprio(1);
#pragma unroll
        for (int qg = 0; qg < 2; ++qg) {
#pragma unroll
            for (int i = 0; i < 16; ++i) s[qg][i] = cinit;
#pragma unroll
            for (int ks = 0; ks < 4; ++ks) s[qg] = __builtin_amdgcn_mfma_f32_32x32x16_bf16(kf[ks], qf[qg][ks], s[qg], 0, 0, 0);
        }
        __builtin_amdgcn_s_setprio(0);
        float tmax[2];
#pragma unroll
        for (int qg = 0; qg < 2; ++qg) {
            const int q = 32 * qg + r32;
            float tm = -1e30f;
            if (!far && VAR != 2) {
                if (t < 10) {
#pragma unroll
                    for (int i = 0; i < 16; ++i) {
                        const int j = j0 + crow(i, hi); const int rel = 512 + q - j; const int bi = (rel < 256 ? rel : 256) + 63;
                        s[qg][i] += btab[bi];
                    }
                } else {
                    const LAS float* bp = btab + (575 - 27 + q - j0 - 4 * hi);
#pragma unroll
                    for (int i = 0; i < 16; ++i) s[qg][i] += bp[27 - ((i & 3) + 8 * (i >> 2))];
                }
            }
#pragma unroll
            for (int i = 0; i < 16; ++i) tm = fmaxf(tm, s[qg][i]);
            tmax[qg] = xmax32(tm);
        }
        if (__any((tmax[0] > mrun[0] + 8.f) || (tmax[1] > mrun[1] + 8.f))) {
#pragma unroll
            for (int qg = 0; qg < 2; ++qg) {
                const float mn = fmaxf(mrun[qg], tmax[qg]), alpha = __builtin_amdgcn_exp2f(mrun[qg] - mn); mrun[qg] = mn;
                lrun[qg] *= alpha;
#pragma unroll
                for (int dt = 0; dt < 2; ++dt)
#pragma unroll
                    for (int i = 0; i < 16; ++i) o[dt][qg][i] *= alpha;
            }
        }
        bf16x8 pk[2][2];
#pragma unroll
        for (int qg = 0; qg < 2; ++qg) {
            const float mn = mrun[qg];
            float ps = 0.f;
#pragma unroll
            for (int i = 0; i < 16; ++i) { const float p = (VAR == 2) ? s[qg][i] : __builtin_amdgcn_exp2f(s[qg][i] - mn); s[qg][i] = p; ps += p; }
            lrun[qg] += ps;
#pragma unroll
            for (int st = 0; st < 2; ++st) {
                u32x4 w; w.x = cvtpk(s[qg][8 * st + 0], s[qg][8 * st + 1]); w.y = cvtpk(s[qg][8 * st + 2], s[qg][8 * st + 3]);
                w.z = cvtpk(s[qg][8 * st + 4], s[qg][8 * st + 5]); w.w = cvtpk(s[qg][8 * st + 6], s[qg][8 * st + 7]);
                pk[qg][st] = __builtin_bit_cast(bf16x8, w);
            }
        }
        asm volatile("s_waitcnt lgkmcnt(0)" ::: "memory");
        if (VAR == 1) { o[0][0][1] += __uint_as_float(__builtin_bit_cast(u32x4, pk[0][0]).x ^ __builtin_bit_cast(u32x4, pk[1][1]).w ^ __builtin_bit_cast(u32x4, pk[0][1]).y ^ __builtin_bit_cast(u32x4, pk[1][0]).z); } else
#pragma unroll
        for (int dt = 0; dt < 2; ++dt)
#pragma unroll
            for (int st = 0; st < 2; ++st) {
                LAS unsigned char* pb = vimg + dt * 2048 + (16 * st + 4 * hi + qq) * 64 + (16 * blk + 4 * pp) * 2;
                const s16x4 lo = tr_read(pb), hi4 = tr_read(pb + 8 * 64);
                const bf16x8 vf = __builtin_shufflevector(lo, hi4, 0, 1, 2, 3, 4, 5, 6, 7);
                __builtin_amdgcn_s_setprio(1);
#pragma unroll
                for (int qg = 0; qg < 2; ++qg) o[dt][qg] = __builtin_amdgcn_mfma_f32_32x32x16_bf16(vf, pk[qg][st], o[dt][qg], 0, 0, 0);
                __builtin_amdgcn_s_setprio(0);
            }
        asm volatile("s_waitcnt lgkmcnt(0)" ::: "memory");
    }
#undef MA_LOAD
#pragma unroll
    for (int qg = 0; qg < 2; ++qg) {
        const float lt = xsum32(lrun[qg]); const float inv = __builtin_amdgcn_rcpf(lt);
#pragma unroll
        for (int dt = 0; dt < 2; ++dt)
#pragma unroll
            for (int i = 0; i < 16; ++i) ost[(32 * qg + r32) * 72 + 32 * dt + crow(i, hi)] = f2bf(o[dt][qg][i] * inv);
    }
    asm volatile("s_waitcnt lgkmcnt(0)" ::: "memory");
    u32x4 zv8[8];
#pragma unroll
    for (int r = 0; r < 8; ++r) { const int row = (lane >> 3) + 8 * r, ch = lane & 7; zv8[r] = *(const u32x4*)(C.P + (tok0 + row) * PW + h * 64 + ch * 8 + C_ZA); }
#pragma unroll
    for (int r = 0; r < 8; ++r) {
        const int row = (lane >> 3) + 8 * r, ch = lane & 7;
        const u32x4 ov = *(const LAS u32x4*)(ost + row * 72 + ch * 8);
        const u32x4 zv = zv8[r];
        u32x2 w;
        w.x = pk4_fp8(bf_lo(ov[0]) * bf_lo(zv[0]) * Y8_SCALE, bf_hi(ov[0]) * bf_hi(zv[0]) * Y8_SCALE, bf_lo(ov[1]) * bf_lo(zv[1]) * Y8_SCALE, bf_hi(ov[1]) * bf_hi(zv[1]) * Y8_SCALE);
        w.y = pk4_fp8(bf_lo(ov[2]) * bf_lo(zv[2]) * Y8_SCALE, bf_hi(ov[2]) * bf_hi(zv[2]) * Y8_SCALE, bf_lo(ov[3]) * bf_lo(zv[3]) * Y8_SCALE, bf_hi(ov[3]) * bf_hi(zv[3]) * Y8_SCALE);
        *(u32x2*)(outp + (tok0 + row) * (size_t)opitch + h * 64 + ch * 8) = w;
    }
    asm volatile("s_waitcnt lgkmcnt(0)" ::: "memory");
}

__device__ __forceinline__ int t5_bucket(int rel) {
    const int n = rel < 0 ? -rel : rel;
    int bkt = n < 8 ? n : 8 + (n >= 12) + (n >= 16) + (n >= 23) + (n >= 32) + (n >= 46) + (n >= 64) + (n >= 91);
    return bkt + (rel > 0 ? 16 : 0);
}
constexpr int BF_STRIDE = 580;
constexpr int BF_LIST = 0;
constexpr int BF_CNT = 64 * BF_STRIDE * 4;
constexpr int BF_THRF = BF_CNT + 512;
constexpr int BF_PEND = BF_THRF + 256;
constexpr int BF_HIST = BF_PEND + 768;
constexpr int BF_T5 = BF_HIST + 8192;
constexpr int BF_PBAR = BF_T5 + 1024;
constexpr int BF_END = BF_PBAR + 64;
constexpr int BF_CAP = 576;
constexpr int BF_SEL = 0;
constexpr int BF_VIMG = 65536;
static_assert(BF_END <= LDS_BYTES - 64 && BF_VIMG + 8 * 8320 <= BF_CNT, "LDS map");

constexpr int NV = 9;
__device__ __forceinline__ unsigned pack_key(float s, unsigned idxinv) { const int b = __float_as_int(s); const unsigned u = (unsigned)b ^ ((unsigned)(b >> 31) | 0x80000000u); return (u & 0xFFFFE000u) | idxinv; }
__device__ __forceinline__ float key_lower_float(unsigned T) { const unsigned u = T & 0xFFFFE000u; const unsigned bits = (u & 0x80000000u) ? (u & 0x7FFFFFFFu) : ~u; return __uint_as_float(bits); }
__device__ __forceinline__ unsigned wave_prefix_sum(unsigned v) {
    v += dpp_u<0x111, 0xf>(0u, v); v += dpp_u<0x112, 0xf>(0u, v); v += dpp_u<0x114, 0xf>(0u, v); v += dpp_u<0x118, 0xf>(0u, v);
    v += dpp_u<0x142, 0xa>(0u, v); v += dpp_u<0x143, 0xc>(0u, v); return v;
}
__device__ __forceinline__ unsigned wave_max_u(unsigned v) {
    unsigned t;
    t = dpp_u<0x111, 0xf>(0u, v); v = v > t ? v : t; t = dpp_u<0x112, 0xf>(0u, v); v = v > t ? v : t;
    t = dpp_u<0x114, 0xf>(0u, v); v = v > t ? v : t; t = dpp_u<0x118, 0xf>(0u, v); v = v > t ? v : t;
    t = dpp_u<0x142, 0xa>(0u, v); v = v > t ? v : t; t = dpp_u<0x143, 0xc>(0u, v); v = v > t ? v : t;
    return (unsigned)__builtin_amdgcn_readlane((int)v, 63);
}
__device__ __forceinline__ unsigned wave_min_u(unsigned v) {
    unsigned t;
    t = dpp_u<0x111, 0xf>(0xFFFFFFFFu, v); v = v < t ? v : t; t = dpp_u<0x112, 0xf>(0xFFFFFFFFu, v); v = v < t ? v : t;
    t = dpp_u<0x114, 0xf>(0xFFFFFFFFu, v); v = v < t ? v : t; t = dpp_u<0x118, 0xf>(0xFFFFFFFFu, v); v = v < t ? v : t;
    t = dpp_u<0x142, 0xa>(0xFFFFFFFFu, v); v = v < t ? v : t; t = dpp_u<0x143, 0xc>(0xFFFFFFFFu, v); v = v < t ? v : t;
    return (unsigned)__builtin_amdgcn_readlane((int)v, 63);
}
__device__ __forceinline__ int mbcnt64(unsigned long long m) { return __builtin_amdgcn_mbcnt_hi((unsigned)(m >> 32), __builtin_amdgcn_mbcnt_lo((unsigned)m, 0u)); }
#define LDS_BARRIER() do { asm volatile("s_waitcnt lgkmcnt(0)" ::: "memory"); __builtin_amdgcn_s_barrier(); asm volatile("" ::: "memory"); } while (0)

__device__ __forceinline__ void select_query(LAS unsigned* lq, LAS unsigned* cntp, LAS float* thrp, LAS unsigned* hist, const int cn, bool exact, const int lane) {
    unsigned v[NV];
#pragma unroll
    for (int i = 0; i < NV; ++i) v[i] = lq[i * 64 + lane];
    unsigned mx = 0u, mn = 0xFFFFFFFFu;
#pragma unroll
    for (int i = 0; i < NV; ++i) { if (i * 64 + lane >= cn) v[i] = 0u; mx = v[i] > mx ? v[i] : mx; const unsigned w = v[i] ? v[i] : 0xFFFFFFFFu; mn = w < mn ? w : mn; }
    mx = wave_max_u(mx); mn = wave_min_u(mn);
    int need = 256;
    unsigned base = mn;
    const unsigned range = mx - mn;
    int sh = range >= 256u ? (24 - __builtin_clz(range)) : 0;
    unsigned T = 0u;
    for (;;) {
        *(LAS u32x4*)(hist + lane * 4) = (u32x4){0u, 0u, 0u, 0u};
        asm volatile("s_waitcnt lgkmcnt(0)" ::: "memory");
#pragma unroll
        for (int i = 0; i < NV; ++i) {
            const unsigned dgt = (v[i] - base) >> sh;
            const bool in = (v[i] != 0u) && (v[i] >= base) && (dgt < 256u);
            if (in) (void)__hip_atomic_fetch_add(hist + (255u - dgt), 1u, __ATOMIC_RELAXED, __HIP_MEMORY_SCOPE_WORKGROUP);
        }
        asm volatile("s_waitcnt lgkmcnt(0)" ::: "memory");
        const u32x4 hb = *(const LAS u32x4*)(hist + lane * 4);
        const unsigned S = hb.x + hb.y + hb.z + hb.w;
        const unsigned incl = wave_prefix_sum(S);
        const unsigned excl = incl - S;
        int phys; unsigned popl, abvl;
        {
            unsigned cacc = excl;
            if (cacc + hb.x >= (unsigned)need) { phys = 0; popl = hb.x; abvl = cacc; }
            else { cacc += hb.x;
                if (cacc + hb.y >= (unsigned)need) { phys = 1; popl = hb.y; abvl = cacc; }
                else { cacc += hb.y;
                    if (cacc + hb.z >= (unsigned)need) { phys = 2; popl = hb.z; abvl = cacc; }
                    else { cacc += hb.z; phys = 3; popl = hb.w; abvl = cacc; } } }
            phys += 4 * lane;
        }
        const unsigned long long cm = __ballot(incl >= (unsigned)need);
        const int src = __ffsll((long long)cm) - 1;
        const int bin = 255 - __builtin_amdgcn_readlane(phys, src);
        const int pop = __builtin_amdgcn_readlane((int)popl, src), above = __builtin_amdgcn_readlane((int)abvl, src);
        const unsigned newbase = base + ((unsigned)bin << sh);
        const int kept = (256 - need) + above + pop;
        if (!exact) {
            if (kept <= 288 || sh == 0) { T = newbase; break; }
            exact = true;
        }
        need -= above;
        if (pop <= 64 || sh == 0) {
            int pos = 0;
#pragma unroll
            for (int i = 0; i < NV; ++i) {
                const bool in = (v[i] != 0u) && (v[i] >= newbase) && (((v[i] - newbase) >> sh) == 0u);
                const unsigned long long mk = __ballot(in);
                if (in) hist[pos + mbcnt64(mk)] = v[i];
                pos += __popcll(mk);
            }
            asm volatile("s_waitcnt lgkmcnt(0)" ::: "memory");
            const unsigned e = (lane < pop) ? hist[lane] : 0u;
            int rk = 0;
            for (int k = 0; k < pop; ++k) rk += (hist[k] > e) ? 1 : 0;
            const bool isT = (lane < pop) && (rk == need - 1);
            const unsigned long long tm = __ballot(isT);
            T = (unsigned)__builtin_amdgcn_readlane((int)e, __ffsll((long long)tm) - 1);
            break;
        }
        base = newbase; sh = sh > 8 ? sh - 8 : 0;
    }
    int pos = 0;
#pragma unroll
    for (int i = 0; i < NV; ++i) {
        const bool k = (v[i] != 0u) && (v[i] >= T);
        const unsigned long long mk = __ballot(k);
        if (k) lq[pos + mbcnt64(mk)] = v[i];
        pos += __popcll(mk);
    }
    if (lane == 0) { *cntp = (unsigned)pos; *thrp = key_lower_float(T); }
    asm volatile("s_waitcnt lgkmcnt(0)" ::: "memory");
}

#define PRUNE_MASKS(T_) asm("v_cmp_le_u32_e64 %0, %9, %10\n\tv_cmp_le_u32_e64 %1, %9, %11\n\tv_cmp_le_u32_e64 %2, %9, %12\n\tv_cmp_le_u32_e64 %3, %9, %13\n\tv_cmp_le_u32_e64 %4, %9, %14\n\t" \
            "v_cmp_le_u32_e64 %5, %9, %15\n\tv_cmp_le_u32_e64 %6, %9, %16\n\tv_cmp_le_u32_e64 %7, %9, %17\n\tv_cmp_le_u32_e64 %8, %9, %18" \
            : "=&s"(m0), "=&s"(m1), "=&s"(m2), "=&s"(m3), "=&s"(m4), "=&s"(m5), "=&s"(m6), "=&s"(m7), "=&s"(m8) \
            : "s"(T_), "v"(v[0]), "v"(v[1]), "v"(v[2]), "v"(v[3]), "v"(v[4]), "v"(v[5]), "v"(v[6]), "v"(v[7]), "v"(v[8]))
__device__ __forceinline__ void prune_query(LAS unsigned* lq, LAS unsigned* cntp, LAS float* thrp, const int cn, const int lane) {
    __builtin_amdgcn_s_setprio(3);
    unsigned v[NV];
#pragma unroll
    for (int i = 0; i < NV; ++i) v[i] = lq[i * 64 + lane];
    const float thr_old = __uint_as_float((unsigned)__builtin_amdgcn_readfirstlane((int)__float_as_uint(*thrp)));
    if (7 * 64 + lane >= cn) v[7] = 0u;
    if (8 * 64 + lane >= cn) v[8] = 0u;
    unsigned mx = v[0];
#pragma unroll
    for (int i = 1; i < NV; ++i) mx = v[i] > mx ? v[i] : mx;
    unsigned hi = wave_max_u(mx), lo;
    if (thr_old == -INFINITY) {
        unsigned mn = v[0];
#pragma unroll
        for (int i = 1; i < 7; ++i) mn = v[i] < mn ? v[i] : mn;
        const unsigned w7 = v[7] ? v[7] : 0xFFFFFFFFu, w8 = v[8] ? v[8] : 0xFFFFFFFFu;
        mn = w7 < mn ? w7 : mn; mn = w8 < mn ? w8 : mn;
        lo = wave_min_u(mn);
    } else lo = pack_key(thr_old, 0u);
    unsigned long long m0, m1, m2, m3, m4, m5, m6, m7, m8;
    bool have = false;
    for (;;) {
        if (hi == lo) break;
        const unsigned T = lo + ((hi - lo + 1u) >> 1);
        PRUNE_MASKS(T);
        const int c = __popcll(m0) + __popcll(m1) + __popcll(m2) + __popcll(m3) + __popcll(m4) + __popcll(m5) + __popcll(m6) + __popcll(m7) + __popcll(m8);
        if (c >= 256) { lo = T; if (c <= 288) { have = true; break; } } else hi = T - 1u;
    }
    if (!have) PRUNE_MASKS(lo);
    int pos = 0;
#define PRUNE_PUT(i_, m_) do { if (__builtin_amdgcn_inverse_ballot_w64(m_)) lq[pos + mbcnt64(m_)] = v[i_]; pos += __popcll(m_); } while (0)
    PRUNE_PUT(0, m0); PRUNE_PUT(1, m1); PRUNE_PUT(2, m2); PRUNE_PUT(3, m3); PRUNE_PUT(4, m4); PRUNE_PUT(5, m5); PRUNE_PUT(6, m6); PRUNE_PUT(7, m7); PRUNE_PUT(8, m8);
#undef PRUNE_PUT
    if (lane == 0) { *cntp = (unsigned)pos; *thrp = key_lower_float(lo); }
    asm volatile("s_waitcnt lgkmcnt(0)" ::: "memory");
    __builtin_amdgcn_s_setprio(0);
}
#undef PRUNE_MASKS

__device__ __forceinline__ void b2_loadK(u32x4 (&Kf)[4], const LAS unsigned* sq, int ci, const fp8_t* KBb, int lane) {
    const int g = lane >> 4;
#pragma unroll
    for (int tt = 0; tt < 4; ++tt) {
        const int key = (int)(sq[64 * ci + 16 * tt + (lane & 15)] & 0xffffu);
        Kf[tt] = *(const u32x4*)(KBb + (size_t)key * 64 + 16 * g);
    }
}
__device__ __forceinline__ void b2_loadV(u32x4 (&Vf)[4], const LAS unsigned* sq, int ci, const fp8_t* VBb, int lane) {
#pragma unroll
    for (int r = 0; r < 4; ++r) {
        const int pc = lane + 64 * r, row = pc >> 2, dt = pc & 3;
        const int key = (int)(sq[64 * ci + row] & 0xffffu);
        Vf[r] = *(const u32x4*)(VBb + (size_t)key * 64 + dt * 16);
    }
}
struct B2State { f32x4 o[4]; float mrun, lrun; long qb[2]; u32x4 qbn[2]; u32x2 zz[4]; };
template <int VAR> __device__ __forceinline__ void b2_step(Ctx& C, B2State& st, const u32x4 (&Kf)[4], const u32x4 (&Vf)[4], const LAS unsigned* sq, const LAS float* t5L, LAS unsigned char* vimg,
                                        int ci, int nchunk, int ns, size_t tok, int pos, fp8_t* outp, int opitch, int lane, bool haveNext) {
    const int hd = lane & 15, g = lane >> 4, hd7 = hd & 7;
    const int qq4 = hd >> 2, pp = hd & 3;
    if (ci == 0) {
#pragma unroll
        for (int d = 0; d < 4; ++d) st.o[d] = (f32x4){0.f, 0.f, 0.f, 0.f};
        st.mrun = -1e30f; st.lrun = 0.f;
#pragma unroll
        for (int ks = 0; ks < 2; ++ks) {
            const u32x4 t = st.qbn[ks];
            u32x2 q8; q8.x = pk4_fp8(bf_lo(t.x) * 8.f, bf_hi(t.x) * 8.f, bf_lo(t.y) * 8.f, bf_hi(t.y) * 8.f); q8.y = pk4_fp8(bf_lo(t.z) * 8.f, bf_hi(t.z) * 8.f, bf_lo(t.w) * 8.f, bf_hi(t.w) * 8.f);
            if (hd >= 8) q8 = (u32x2){0u, 0u};
            st.qb[ks] = __builtin_bit_cast(long, q8);
        }
#pragma unroll
        for (int d = 0; d < 4; ++d) st.zz[d] = *(const u32x2*)(C.P + tok * PW + hd7 * 64 + 4 * g + C_ZB + 16 * d);
        if (haveNext) {
#pragma unroll
            for (int ks = 0; ks < 2; ++ks) st.qbn[ks] = *(const u32x4*)(C.P + (tok + 1) * PW + C_QB + hd7 * 64 + 32 * ks + 8 * g);
        }
    }
#pragma unroll
    for (int r = 0; r < 4; ++r) {
        const int pc = lane + 64 * r, row = pc >> 2, dt = pc & 3;
        const int pos = (row & 32) + 8 * ((row >> 2) & 3) + 4 * ((row >> 4) & 1) + (row & 3);
        *(LAS u32x4*)(vimg + dt * 1024 + pos * 16) = Vf[r];
    }
    const int hup = hd >> 3;
    u32x4 kk[2];
#pragma unroll
    for (int p = 0; p < 2; ++p) kk[p] = *(const LAS u32x4*)(sq + 16 * (4 * ci + 2 * p + hup) + 4 * g);
    float bias[2][4];
#pragma unroll
    for (int p = 0; p < 2; ++p)
#pragma unroll
        for (int i = 0; i < 4; ++i) bias[p][i] = t5L[(kk[p][i] >> 16) * 8 + hd7];
    f32x4 acc4[4];
#pragma unroll
    for (int tt = 0; tt < 4; ++tt) {
        f32x4 a = (f32x4){0.f, 0.f, 0.f, 0.f};
        a = __builtin_amdgcn_mfma_f32_16x16x32_fp8_fp8(__builtin_bit_cast(long, (u32x2){Kf[tt].x, Kf[tt].y}), st.qb[0], a, 0, 0, 0);
        acc4[tt] = __builtin_amdgcn_mfma_f32_16x16x32_fp8_fp8(__builtin_bit_cast(long, (u32x2){Kf[tt].z, Kf[tt].w}), st.qb[1], a, 0, 0, 0);
    }
    float lg[2][4];
    float cmax = -1e30f;
#pragma unroll
    for (int p = 0; p < 2; ++p)
#pragma unroll
        for (int i = 0; i < 4; ++i) {
            const float f = __uint_as_float((unsigned)__builtin_amdgcn_update_dpp((int)__float_as_uint(acc4[2 * p][i]), (int)__float_as_uint(acc4[2 * p + 1][i]), 0x128, 0xf, 0xc, false));
            const float x = __builtin_fmaf(f, 0.125f, bias[p][i]);
            lg[p][i] = x; cmax = fmaxf(cmax, x);
        }
    cmax = xmax32(xmax16(cmax));
    cmax = fmaxf(cmax, __uint_as_float(dpp_u<0x128, 0xf>(0u, __float_as_uint(cmax))));
    const float mn = fmaxf(st.mrun, cmax); const float alpha = __builtin_amdgcn_exp2f(st.mrun - mn); st.mrun = mn;
    float ps = 0.f;
#pragma unroll
    for (int p = 0; p < 2; ++p)
#pragma unroll
        for (int i = 0; i < 4; ++i) { const float e = __builtin_amdgcn_exp2f(lg[p][i] - mn); lg[p][i] = e; ps += e; }
    st.lrun = st.lrun * alpha + ps;
#pragma unroll
    for (int d = 0; d < 4; ++d) st.o[d] = st.o[d] * alpha;
    asm volatile("s_waitcnt lgkmcnt(0)" ::: "memory");
    {
        long vf[2][4];
#pragma unroll
        for (int ul = 0; ul < 2; ++ul)
#pragma unroll
            for (int d = 0; d < 4; ++d) {
                LAS unsigned char* pa = vimg + d * 1024 + (32 * ul + 8 * g + (hd >> 1)) * 16 + 8 * (hd & 1);
                vf[ul][d] = __builtin_bit_cast(long, __builtin_amdgcn_ds_read_tr8_b64_v2i32((LAS i32x2*)pa));
            }
#pragma unroll
        for (int ul = 0; ul < 2; ++ul) {
            u32x2 w;
            w.x = pk4_fp8_raw(lg[ul][0], lg[ul][1], lg[ul][2], lg[ul][3]);
            w.y = dpp_u<0x128, 0xf>(0u, w.x);
            const long pb = __builtin_bit_cast(long, w);
#pragma unroll
            for (int d = 0; d < 4; ++d) st.o[d] = __builtin_amdgcn_mfma_f32_16x16x32_fp8_fp8(vf[ul][d], pb, st.o[d], 0, 0, 0);
        }
    }
    asm volatile("s_waitcnt lgkmcnt(0)" ::: "memory");
    if (ci == nchunk - 1) {
        float l = xsum32(xsum16(st.lrun));
        l += __uint_as_float(dpp_u<0x128, 0xf>(0u, __float_as_uint(l)));
        const float inv = __builtin_amdgcn_rcpf(l);
        if (hd < 8) {
            fp8_t* op = outp + tok * (size_t)opitch + hd * 64 + 4 * g;
            const float inv8 = inv * Y8_SCALE;
#pragma unroll
            for (int d = 0; d < 4; ++d) {
                const u32x2 z = st.zz[d];
                *(unsigned*)(op + 16 * d) = pk4_fp8(st.o[d][0] * inv8 * bf_lo(z.x), st.o[d][1] * inv8 * bf_hi(z.x), st.o[d][2] * inv8 * bf_lo(z.y), st.o[d][3] * inv8 * bf_hi(z.y));
            }
        }
    }
}

template <int MODE> __device__ __forceinline__ void mixerB_unit(Ctx& C, int b, int c, fp8_t* outp, int opitch) {
    int lane = C.lane; const int wave = C.wave;
    asm volatile("" : "+v"(lane));
    LAS unsigned* listL = (LAS unsigned*)(C.lds + BF_LIST);
    LAS unsigned* cntL = (LAS unsigned*)(C.lds + BF_CNT);
    LAS float* thrL = (LAS float*)(C.lds + BF_THRF);
    LAS unsigned* histL = (LAS unsigned*)(C.lds + BF_HIST + wave * 1024);
    LAS float* t5L = (LAS float*)(C.lds + BF_T5);
    const int n = (c + 1) * 64;
    const int nround = (n + 127) >> 7;
    LAS unsigned* cntF = cntL + 64 * (nround & 1);
    const size_t tok0 = (size_t)b * SEQ + (size_t)c * 64;
    __syncthreads();
    if (C.tid < 64) { cntL[C.tid] = 0u; thrL[C.tid] = -INFINITY; }
    if (C.tid < 192) ((LAS unsigned*)(C.lds + BF_PEND))[C.tid] = 0u;
    if (C.tid < 4) ((LAS unsigned*)(C.lds + BF_PBAR))[C.tid] = 0u;
    for (int i = C.tid; i < 256; i += NWAVES * 64) t5L[i] = C.t5[i] * LOG2E;
    __syncthreads();
    if (MODE < 4) {
        const int qg4 = wave >> 1, kw = wave & 1;
        const int ql = lane & 15, g = lane >> 4;
        const int q = 16 * qg4 + ql;
        bf16x8 qf[8][2];
        const bf16_t* Qp = C.P + (tok0 + q) * PW + C_QI + 8 * g;
#pragma unroll
        for (int h = 0; h < 8; ++h)
#pragma unroll
            for (int ks = 0; ks < 2; ++ks) qf[h][ks] = *(const bf16x8*)(Qp + h * 64 + 32 * ks);
        float wv[8];
        { const f32x4 w0 = *(const f32x4*)(C.WI + (tok0 + q) * 8), w1 = *(const f32x4*)(C.WI + (tok0 + q) * 8 + 4);
          wv[0] = 0.5f * w0.x; wv[1] = 0.5f * w0.y; wv[2] = 0.5f * w0.z; wv[3] = 0.5f * w0.w; wv[4] = 0.5f * w1.x; wv[5] = 0.5f * w1.y; wv[6] = 0.5f * w1.z; wv[7] = 0.5f * w1.w; }
        bf16x8 qhi[2], qlo[2];
#pragma unroll
        for (int ks = 0; ks < 2; ++ks) {
            float acc8[8];
#pragma unroll
            for (int e = 0; e < 8; ++e) acc8[e] = 0.f;
#pragma unroll
            for (int h = 0; h < 8; ++h) {
                const u32x4 t = __builtin_bit_cast(u32x4, qf[h][ks]);
#pragma unroll
                for (int e = 0; e < 4; ++e) { acc8[2 * e] += wv[h] * bf_lo(t[e]); acc8[2 * e + 1] += wv[h] * bf_hi(t[e]); }
            }
            u32x4 hi_, lo_;
#pragma unroll
            for (int e = 0; e < 4; ++e) {
                const unsigned hp = cvtpk(acc8[2 * e], acc8[2 * e + 1]);
                hi_[e] = hp; lo_[e] = cvtpk(acc8[2 * e] - bf_lo(hp), acc8[2 * e + 1] - bf_hi(hp));
            }
            qhi[ks] = __builtin_bit_cast(bf16x8, hi_); qlo[ks] = __builtin_bit_cast(bf16x8, lo_);
        }
        const char* KIbase = (const char*)(C.KI + (size_t)b * SEQ * 64);
        const unsigned kvoff = (unsigned)(ql * 128 + 16 * g);
        LAS unsigned* lq = listL + q * BF_STRIDE;
        LAS unsigned* pendL = (LAS unsigned*)(C.lds + BF_PEND);
        int p3 = 0;
        LAS unsigned* pbar = (LAS unsigned*)(C.lds + BF_PBAR) + qg4;
        unsigned psync = 0u;
        bf16x8 kc[4][2];
#define B1_LOADKT(tt_, k0_) do { const char* Kp_ = KIbase + (size_t)((k0_) + 16 * (tt_)) * 128; kc[tt_][0] = *(const bf16x8*)(Kp_ + kvoff); kc[tt_][1] = *(const bf16x8*)(Kp_ + kvoff + 64); } while (0)
        if (64 * kw < n) {
#pragma unroll
            for (int tt = 0; tt < 4; ++tt) B1_LOADKT(tt, 64 * kw);
        }
#pragma unroll 1
        for (int r = 0; r < nround; ++r) {
            const int k0 = 128 * r + 64 * kw;
#define PAIR_SYNC() do { asm volatile("s_waitcnt lgkmcnt(0)" ::: "memory"); ++psync; \
                if (lane == 0) (void)__hip_atomic_fetch_add(pbar, 1u, __ATOMIC_RELAXED, __HIP_MEMORY_SCOPE_WORKGROUP); \
                for (unsigned sp_ = 0; sp_ < (1u << 24); ++sp_) { \
                    const unsigned pv_ = (unsigned)__builtin_amdgcn_readfirstlane((int)__hip_atomic_load(pbar, __ATOMIC_RELAXED, __HIP_MEMORY_SCOPE_WORKGROUP)); \
                    if (pv_ >= 2u * psync) break; __builtin_amdgcn_s_sleep(0); } \
                asm volatile("" ::: "memory"); } while (0)
            f32x4 sc[4];
            if (k0 < n) {
                f32x4 hacc[3];
                __builtin_amdgcn_s_setprio(2);
#pragma unroll
                for (int m = 0; m < 34; ++m) {
                    if (m < 32) {
                        const int tt = m >> 3, h = m & 7;
                        if (h == 0) {
                            f32x4 sacc = (f32x4){0.f, 0.f, 0.f, 0.f};
                            sacc = __builtin_amdgcn_mfma_f32_16x16x32_bf16(kc[tt][0], qhi[0], sacc, 0, 0, 0);
                            sacc = __builtin_amdgcn_mfma_f32_16x16x32_bf16(kc[tt][1], qhi[1], sacc, 0, 0, 0);
                            sacc = __builtin_amdgcn_mfma_f32_16x16x32_bf16(kc[tt][0], qlo[0], sacc, 0, 0, 0);
                            sacc = __builtin_amdgcn_mfma_f32_16x16x32_bf16(kc[tt][1], qlo[1], sacc, 0, 0, 0);
                            sc[tt] = sacc;
                        }
                        f32x4 a = (f32x4){0.f, 0.f, 0.f, 0.f};
                        a = __builtin_amdgcn_mfma_f32_16x16x32_bf16(kc[tt][0], qf[h][0], a, 0, 0, 0);
                        hacc[m % 3] = __builtin_amdgcn_mfma_f32_16x16x32_bf16(kc[tt][1], qf[h][1], a, 0, 0, 0);
                        if (h == 7 && k0 + 128 < n) B1_LOADKT(tt, k0 + 128);
                    }
                    __builtin_amdgcn_sched_barrier(0);
                    if (m >= 2) {
                        const int mm = m - 2, tt = mm >> 3, h = mm & 7;
#pragma unroll
                        for (int i = 0; i < 4; ++i) { sc[tt][i] = __builtin_fmaf(wv[h], __builtin_fabsf(hacc[mm % 3][i]), sc[tt][i]); asm volatile("" : "+v"(sc[tt][i])); }
                    }
                    __builtin_amdgcn_sched_barrier(0);
                }
                __builtin_amdgcn_s_setprio(0);
            }
            LAS unsigned* cur = cntL + 64 * (r & 1);
            LAS unsigned* nxt = cntL + 64 * ((r + 1) & 1);
            LAS unsigned* pendR = pendL + 64 * p3;
            LAS unsigned* pendZ = pendL + 64 * (p3 == 0 ? 2 : p3 - 1);
            p3 = (p3 == 2) ? 0 : p3 + 1;
            float thr = thrL[q];
            int np = 0;
            if (k0 < n) {
#pragma unroll
                for (int tt = 0; tt < 4; ++tt)
#pragma unroll
                    for (int i = 0; i < 4; ++i) np += (sc[tt][i] >= thr) ? 1 : 0;
            }
            unsigned base = 0u;
            if (np > 0) base = __hip_atomic_fetch_add(pendR + q, (unsigned)np, __ATOMIC_RELAXED, __HIP_MEMORY_SCOPE_WORKGROUP);
            PAIR_SYNC();
            {
                const int cmine = (int)cur[q], pmine = (int)pendR[q];
                if (g == 0) pendZ[q] = 0u;
                const unsigned pm = (unsigned)__ballot(cmine + pmine > BF_CAP) & 0xFFFFu;
                const bool mine = (pm >> ql) & 1u;
                if (kw == 0 && g == 0 && !mine) nxt[q] = (unsigned)(cmine + pmine);
                base += (unsigned)cmine;
                if (pm) {
                    unsigned pw = pm;
                    int idx = 0;
                    while (pw) {
                        const int j = __builtin_ctz(pw); pw &= pw - 1u;
                        if ((idx & 1) == kw) {
                            const int qq = 16 * qg4 + j;
                            const int cn = __builtin_amdgcn_readlane(cmine, j);
                            prune_query(listL + qq * BF_STRIDE, nxt + qq, thrL + qq, cn, lane);
                        }
                        ++idx;
                    }
                    PAIR_SYNC();
                    if (mine) {
                        thr = thrL[q];
                        np = 0;
                        if (k0 < n) {
#pragma unroll
                            for (int tt = 0; tt < 4; ++tt)
#pragma unroll
                                for (int i = 0; i < 4; ++i) np += (sc[tt][i] >= thr) ? 1 : 0;
                        }
                        if (np > 0) base = __hip_atomic_fetch_add(nxt + q, (unsigned)np, __ATOMIC_RELAXED, __HIP_MEMORY_SCOPE_WORKGROUP);
                    }
                }
            }
            if (np > 0) {
                unsigned slot = base;
#pragma unroll
                for (int tt = 0; tt < 4; ++tt) {
                    const unsigned kbi = (unsigned)(8191 - (k0 + 16 * tt + 4 * g));
#pragma unroll
                    for (int i = 0; i < 4; ++i)
                        if (sc[tt][i] >= thr) { lq[slot] = pack_key(sc[tt][i], kbi - (unsigned)i); ++slot; }
                }
            }
        }
        PAIR_SYNC();
#undef B1_LOADKT
#undef PAIR_SYNC
    }
    if (MODE >= 4) { if (C.tid < 64) cntF[C.tid] = (unsigned)(n < 256 ? n : 256); __syncthreads(); }
#pragma unroll 1
    for (int j = 0; j < 8; ++j) {
        const int qq = 8 * wave + j;
        const int cn = __builtin_amdgcn_readfirstlane((int)cntF[qq]);
        if (MODE < 2 && cn > 256) select_query(listL + qq * BF_STRIDE, cntF + qq, thrL + qq, histL, cn, true, lane);
    }
    asm volatile("s_waitcnt lgkmcnt(0)" ::: "memory");
    unsigned selp[8][4];
#pragma unroll
    for (int j = 0; j < 8; ++j) {
        const int qq = 8 * wave + j;
        const int cq = __builtin_amdgcn_readfirstlane((int)cntF[qq]);
        const u32x4 v = *(const LAS u32x4*)(listL + qq * BF_STRIDE + lane * 4);
#pragma unroll
        for (int k = 0; k < 4; ++k) {
            int id = (int)(8191u - (v[k] & 0x1FFFu));
            if (MODE == 4 || MODE >= 6) id = (lane * 4 + k) & 63;
            if (MODE == 5) id = (int)(((unsigned)(lane * 4 + k) * 2654435761u + (unsigned)qq * 40503u) >> 7) % n;
            selp[j][k] = (lane * 4 + k < cq) ? ((unsigned)id | ((unsigned)t5_bucket(id - (c * 64 + qq)) << 16)) : 0u;
        }
    }
    __syncthreads();
    LAS unsigned* selL = (LAS unsigned*)(C.lds + BF_SEL);
#pragma unroll
    for (int j = 0; j < 8; ++j) { const int qq = 8 * wave + j; *(LAS u32x4*)(selL + qq * 256 + lane * 4) = (u32x4){selp[j][0], selp[j][1], selp[j][2], selp[j][3]}; }
    __syncthreads();
    if (MODE >= 1 && MODE < 4) { if (lane < 8) outp[(tok0 + 8 * wave + lane) * (size_t)opitch + 1] = (fp8_t)selL[(8 * wave + lane) * 256 + 3]; __syncthreads(); return; }
    {
        asm volatile("" : "+v"(lane));
        LAS unsigned char* vimg = C.lds + BF_VIMG + wave * 8320;
        const fp8_t* KBb = (const fp8_t*)C.KB + (size_t)b * SEQ * 64;
        const fp8_t* VBb = (const fp8_t*)C.VB + (size_t)b * SEQ * 64;
        const int nsu = n < 256 ? n : 256, nchunk = nsu >> 6, nsteps = 8 * nchunk;
        u32x4 KA[4], KBf[4]; u32x4 VA[4], VBf[4];
        B2State st;
        int jj = 0, ci = 0, jn = 0, cnx = 0;
#define B2_ADV(j_, c_) do { if (++(c_) == nchunk) { (c_) = 0; ++(j_); } } while (0)
#define B2_STEP(Kf_, Vf_, Kn_, Vn_, more_) do { const int qq_ = 8 * wave + jj; const int ns_ = __builtin_amdgcn_readfirstlane((int)cntF[qq_]); \
        if (more_) { b2_loadK(Kn_, selL + (8 * wave + jn) * 256, cnx, KBb, lane); b2_loadV(Vn_, selL + (8 * wave + jn) * 256, cnx, VBb, lane); B2_ADV(jn, cnx); } \
        b2_step<(MODE == 6 ? 1 : MODE == 7 ? 2 : 0)>(C, st, Kf_, Vf_, selL + qq_ * 256, t5L, vimg, ci, nchunk, ns_, tok0 + qq_, c * 64 + qq_, outp, opitch, lane, jj < 7); B2_ADV(jj, ci); } while (0)
        b2_loadK(KA, selL + (8 * wave + jn) * 256, cnx, KBb, lane); b2_loadV(VA, selL + (8 * wave + jn) * 256, cnx, VBb, lane); B2_ADV(jn, cnx);
        { const int hd7_ = lane & 7, g_ = lane >> 4;
#pragma unroll
          for (int ks = 0; ks < 2; ++ks) st.qbn[ks] = *(const u32x4*)(C.P + (tok0 + 8 * wave) * PW + C_QB + hd7_ * 64 + 32 * ks + 8 * g_); }
#pragma unroll 1
        for (int s = 0; s < nsteps; s += 2) {
            B2_STEP(KA, VA, KBf, VBf, true);
            B2_STEP(KBf, VBf, KA, VA, (s + 2 < nsteps));
        }
#undef B2_ADV
#undef B2_STEP
    }
    __syncthreads();
}

#define XB_TMO      128
#define XB_XCNT(j)  (256  + 64 * (j))
#define XB_XSUB(j)  (1280 + 64 * (j))
#define XB_XGEN(j)  (2304 + 64 * (j))
#define XB_TOP      3328
#define XB_TOPGEN   3392
#define XCD_BAR_WORDS 3456
#define XB_SPIN_CAP (1u << 18)
__device__ __forceinline__ unsigned xb_ld(unsigned* p)              { return __hip_atomic_load(p, __ATOMIC_RELAXED, __HIP_MEMORY_SCOPE_AGENT); }
__device__ __forceinline__ unsigned xb_add(unsigned* p, unsigned v) { return __hip_atomic_fetch_add(p, v, __ATOMIC_RELAXED, __HIP_MEMORY_SCOPE_AGENT); }
__device__ __forceinline__ unsigned xb_xcc_id() { return (unsigned)__builtin_amdgcn_s_getreg((3 << 11) | 20) & 0xFu; }
#define XB_SPIN(cond, bar) do { unsigned _sp = 0; while (cond) { __builtin_amdgcn_s_sleep(1); \
    if ((++_sp & 255u) == 0u) { if (xb_ld(&(bar)[XB_TMO])) break; if (_sp > XB_SPIN_CAP) { atomicAdd(&(bar)[XB_TMO], 1u); break; } } } } while (0)
struct XcdBarrier { unsigned* bar; unsigned x; volatile LAS unsigned* st; };
__device__ __forceinline__ XcdBarrier xcd_barrier_post(unsigned* bar, volatile LAS unsigned* st) {
    XcdBarrier b; b.bar = bar; b.x = xb_xcc_id(); b.st = st;
    if (threadIdx.x == 0) (void)xb_add(&bar[XB_XCNT(b.x)], 1u);
    return b;
}
__device__ __forceinline__ void xcd_barrier_complete(unsigned* bar, unsigned x, unsigned& nloc, unsigned& nx) {
    const unsigned G = gridDim.x * gridDim.y * gridDim.z;
    unsigned sum, cnt, mine, sp = 0u;
    for (;;) {
        sum = 0u; cnt = 0u; mine = 0u;
#pragma unroll
        for (unsigned j = 0; j < 16; ++j) { const unsigned c = xb_ld(&bar[XB_XCNT(j)]); sum += c; cnt += (c > 0u) ? 1u : 0u; mine = (j == x) ? c : mine; }
        if (sum == G) break;
        __builtin_amdgcn_s_sleep(1);
        if ((++sp & 255u) == 0u) { if (xb_ld(&bar[XB_TMO])) break; if (sp > XB_SPIN_CAP) { atomicAdd(&bar[XB_TMO], 1u); break; } }
    }
    nloc = mine > 0u ? mine : 1u; nx = cnt > 0u ? cnt : 1u;
}
__device__ __forceinline__ void xcd_barrier(const XcdBarrier& b) {
    asm volatile("s_waitcnt vmcnt(0)" ::: "memory");
    __syncthreads();
    if (threadIdx.x == 0) {
        unsigned* bar = b.bar;
        __builtin_amdgcn_s_waitcnt(0);
        unsigned nloc = b.st[0], nx = b.st[1];
        if (nloc == 0u) { xcd_barrier_complete(bar, b.x, nloc, nx); b.st[0] = nloc; b.st[1] = nx; }
        const unsigned old = xb_add(&bar[XB_XSUB(b.x)], 1u);
        const unsigned gen = old / nloc;
        if (old + 1u == (gen + 1u) * nloc) {
            __builtin_amdgcn_fence(__ATOMIC_RELEASE, "agent");
            asm volatile("s_waitcnt vmcnt(0)" ::: "memory");
            const unsigned og = xb_add(&bar[XB_TOP], 1u);
            const unsigned tg = og / nx;
            if (og + 1u == (tg + 1u) * nx) xb_add(&bar[XB_TOPGEN], 1u);
            else XB_SPIN(xb_ld(&bar[XB_TOPGEN]) == tg, bar);
            __builtin_amdgcn_fence(__ATOMIC_ACQUIRE, "agent");
            xb_add(&bar[XB_XGEN(b.x)], 1u);
            asm volatile("s_waitcnt vmcnt(0)" ::: "memory");
        } else {
            XB_SPIN(xb_ld(&bar[XB_XGEN(b.x)]) == gen, bar);
            __builtin_amdgcn_fence(__ATOMIC_ACQUIRE, "agent");
            asm volatile("s_waitcnt vmcnt(0)" ::: "memory");
        }
    }
    __syncthreads();
}

struct Args { const float* in[9]; float* out; unsigned char* ws; int ph_lo, ph_hi; };
__global__ void __launch_bounds__(NWAVES * 64, 2) fwd_kernel(Args args) {
    extern __shared__ __attribute__((aligned(16))) unsigned char lds_raw[];
    Ctx C;
    C.lds = (LAS unsigned char*)lds_raw;
    C.tid = threadIdx.x; C.lane = C.tid & 63; C.wave = __builtin_amdgcn_readfirstlane(C.tid >> 6);
    C.G = gridDim.x; C.bid = blockIdx.x; C.dbg = 0ull;
    C.x = args.in[0]; C.norm_gain = args.in[1]; C.w_in = args.in[2]; C.a_rel = args.in[3]; C.t5 = args.in[4];
    C.w_a = args.in[5]; C.w_b = args.in[6]; C.w_o = args.in[7]; C.fgain = args.in[8]; C.out = args.out;
    unsigned char* ws = args.ws;
    C.WT1 = (bf16_t*)(ws + WS_WT1); C.WAT = (fp8_t*)(ws + WS_WAT); C.WBT = (fp8_t*)(ws + WS_WBT); C.WOT = (fp8_t*)(ws + WS_WOT);
    C.Y8 = (fp8_t*)(ws + WS_Y8); C.MG8 = (fp8_t*)(ws + WS_XN8); C.WT18 = (fp8_t*)(ws + WS_WT18); C.XN8 = (fp8_t*)(ws + WS_XN8);
    C.KB = (bf16_t*)(ws + WS_KB); C.VB = (bf16_t*)(ws + WS_VB); C.KI = (bf16_t*)(ws + WS_KI); C.XN = (bf16_t*)(ws + WS_XN); C.P = (bf16_t*)(ws + WS_P);
    C.WI = (float*)(ws + WS_WI); C.RSS = (float*)(ws + WS_RSS); C.RSX = (float*)(ws + WS_RSX);
    const int lo = args.ph_lo, hi = args.ph_hi;
#if MK_ONE_LAUNCH
    volatile LAS unsigned* MISC = (volatile LAS unsigned*)(C.lds + LDS_BYTES - 64);
    if (C.tid < 16) MISC[C.tid] = 0u;
    __syncthreads();
    const XcdBarrier xbar = xcd_barrier_post((unsigned*)(ws + WS_CTL) + 1024, MISC);
#define GRID_SYNC() xcd_barrier(xbar)
#else
#define GRID_SYNC() do {} while (0)
#endif
#ifndef PH_ENABLE
#define PH_ENABLE 63
#endif
#define IN(k) (((PH_ENABLE >> (k)) & 1) && lo <= (k) && (k) < hi)
#define BOTH(k) (IN(k) && IN((k) + 1))

    if (IN(0)) {
        p0_prologue(C); if (BOTH(0)) GRID_SYNC(); }

    if (IN(1)) {
        if ((C.bid >> 3) & 1) { __builtin_amdgcn_s_sleep(127); __builtin_amdgcn_s_sleep(127); }
        {
            pg8::Gemm g{C.XN, C.WT1, C.XN, C.WT1, 2 * DM, 2 * DM, NTOK, 768, 2 * DM, 2 * DM};
            pg8::StaticOrder S; S.init(NTOK, 768, C.G, C.bid);
            EpiProj E{C.P, C.KB, C.VB, C.KI, C.WI, 0, 1.f};
            pg8::gemm_phase<EpiProj, pg8::StaticOrder, true>(C.lds, g, S, E);
        }
        {
            pg8::Gemm g{C.XN8, C.WT18, C.XN8, C.WT18, DM, DM, NTOK, 5120, DM, DM};
            pg8::SplitOrder S; S.init(NTOK, 5120, C.G, C.bid);
            EpiProj E{C.P, C.KB, C.VB, C.KI, C.WI, 1, 1.f / W8_SCALE};
            pg8::gemm_phase<EpiProj, pg8::SplitOrder, true, true>(C.lds, g, S, E);
        }
        if (BOTH(1)) GRID_SYNC();
    }

    if (IN(2)) {
        for (int u = C.bid; u < BATCH * 64; u += C.G) { const int bb = (u & 7) >> 1, pi = (u >> 3) + 32 * (u & 1); mixerB_unit<0>(C, bb, 127 - pi, C.Y8 + 512, 1024); mixerB_unit<0>(C, bb, pi, C.Y8 + 512, 1024); }
        {
            unsigned* actr = (unsigned*)(ws + WS_CTL) + 12288;
            volatile LAS unsigned* slot = (volatile LAS unsigned*)(C.lds + LDS_BYTES - 128);
            for (int li = 0; li < 8; ++li) {
                const int x = (C.bid + li) & 7;
                for (;;) {
                    __syncthreads();
                    if (C.tid == 0) *slot = __hip_atomic_fetch_add(actr + 16 * x, 1u, __ATOMIC_RELAXED, __HIP_MEMORY_SCOPE_AGENT);
                    __syncthreads();
                    const unsigned idx = *slot;
                    if (idx >= 64u) break;
                    const int u = x + 8 * (int)idx, uu = u & 255;
                    mixerA_unit<0>(C, (uu & 7) >> 1, 64 * (uu & 1) + (uu >> 3) + 32 * (u >> 8), C.Y8, 1024);
                }
            }
            __syncthreads();
        }
        if (BOTH(2)) GRID_SYNC();
    }

    if (IN(3)) {
        pg8::Gemm g{C.Y8, C.WAT, C.Y8 + 512, C.WBT, 1024, 512, NTOK, DM, 1024, 512};
        pg8::StaticOrder S; S.init(NTOK, DM, C.G, C.bid);
        EpiMerge E{C.P, C.MG8};
        pg8::gemm_phase<EpiMerge, pg8::StaticOrder, true, true>(C.lds, g, S, E);
        if (BOTH(3)) GRID_SYNC();
    }

    if (IN(4)) {
        pg8::Gemm g{C.MG8, C.WOT, C.MG8, C.WOT, DM, DM, NTOK, DM, DM, DM};
        pg8::StaticOrder S; S.init(NTOK, DM, C.G, C.bid);
        EpiOut E{C.XN, C.RSX, C.out, C.RSS, C.fgain, (unsigned*)(ws + WS_CTL) + 8192};
        pg8::gemm_phase<EpiOut, pg8::StaticOrder, true, true>(C.lds, g, S, E);
    }
#undef IN
#undef BOTH
}

extern "C" void kernel_launch(void* const* d_in, const int* in_sizes, int n_in, void* d_out, int out_size, void* d_ws, size_t ws_size, hipStream_t stream) {
    static int grid = 0;
    if (grid == 0) {
        if (n_in != 9 || in_sizes[0] != NTOK * DM || out_size != NTOK * DM || ws_size < WS_END) {
            fprintf(stderr, "kernel_launch: unexpected shapes (n_in %d, in0 %d, out %d, ws %zu)\n", n_in, n_in > 0 ? in_sizes[0] : -1, out_size, ws_size); grid = -1; return; }
        int dev = 0, cus = 0, per_cu = 0;
        if (hipGetDevice(&dev) != hipSuccess || hipDeviceGetAttribute(&cus, hipDeviceAttributeMultiprocessorCount, dev) != hipSuccess) { grid = -1; return; }
        if (hipFuncSetAttribute((const void*)fwd_kernel, hipFuncAttributeMaxDynamicSharedMemorySize, LDS_BYTES) != hipSuccess) { fprintf(stderr, "kernel_launch: hipFuncSetAttribute failed\n"); grid = -1; return; }
        if (hipOccupancyMaxActiveBlocksPerMultiprocessor(&per_cu, (const void*)fwd_kernel, NWAVES * 64, LDS_BYTES) != hipSuccess || per_cu < 1) { fprintf(stderr, "kernel_launch: occupancy query gives %d\n", per_cu); per_cu = 1; }
        (void)hipGetLastError();
        grid = cus;
    }
    if (grid < 0) return;
    Args a{};
    for (int i = 0; i < 9; ++i) a.in[i] = (const float*)d_in[i];
    a.out = (float*)d_out; a.ws = (unsigned char*)d_ws;
#if MK_ONE_LAUNCH
    a.ph_lo = 0; a.ph_hi = 5;
    if (hipMemsetAsync((char*)d_ws + WS_CTL, 0, 65536, stream) != hipSuccess) { fprintf(stderr, "kernel_launch: hipMemsetAsync failed\n"); return; }
    hipLaunchKernelGGL(fwd_kernel, dim3(grid), dim3(NWAVES * 64), LDS_BYTES, stream, a);
#else
    for (int ph = 0; ph < 5; ++ph) {
        a.ph_lo = ph; a.ph_hi = ph + 1;
        hipLaunchKernelGGL(fwd_kernel, dim3(grid), dim3(NWAVES * 64), LDS_BYTES, stream, a);
    }
#endif
}
```

```cpp
#include <hip/hip_runtime.h>
#include <cstdio>
#include <cstdint>

#ifndef MK_ONE_LAUNCH
#define MK_ONE_LAUNCH 1
#endif


#define LAS __attribute__((address_space(3)))
typedef unsigned short bf16_t;
typedef short bf16x8 __attribute__((ext_vector_type(8)));
typedef short s16x4 __attribute__((ext_vector_type(4)));
typedef float f32x4 __attribute__((ext_vector_type(4)));
typedef float f32x2 __attribute__((ext_vector_type(2)));
typedef int i32x4 __attribute__((ext_vector_type(4)));
typedef int i32x2 __attribute__((ext_vector_type(2)));
typedef float f32x16 __attribute__((ext_vector_type(16)));
typedef unsigned u32x4 __attribute__((ext_vector_type(4)));
typedef unsigned u32x2 __attribute__((ext_vector_type(2)));
typedef __bf16 bf16x2_t __attribute__((ext_vector_type(2)));

constexpr int BATCH = 4, SEQ = 8192, DM = 1024, NTOK = BATCH * SEQ;
constexpr int IN_COLS = 5832;
constexpr int PW = 5632;
constexpr int NW1 = 5888;
constexpr int C_QA = 0, C_KA = 512, C_VA = 1024, C_ZA = 1536, C_QB = 2048, C_ZB = 2560, C_QI = 3072, C_GA = 3584, C_GB = 4608;
constexpr float LOG2E = 1.4426950408889634f;
constexpr float QSC = 0.125f * LOG2E;
constexpr float IDX_SCALE = 0.04419417382415922f;
constexpr float EPS = 1e-6f;

constexpr size_t MiB = 1u << 20;
constexpr size_t WS_CTL = 0;
constexpr size_t WS_WT1 = 2 * MiB;
constexpr size_t WS_WT18 = 4 * MiB;
constexpr size_t WS_WAT = 14 * MiB;
constexpr size_t WS_WBT = 15 * MiB;
constexpr size_t WS_WOT = 16 * MiB;
constexpr size_t WS_KB = 18 * MiB;
constexpr size_t WS_VB = 22 * MiB;
constexpr size_t WS_KI = 26 * MiB;
constexpr size_t WS_WI = 30 * MiB;
constexpr size_t WS_RSS = 31 * MiB;
constexpr size_t WS_RSX = 31 * MiB + 512 * 1024;
constexpr size_t WS_XN = 32 * MiB;
constexpr size_t WS_P = 96 * MiB;
constexpr size_t WS_Y8 = 448 * MiB;
constexpr size_t WS_XN8 = 480 * MiB;
constexpr size_t WS_END = 512 * MiB;

constexpr int NWAVES = 8;
constexpr int LDS_BYTES = 163840;

__device__ __forceinline__ unsigned cvtpk(float lo, float hi) { f32x2 v = {lo, hi}; bf16x2_t b = __builtin_convertvector(v, bf16x2_t); return __builtin_bit_cast(unsigned, b); }
__device__ __forceinline__ float bf_lo(unsigned u) { return __uint_as_float(u << 16); }
__device__ __forceinline__ float bf_hi(unsigned u) { return __uint_as_float(u & 0xffff0000u); }
__device__ __forceinline__ float bf2f(bf16_t b) { return __uint_as_float((unsigned)b << 16); }
__device__ __forceinline__ bf16_t f2bf(float f) { return (bf16_t)(cvtpk(f, 0.f) & 0xffffu); }
__device__ __forceinline__ float fast_sigmoid(float x) { return __builtin_amdgcn_rcpf(1.f + __builtin_amdgcn_exp2f(-x * LOG2E)); }
typedef int i32x8 __attribute__((ext_vector_type(8)));
typedef unsigned char fp8_t;
constexpr float Y8_SCALE = 64.f, W8_SCALE = 32.f;
constexpr float ACC8_UNSCALE = 1.f / (64.f * 32.f);
__device__ __forceinline__ unsigned pk4_fp8_raw(float a, float b, float c, float d) { int p = __builtin_amdgcn_cvt_pk_fp8_f32(a, b, 0, false); p = __builtin_amdgcn_cvt_pk_fp8_f32(c, d, p, true); return (unsigned)p; }
__device__ __forceinline__ float sat8(float x) { return __builtin_amdgcn_fmed3f(x, -448.f, 448.f); }
__device__ __forceinline__ unsigned pk4_fp8(float a, float b, float c, float d) { return pk4_fp8_raw(sat8(a), sat8(b), sat8(c), sat8(d)); }
__device__ __forceinline__ float wave_sum(float v) {
#pragma unroll
    for (int o = 32; o >= 1; o >>= 1) v += __shfl_xor(v, o);
    return v;
}
__device__ __forceinline__ float wave_max(float v) {
#pragma unroll
    for (int o = 32; o >= 1; o >>= 1) v = fmaxf(v, __shfl_xor(v, o));
    return v;
}
__device__ __forceinline__ int wave_sum_i(int v) {
#pragma unroll
    for (int o = 32; o >= 1; o >>= 1) v += __shfl_xor(v, o);
    return v;
}
__device__ __forceinline__ float xmax16(float m) { auto r = __builtin_amdgcn_permlane16_swap(__float_as_uint(m), __float_as_uint(m), false, false); return fmaxf(__uint_as_float(r[0]), __uint_as_float(r[1])); }
__device__ __forceinline__ float xmax32(float m) { auto r = __builtin_amdgcn_permlane32_swap(__float_as_uint(m), __float_as_uint(m), false, false); return fmaxf(__uint_as_float(r[0]), __uint_as_float(r[1])); }
__device__ __forceinline__ float xsum16(float m) { auto r = __builtin_amdgcn_permlane16_swap(__float_as_uint(m), __float_as_uint(m), false, false); return __uint_as_float(r[0]) + __uint_as_float(r[1]); }
__device__ __forceinline__ float xsum32(float m) { auto r = __builtin_amdgcn_permlane32_swap(__float_as_uint(m), __float_as_uint(m), false, false); return __uint_as_float(r[0]) + __uint_as_float(r[1]); }
template <int CTRL, int ROWMASK> __device__ __forceinline__ unsigned dpp_u(unsigned old, unsigned src) { return (unsigned)__builtin_amdgcn_update_dpp((int)old, (int)src, CTRL, ROWMASK, 0xf, false); }
__device__ __forceinline__ int crow(int r, int hi) { return (r & 3) + 8 * (r >> 2) + 4 * hi; }

namespace pg8 {
constexpr int BM = 256, BK = 64, HALF = 128, HTB = HALF * BK * 2, STAGE_BYTES = 8 * HTB, NXCD = 8, WGM = 8;
__host__ __device__ __forceinline__ int lds_byte(int r, int c) { const int st = (r >> 4) * 2 + (c >> 5), rr = r & 15, cc = c & 31, ob = rr * 64 + cc * 2; return st * 1024 + (ob ^ (((ob >> 9) & 1) << 5)); }
__host__ __device__ __forceinline__ void stage_rc(int b, int& R, int& C) { const int st = b / 1024, sb = b % 1024, swz = sb ^ (((sb >> 9) & 1) << 5); R = (st >> 1) * 16 + swz / 64; C = (st & 1) * 32 + (swz % 64) / 2; }
__host__ __device__ __forceinline__ int perm32(int rho) { const int n = rho >> 4, i = rho & 15; return 8 * (i >> 2) + 4 * n + (i & 3); }

struct Unit { int pm, pn; };
struct Gemm { const void* A; const void* Bt; const void* A2; const void* Bt2; int lda, ldb, M, N, K, K1; };

struct StaticOrder {
    int nM, nN, nwg, G, c;
    __host__ __device__ void init(int M, int N, int G_, int c_) { nM = M / BM; nN = N / BM; nwg = nM * nN; G = G_; c = c_; }
    __host__ __device__ bool next(int i, Unit& u) const { const long L = (long)i * G + c; if (L >= nwg) return false; map((int)L, u); return true; }
    __host__ __device__ void map(int L, Unit& u) const {
        int wgid = L; { const int q = nwg / NXCD, r = nwg % NXCD, xcd = wgid % NXCD, off = wgid / NXCD; wgid = (xcd < r ? xcd * (q + 1) : r * (q + 1) + (xcd - r) * q) + off; }
        const int nig = WGM * nN, gid = wgid / nig, fm = gid * WGM, gsz = (nM - fm) < WGM ? (nM - fm) : WGM;
        u.pm = fm + ((wgid % nig) % gsz); u.pn = (wgid % nig) / gsz;
    }
};
struct SplitOrder {
    StaticOrder so;
    __host__ __device__ void init(int M, int N, int G_, int c_) { so.init(M, N, G_, c_); }
    __host__ __device__ bool next(int i, Unit& u) const {
        if (so.G != 256 || so.nwg != 2560) return so.next(i, u);
        int L;
        if (i < 9) L = i * 256 + so.c;
        else if (so.c >= 128 && i < 11) L = 2304 + (i - 9) * 128 + (so.c - 128);
        else return false;
        so.map(L, u); return true;
    }
};

template <class Epi, class Sched, bool ALIGN_EPI, bool FP8 = false>
__device__ __forceinline__ void gemm_phase(LAS unsigned char* lds, const Gemm g, const Sched& S, const Epi& E) {
    const int tid = threadIdx.x, wid = __builtin_amdgcn_readfirstlane(tid >> 6), lane = tid & 63, wr = wid >> 2, wc = wid & 3, fr = lane & 15, fq = lane >> 4;
    const int nt = g.K / (2 * BK), nt1 = g.K1 / (2 * BK);
    unsigned voffA[2], voffB[2];
#pragma unroll
    for (int i = 0; i < 2; ++i) { int R, C; stage_rc(tid * 16 + i * 8192, R, C); const int Rb = Epi::PERM ? ((R & ~31) + perm32(R & 31)) : R;
        voffA[i] = (unsigned)(R * g.lda + 2 * C); voffB[i] = (unsigned)(Rb * g.ldb + 2 * C); }
    const size_t kstep = (size_t)(BK * 2);
    const size_t hstepA = (size_t)HALF * g.lda, hstepB = (size_t)HALF * g.ldb;
    const size_t tstepA = 2 * hstepA, tstepB = 2 * hstepB;
    const unsigned ldsw = (unsigned)wid * 1024u;
    const int aoff = lds_byte(wr * 64 + fr, fq * 8), boff = lds_byte(wc * 32 + fr, fq * 8);
#define PG8_SA(b, h) (((b) * 2 + (h)) * HTB)
#define PG8_SB(b, h) ((4 + (b) * 2 + (h)) * HTB)
#define PG8_STAGE(bufoff, gbase, voff) do { _Pragma("unroll") for (int _i = 0; _i < 2; ++_i) \
        __builtin_amdgcn_global_load_lds((const unsigned*)((const char*)(gbase) + (voff)[_i]), (LAS unsigned*)(lds + (bufoff) + ldsw + _i * 8192), 16, 0, 0); } while (0)
#define PG8_LD8(addr_) __builtin_shufflevector(*(const LAS i32x4*)(addr_), *(const LAS i32x4*)((addr_) + 1024), 0, 1, 2, 3, 4, 5, 6, 7)
#define PG8_LDA(dst, b, h) do { _Pragma("unroll") for (int m = 0; m < 4; ++m) dst[m] = PG8_LD8(lds + PG8_SA(b, h) + aoff + m * 2048); } while (0)
#define PG8_LDB(dst, b, h) do { _Pragma("unroll") for (int n = 0; n < 2; ++n) dst[n] = PG8_LD8(lds + PG8_SB(b, h) + boff + n * 2048); } while (0)
#define PG8_LO(x_) __builtin_bit_cast(bf16x8, __builtin_shufflevector((x_), (x_), 0, 1, 2, 3))
#define PG8_HI(x_) __builtin_bit_cast(bf16x8, __builtin_shufflevector((x_), (x_), 4, 5, 6, 7))
#define PG8_MMA(ai, bj, At, Bt) do { __builtin_amdgcn_s_setprio(1); \
        if constexpr (FP8) { asm volatile("s_nop 1"); _Pragma("unroll") for (int m = 0; m < 4; ++m) _Pragma("unroll") for (int n = 0; n < 2; ++n) \
            asm volatile("v_mfma_f32_16x16x128_f8f6f4 %0, %1, %2, %0" : "+v"(acc[ai][bj][m][n]) : "v"(Bt[n]), "v"(At[m])); }   \
        else { _Pragma("unroll") for (int m = 0; m < 4; ++m) _Pragma("unroll") for (int n = 0; n < 2; ++n) { \
            acc[ai][bj][m][n] = __builtin_amdgcn_mfma_f32_16x16x32_bf16(PG8_LO(Bt[n]), PG8_LO(At[m]), acc[ai][bj][m][n], 0, 0, 0); \
            acc[ai][bj][m][n] = __builtin_amdgcn_mfma_f32_16x16x32_bf16(PG8_HI(Bt[n]), PG8_HI(At[m]), acc[ai][bj][m][n], 0, 0, 0); } } \
        __builtin_amdgcn_s_setprio(0); } while (0)
#define PG8_WAIT_V(n) asm volatile("s_waitcnt vmcnt(" #n ")" ::: "memory")
#define PG8_WAIT_L(n) asm volatile("s_waitcnt lgkmcnt(" #n ")" ::: "memory")
#define PG8_BAR __builtin_amdgcn_s_barrier()
#define PG8_SCHED __builtin_amdgcn_sched_barrier(0)
#define PG8_KT(b1, b2, t) ((t) < nt1 ? (b1) + (size_t)(t) * kstep : (b2) + (size_t)((t) - nt1) * kstep)
    Unit cur, nxt; int ui = 0;
    if (!S.next(0, cur)) return;
    f32x4 acc[2][2][4][2];
#pragma unroll
    for (int a = 0; a < 2; ++a)
#pragma unroll
        for (int b = 0; b < 2; ++b)
#pragma unroll
            for (int m = 0; m < 4; ++m)
#pragma unroll
                for (int n = 0; n < 2; ++n) acc[a][b][m][n] = (f32x4){0.f, 0.f, 0.f, 0.f};
    i32x8 At[4], B0[2], B1[2];
    const char* cA = (const char*)g.A + (size_t)cur.pm * tstepA; const char* cB = (const char*)g.Bt + (size_t)cur.pn * tstepB;
    const char* cA2 = (const char*)g.A2 + (size_t)cur.pm * tstepA; const char* cB2 = (const char*)g.Bt2 + (size_t)cur.pn * tstepB;
    PG8_STAGE(PG8_SB(0, 0), cB, voffB); PG8_STAGE(PG8_SB(0, 1), cB + hstepB, voffB); PG8_STAGE(PG8_SA(0, 0), cA, voffA); PG8_STAGE(PG8_SA(0, 1), cA + hstepA, voffA);
    if (wr == 1) PG8_BAR;
    PG8_WAIT_V(2); PG8_BAR;
    PG8_STAGE(PG8_SB(1, 0), cB + kstep, voffB); PG8_STAGE(PG8_SA(1, 0), cA + kstep, voffA); PG8_STAGE(PG8_SB(1, 1), cB + hstepB + kstep, voffB);
    PG8_WAIT_V(6); PG8_BAR;
    for (;;) {
        const bool has_next = S.next(ui + 1, nxt);
        const char* nA = has_next ? (const char*)g.A + (size_t)nxt.pm * tstepA : cA; const char* nB = has_next ? (const char*)g.Bt + (size_t)nxt.pn * tstepB : cB;
        for (int seg = 0; seg < 2; ++seg) {
        const int tb = seg ? nt1 : 0, te = seg ? nt : nt1;
        if (seg && tb < te) { PG8_SCHED; if constexpr (FP8) asm volatile("s_nop 15\n\ts_nop 15" ::: "memory"); E.mid(acc, cur, wr, wc, fr, fq); PG8_SCHED; }
        for (int t = tb; t < te; t += 2) {
            const bool last = (t == nt - 2);
            const char* a1 = PG8_KT(cA, cA2, t + 1);
            const char* a2 = last ? nA : PG8_KT(cA, cA2, t + 2); const char* b2 = last ? nB : PG8_KT(cB, cB2, t + 2);
            const char* a3 = a2 + kstep; const char* b3 = b2 + kstep;
            PG8_LDB(B0, 0, 0); PG8_LDB(B1, 0, 1); PG8_SCHED; PG8_LDA(At, 0, 0); PG8_STAGE(PG8_SA(1, 1), a1 + hstepA, voffA);
            PG8_WAIT_V(8); PG8_WAIT_L(0); PG8_BAR; PG8_MMA(0, 0, At, B0); PG8_MMA(0, 1, At, B1); PG8_BAR; PG8_SCHED;
            PG8_LDA(At, 0, 1); PG8_STAGE(PG8_SB(0, 0), b2, voffB); PG8_STAGE(PG8_SB(0, 1), b2 + hstepB, voffB); PG8_STAGE(PG8_SA(0, 0), a2, voffA);
            PG8_WAIT_V(8); PG8_WAIT_L(0); PG8_BAR; PG8_MMA(1, 0, At, B0); PG8_MMA(1, 1, At, B1); PG8_BAR; PG8_SCHED;
            PG8_LDB(B0, 1, 0); PG8_LDB(B1, 1, 1); PG8_SCHED; PG8_LDA(At, 1, 0); PG8_STAGE(PG8_SA(0, 1), a2 + hstepA, voffA);
            PG8_WAIT_V(8); PG8_WAIT_L(0); PG8_BAR; PG8_MMA(0, 0, At, B0); PG8_MMA(0, 1, At, B1); PG8_BAR; PG8_SCHED;
            PG8_LDA(At, 1, 1); PG8_STAGE(PG8_SB(1, 0), b3, voffB); PG8_STAGE(PG8_SB(1, 1), b3 + hstepB, voffB); PG8_STAGE(PG8_SA(1, 0), a3, voffA);
            PG8_WAIT_V(8); PG8_WAIT_L(0); PG8_BAR; PG8_MMA(1, 0, At, B0); PG8_MMA(1, 1, At, B1); PG8_BAR; PG8_SCHED;
        }
        }
        if constexpr (ALIGN_EPI) { if (wr == 0) PG8_BAR; }
        if constexpr (FP8) asm volatile("s_nop 15\n\ts_nop 15" ::: "memory");
        E(acc, cur, wr, wc, fr, fq);
        if (!has_next) break;
#pragma unroll
        for (int a = 0; a < 2; ++a)
#pragma unroll
            for (int b = 0; b < 2; ++b)
#pragma unroll
                for (int m = 0; m < 4; ++m)
#pragma unroll
                    for (int n = 0; n < 2; ++n) { float z_ = 0.f; asm volatile("" : "+v"(z_)); acc[a][b][m][n] = (f32x4){z_, z_, z_, z_}; }
        cur = nxt; cA = nA; cB = nB; ++ui;
        cA2 = (const char*)g.A2 + (size_t)cur.pm * tstepA; cB2 = (const char*)g.Bt2 + (size_t)cur.pn * tstepB;
        if constexpr (ALIGN_EPI) { if (wr == 1) PG8_BAR; }
    }
    PG8_WAIT_V(0);
    if constexpr (!ALIGN_EPI) { if (wr == 0) PG8_BAR; }
    PG8_BAR;
#undef PG8_SA
#undef PG8_SB
#undef PG8_STAGE
#undef PG8_LDA
#undef PG8_LDB
#undef PG8_MMA
#undef PG8_LD8
#undef PG8_LO
#undef PG8_HI
#undef PG8_WAIT_V
#undef PG8_WAIT_L
#undef PG8_BAR
#undef PG8_SCHED
#undef PG8_KT
}
}

struct EpiProj {
    static constexpr bool PERM = true;
    bf16_t* P; bf16_t* KB; bf16_t* VB; bf16_t* KI; float* WI; int part; float ascale;
    __device__ __forceinline__ void mid(f32x4 (&)[2][2][4][2], const pg8::Unit&, int, int, int, int) const {}
    __device__ __forceinline__ void operator()(const f32x4 (&acc)[2][2][4][2], const pg8::Unit& u, int wr, int wc, int fr, int fq) const {
        const int row0 = u.pm * 256 + wr * 64 + fr;
        const int pn = part ? (u.pn < 12 ? u.pn : u.pn + 2) : (u.pn < 2 ? 12 + u.pn : 22);
        if (pn < 22) {
            int mode = 0; float sc = ascale;
            if (pn < 2 || pn == 8 || pn == 9) sc = QSC * ascale;
            else if (pn == 6 || pn == 7 || pn == 10 || pn == 11) mode = 1;
            else if (pn >= 14) mode = 2;
            const int col0 = pn * 256 + wc * 32 + 8 * fq;
            const float c2 = -sc * LOG2E;
#define EPI_BODY(EXPR_) do { _Pragma("unroll") for (int ai = 0; ai < 2; ++ai) _Pragma("unroll") for (int m = 0; m < 4; ++m) { \
                bf16_t* rowp = P + (size_t)(row0 + ai * 128 + m * 16) * PW + col0; \
                _Pragma("unroll") for (int bj = 0; bj < 2; ++bj) { float v[8]; \
                    _Pragma("unroll") for (int e = 0; e < 4; ++e) { v[e] = acc[ai][bj][m][0][e]; v[4 + e] = acc[ai][bj][m][1][e]; } \
                    _Pragma("unroll") for (int e = 0; e < 8; ++e) { float x = v[e]; EXPR_; asm("" : "+v"(x)); v[e] = x; } \
                    u32x4 w; w.x = cvtpk(v[0], v[1]); w.y = cvtpk(v[2], v[3]); w.z = cvtpk(v[4], v[5]); w.w = cvtpk(v[6], v[7]); \
                    *(u32x4*)(rowp + bj * 128) = w; } } } while (0)
            if (pn == 8 || pn == 9) {
                const int qcol0 = (pn & 1) * 256 + wc * 32 + 8 * fq;
                const float s8 = sc * 8.f;
#pragma unroll
                for (int ai = 0; ai < 2; ++ai)
#pragma unroll
                    for (int m = 0; m < 4; ++m) {
                        unsigned char* rowp = (unsigned char*)(P + (size_t)(row0 + ai * 128 + m * 16) * PW + C_QB) + qcol0;
#pragma unroll
                        for (int bj = 0; bj < 2; ++bj) {
                            const f32x4 a = acc[ai][bj][m][0] * s8, b = acc[ai][bj][m][1] * s8;
                            u32x2 w; w.x = pk4_fp8(a[0], a[1], a[2], a[3]); w.y = pk4_fp8(b[0], b[1], b[2], b[3]);
                            *(u32x2*)(rowp + bj * 128) = w;
                        }
                    }
            }
            else if (mode == 0) EPI_BODY(x = x * sc);
            else if (mode == 1) {
                const int zcol0 = (pn & 1) * 256 + wc * 32 + 8 * fq;
#pragma unroll
                for (int ai = 0; ai < 2; ++ai)
#pragma unroll
                    for (int m = 0; m < 4; ++m) {
                        unsigned char* rowp = (unsigned char*)(P + (size_t)(row0 + ai * 128 + m * 16) * PW + (pn < 8 ? C_ZA : C_ZB)) + zcol0;
#pragma unroll
                        for (int bj = 0; bj < 2; ++bj) {
                            float v[8];
#pragma unroll
                            for (int e = 0; e < 8; ++e) {
                                float x = acc[ai][bj][m][e >> 2][e & 3];
                                float e_ = __builtin_amdgcn_exp2f(x * c2); asm("" : "+v"(e_));
                                e_ = __builtin_amdgcn_rcpf(1.f + e_); asm("" : "+v"(e_));
                                x = x * sc; asm("" : "+v"(x));
                                v[e] = x * e_;
                            }
                            u32x2 w; w.x = pk4_fp8(v[0], v[1], v[2], v[3]); w.y = pk4_fp8(v[4], v[5], v[6], v[7]);
                            *(u32x2*)(rowp + bj * 128) = w;
                        }
                    }
            }
            else {
                const int gcol0 = (pn - 14) * 256 + wc * 32 + 8 * fq;
#pragma unroll
                for (int ai = 0; ai < 2; ++ai)
#pragma unroll
                    for (int m = 0; m < 4; ++m) {
                        unsigned char* rowp = (unsigned char*)(P + (size_t)(row0 + ai * 128 + m * 16) * PW + C_GA) + gcol0;
#pragma unroll
                        for (int bj = 0; bj < 2; ++bj) {
                            u32x2 w = (u32x2){0u, 0u};
#pragma unroll
                            for (int e = 0; e < 8; ++e) {
                                float x = acc[ai][bj][m][e >> 2][e & 3];
                                float e_ = __builtin_amdgcn_exp2f(x * c2); asm("" : "+v"(e_));
                                x = __builtin_fmaf(__builtin_amdgcn_rcpf(1.f + e_), 254.f, 1.f); asm("" : "+v"(x));
                                if (e < 4) w.x = __builtin_amdgcn_cvt_pk_u8_f32(x, e & 3, w.x); else w.y = __builtin_amdgcn_cvt_pk_u8_f32(x, e & 3, w.y);
                            }
                            *(u32x2*)(rowp + bj * 128) = w;
                        }
                    }
            }
#undef EPI_BODY
        } else {
#pragma unroll
            for (int ai = 0; ai < 2; ++ai)
#pragma unroll
                for (int m = 0; m < 4; ++m) {
                    const size_t row = (size_t)(row0 + ai * 128 + m * 16);
                    {
                        const f32x4 a = acc[ai][0][m][0], b = acc[ai][0][m][1];
                        u32x4 w; w.x = cvtpk(a[0], a[1]); w.y = cvtpk(a[2], a[3]); w.z = cvtpk(b[0], b[1]); w.w = cvtpk(b[2], b[3]);
                        if (wc < 2) {
                            u32x2 w8; w8.x = pk4_fp8(a[0], a[1], a[2], a[3]); w8.y = pk4_fp8(b[0], b[1], b[2], b[3]);
                            *(u32x2*)((fp8_t*)KB + row * 64 + fq * 16 + wc * 8) = w8;
                        } else {
                            u32x2 w8; w8.x = pk4_fp8(a[0], a[1], a[2], a[3]); w8.y = pk4_fp8(b[0], b[1], b[2], b[3]);
                            *(u32x2*)((fp8_t*)VB + row * 64 + (wc - 2) * 32 + 8 * fq) = w8;
                        }
                    }
                    {
                        const f32x4 a = acc[ai][1][m][0], b = acc[ai][1][m][1];
                        if (wc < 2) {
                            u32x4 w; w.x = cvtpk(a[0], a[1]); w.y = cvtpk(a[2], a[3]); w.z = cvtpk(b[0], b[1]); w.w = cvtpk(b[2], b[3]);
                            *(u32x4*)(KI + row * 64 + wc * 32 + 8 * fq) = w;
                        } else if (wc == 2 && fq == 0) {
                            *(f32x4*)(WI + row * 8) = a * IDX_SCALE; *(f32x4*)(WI + row * 8 + 4) = b * IDX_SCALE;
                        }
                    }
                }
        }
    }
};

__device__ __forceinline__ u32x4 buf_load16(__amdgpu_buffer_rsrc_t r, unsigned voff, unsigned soff) { return __builtin_bit_cast(u32x4, __builtin_amdgcn_raw_buffer_load_b128(r, (int)voff, (int)soff, 0)); }
__device__ __forceinline__ void buf_store16(__amdgpu_buffer_rsrc_t r, unsigned voff, unsigned soff, u32x4 v) { __builtin_amdgcn_raw_buffer_store_b128(v, r, (int)voff, (int)soff, 0); }
struct EpiMerge {
    static constexpr bool PERM = true;
    const bf16_t* P; fp8_t* MG;
    static __device__ __forceinline__ float ub(unsigned w, int k) { return (float)((w >> (8 * k)) & 0xffu); }
    __device__ __forceinline__ void mid(f32x4 (&acc)[2][2][4][2], const pg8::Unit& u, int wr, int wc, int fr, int fq) const {
        { int l_ = (int)(threadIdx.x & 63u); asm volatile("" : "+v"(l_)); fr = l_ & 15; fq = l_ >> 4; }
        const __amdgpu_buffer_rsrc_t rp = __builtin_amdgcn_make_buffer_rsrc((void*)P, (short)0, (int)((size_t)NTOK * PW * 2), 0x00020000);
        const unsigned voff = (unsigned)(fr * PW * 2 + 8 * fq);
#pragma unroll
        for (int ai = 0; ai < 2; ++ai) {
            u32x2 sa[4][2], sb[4][2];
#pragma unroll
            for (int m = 0; m < 4; ++m) {
                const unsigned soff = (unsigned)(u.pm * 256 + wr * 64 + ai * 128 + m * 16) * (unsigned)(PW * 2) + (unsigned)(2 * C_GA + u.pn * 256 + wc * 32);
#pragma unroll
                for (int bj = 0; bj < 2; ++bj) {
                    sa[m][bj] = __builtin_bit_cast(u32x2, __builtin_amdgcn_raw_buffer_load_b64(rp, (int)voff, (int)(soff + bj * 128), 0));
                    sb[m][bj] = __builtin_bit_cast(u32x2, __builtin_amdgcn_raw_buffer_load_b64(rp, (int)voff, (int)(soff + 1024 + bj * 128), 0));
                }
            }
#pragma unroll
            for (int m = 0; m < 4; ++m)
#pragma unroll
                for (int bj = 0; bj < 2; ++bj)
#pragma unroll
                    for (int d = 0; d < 2; ++d)
#pragma unroll
                        for (int k = 0; k < 4; ++k) acc[ai][bj][m][d][k] *= ub(sa[m][bj][d], k) * __builtin_amdgcn_rcpf(ub(sb[m][bj][d], k));
            asm volatile("" ::: "memory");
        }
    }
    __device__ __forceinline__ void operator()(const f32x4 (&acc)[2][2][4][2], const pg8::Unit& u, int wr, int wc, int fr, int fq) const {
        { int l_ = (int)(threadIdx.x & 63u); asm volatile("" : "+v"(l_)); fr = l_ & 15; fq = l_ >> 4; }
        const __amdgpu_buffer_rsrc_t rp = __builtin_amdgcn_make_buffer_rsrc((void*)P, (short)0, (int)((size_t)NTOK * PW * 2), 0x00020000);
        const __amdgpu_buffer_rsrc_t ro = __builtin_amdgcn_make_buffer_rsrc((void*)MG, (short)0, (int)((size_t)NTOK * DM), 0x00020000);
        const unsigned voff = (unsigned)(fr * PW * 2 + 8 * fq), voffo = (unsigned)(fr * DM + 8 * fq);
        constexpr float c8 = Y8_SCALE * ACC8_UNSCALE * (1.f / 255.f);
#pragma unroll
        for (int ai = 0; ai < 2; ++ai) {
            u32x2 sb[4][2];
#pragma unroll
            for (int m = 0; m < 4; ++m) {
                const unsigned soff = (unsigned)(u.pm * 256 + wr * 64 + ai * 128 + m * 16) * (unsigned)(PW * 2) + (unsigned)(2 * C_GA + 1024 + u.pn * 256 + wc * 32);
#pragma unroll
                for (int bj = 0; bj < 2; ++bj) sb[m][bj] = __builtin_bit_cast(u32x2, __builtin_amdgcn_raw_buffer_load_b64(rp, (int)voff, (int)(soff + bj * 128), 0));
            }
#pragma unroll
            for (int m = 0; m < 4; ++m) {
                const unsigned soffo = (unsigned)(u.pm * 256 + wr * 64 + ai * 128 + m * 16) * (unsigned)DM + (unsigned)(u.pn * 256 + wc * 32);
#pragma unroll
                for (int bj = 0; bj < 2; ++bj) {
                    const f32x4 a = acc[ai][bj][m][0], b = acc[ai][bj][m][1];
                    const u32x2 g = sb[m][bj];
                    u32x2 w;
                    w.x = pk4_fp8(a[0] * ub(g.x, 0) * c8, a[1] * ub(g.x, 1) * c8, a[2] * ub(g.x, 2) * c8, a[3] * ub(g.x, 3) * c8);
                    w.y = pk4_fp8(b[0] * ub(g.y, 0) * c8, b[1] * ub(g.y, 1) * c8, b[2] * ub(g.y, 2) * c8, b[3] * ub(g.y, 3) * c8);
                    __builtin_amdgcn_raw_buffer_store_b64(w, ro, (int)voffo, (int)(soffo + bj * 128), 0);
                }
            }
            asm volatile("" ::: "memory");
        }
    }
};

struct EpiOut {
    static constexpr bool PERM = false;
    const bf16_t* XN; const float* RSX; float* O; float* RSS; const float* G; unsigned* CNT;
    __device__ __forceinline__ void mid(f32x4 (&)[2][2][4][2], const pg8::Unit&, int, int, int, int) const {}
    __device__ __forceinline__ void operator()(f32x4 (&acc)[2][2][4][2], const pg8::Unit& u, int wr, int wc, int fr, int fq) const {
        { int l_ = (int)(threadIdx.x & 63u); asm volatile("" : "+v"(l_)); fr = l_ & 15; fq = l_ >> 4; }
        const int col0 = u.pn * 256 + wc * 32 + 4 * fq;
#pragma unroll
        for (int ai = 0; ai < 2; ++ai) {
            u32x2 xv[4][2][2]; float rx[4];
#pragma unroll
            for (int m = 0; m < 4; ++m) {
                const int row = u.pm * 256 + ai * 128 + wr * 64 + m * 16 + fr;
                const size_t off = (size_t)row * DM + col0;
                rx[m] = RSX[row];
#pragma unroll
                for (int bj = 0; bj < 2; ++bj)
#pragma unroll
                    for (int n = 0; n < 2; ++n) xv[m][bj][n] = *(const u32x2*)(XN + off + bj * 128 + n * 16);
            }
#pragma unroll
            for (int m = 0; m < 4; ++m) {
                const int row = u.pm * 256 + ai * 128 + wr * 64 + m * 16 + fr;
                float ss = 0.f;
#pragma unroll
                for (int bj = 0; bj < 2; ++bj)
#pragma unroll
                    for (int n = 0; n < 2; ++n) {
                        const u32x2 xb = xv[m][bj][n];
                        const f32x4 hv = (f32x4){bf_lo(xb.x), bf_hi(xb.x), bf_lo(xb.y), bf_hi(xb.y)} * rx[m] + acc[ai][bj][m][n] * ACC8_UNSCALE;
                        ss += (hv[0] * hv[0] + hv[1] * hv[1]) + (hv[2] * hv[2] + hv[3] * hv[3]);
                        acc[ai][bj][m][n] = hv;
                    }
                ss += __shfl_xor(ss, 16); ss += __shfl_xor(ss, 32);
                if (fq == 0) atomicAdd(RSS + row, ss);
            }
            asm volatile("" ::: "memory");
        }
        asm volatile("s_waitcnt vmcnt(0)" ::: "memory");
        unsigned* cnt = CNT + 16 * u.pm;
        if ((threadIdx.x & 63) == 0) (void)__hip_atomic_fetch_add(cnt, 1u, __ATOMIC_RELAXED, __HIP_MEMORY_SCOPE_AGENT);
        for (unsigned sp = 0; sp < (1u << 22); ++sp) {
            const unsigned c = (unsigned)__builtin_amdgcn_readfirstlane((int)__hip_atomic_load(cnt, __ATOMIC_RELAXED, __HIP_MEMORY_SCOPE_AGENT));
            if (c >= 32u) break;
            __builtin_amdgcn_s_sleep(1);
        }
        float tot[2][4];
#pragma unroll
        for (int ai = 0; ai < 2; ++ai)
#pragma unroll
            for (int m = 0; m < 4; ++m) {
                const int row = u.pm * 256 + ai * 128 + wr * 64 + m * 16 + fr;
                tot[ai][m] = 0.f;
                if (fq == 0) tot[ai][m] = __hip_atomic_fetch_add(RSS + row, 0.f, __ATOMIC_RELAXED, __HIP_MEMORY_SCOPE_AGENT);
            }
        f32x4 gg[2][2];
#pragma unroll
        for (int bj = 0; bj < 2; ++bj)
#pragma unroll
            for (int n = 0; n < 2; ++n) gg[bj][n] = *(const f32x4*)(G + col0 + bj * 128 + n * 16);
#pragma unroll
        for (int ai = 0; ai < 2; ++ai)
#pragma unroll
            for (int m = 0; m < 4; ++m) {
                const int row = u.pm * 256 + ai * 128 + wr * 64 + m * 16 + fr;
                const size_t off = (size_t)row * DM + col0;
                const float t = __shfl(tot[ai][m], fr);
                const float rs = __builtin_amdgcn_rsqf(t * (1.f / DM) + EPS);
#pragma unroll
                for (int bj = 0; bj < 2; ++bj)
#pragma unroll
                    for (int n = 0; n < 2; ++n) *(f32x4*)(O + off + bj * 128 + n * 16) = acc[ai][bj][m][n] * rs * gg[bj][n];
            }
    }
};

struct Ctx {
    LAS unsigned char* lds;
    int tid, lane, wave, G, bid;
    const float *x, *norm_gain, *w_in, *a_rel, *t5, *w_a, *w_b, *w_o, *fgain;
    float* out;
    bf16_t *WT1, *KB, *VB, *KI, *XN, *P;
    fp8_t *WAT, *WBT, *WOT, *Y8, *MG8, *WT18, *XN8;
    float *WI, *RSS, *RSX;
    unsigned long long dbg;
};

__device__ __forceinline__ int proj_src_col(int d0, int& nvalid) {
    nvalid = 32;
    if (d0 < 2560) return d0;
    if (d0 < 3072) return d0 - 2560 + 2688;
    if (d0 < 3584) return d0 - 3072 + 3200;
    if (d0 < 5632) return d0 - 3584 + 3784;
    if (d0 < 5760) return d0 - 5632 + 2560;
    if (d0 < 5824) return d0 - 5760 + 3712;
    if (d0 == 5824) { nvalid = 8; return 3776; }
    nvalid = 0; return 0;
}
__device__ __forceinline__ void transpose_item(const float* W, int ldw, int src_n0, int nvalid, const float* gain, bf16_t* WT, int K, int dst_row0, int k0, LAS float* scr, int lane) {
#pragma unroll 8
    for (int i = 0; i < 32; ++i) {
        const int kk = 2 * i + (lane >> 5), col = lane & 31;
        float v = 0.f;
        if (col < nvalid) { v = W[(size_t)(k0 + kk) * ldw + src_n0 + col]; if (gain) v *= gain[k0 + kk]; }
        scr[kk * 33 + col] = v;
    }
    asm volatile("s_waitcnt lgkmcnt(0)" ::: "memory");
    const int c = lane & 7;
#pragma unroll
    for (int j = 0; j < 4; ++j) {
        const int n = (lane >> 3) + 8 * j; const LAS float* s = scr + (8 * c) * 33 + n;
        u32x4 o; o.x = cvtpk(s[0 * 33], s[1 * 33]); o.y = cvtpk(s[2 * 33], s[3 * 33]); o.z = cvtpk(s[4 * 33], s[5 * 33]); o.w = cvtpk(s[6 * 33], s[7 * 33]);
        *(u32x4*)(WT + (size_t)(dst_row0 + n) * K + k0 + 8 * c) = o;
    }
    asm volatile("s_waitcnt lgkmcnt(0)" ::: "memory");
}
__device__ __forceinline__ void transpose_item8(const float* W, int ldw, int src_n0, const float* gain, fp8_t* WT, int K, int dst_row0, int k0, LAS float* scr, int lane) {
#pragma unroll 8
    for (int i = 0; i < 32; ++i) {
        const int kk = 2 * i + (lane >> 5), col = lane & 31;
        float v = W[(size_t)(k0 + kk) * ldw + src_n0 + col] * W8_SCALE; if (gain) v *= gain[k0 + kk];
        scr[kk * 33 + col] = v;
    }
    asm volatile("s_waitcnt lgkmcnt(0)" ::: "memory");
    const int c = lane & 7;
#pragma unroll
    for (int j = 0; j < 4; ++j) {
        const int n = (lane >> 3) + 8 * j; const LAS float* s = scr + (8 * c) * 33 + n;
        u32x2 o; o.x = pk4_fp8(s[0 * 33], s[1 * 33], s[2 * 33], s[3 * 33]); o.y = pk4_fp8(s[4 * 33], s[5 * 33], s[6 * 33], s[7 * 33]);
        *(u32x2*)(WT + (size_t)(dst_row0 + n) * K + k0 + 8 * c) = o;
    }
    asm volatile("s_waitcnt lgkmcnt(0)" ::: "memory");
}
__device__ __forceinline__ void p0_prologue(Ctx& C) {
    LAS float* scr = (LAS float*)(C.lds + C.wave * 16384);
    const int gw = C.bid * NWAVES + C.wave, NGW = C.G * NWAVES;
    constexpr int I_IN = 16 * (NW1 / 32), I_A = 8 * 32, I_O = 16 * 32, NITEMS = I_IN + 2 * I_A + I_O;
    for (int it = gw; it < NITEMS; it += NGW) {
        int r = it;
        if (r < I_IN) { const int kb = r / (NW1 / 32), nb = r % (NW1 / 32); int nv; const int sc = proj_src_col(nb * 32, nv);
            const int dt = nb >> 3, drow = (nb & 7) * 32;
            if (dt == 12 || dt == 13 || dt == 22) transpose_item(C.w_in, IN_COLS, sc, nv, C.norm_gain, C.WT1, DM, (dt == 22 ? 512 : (dt - 12) * 256) + drow, kb * 64, scr, C.lane);
            else transpose_item8(C.w_in, IN_COLS, sc, C.norm_gain, C.WT18, DM, (dt < 12 ? dt : dt - 2) * 256 + drow, kb * 64, scr, C.lane);
            continue; }
        r -= I_IN;
        if (r < I_A) { transpose_item8(C.w_a, DM, (r % 32) * 32, nullptr, C.WAT, 512, (r % 32) * 32, (r / 32) * 64, scr, C.lane); continue; }
        r -= I_A;
        if (r < I_A) { transpose_item8(C.w_b, DM, (r % 32) * 32, nullptr, C.WBT, 512, (r % 32) * 32, (r / 32) * 64, scr, C.lane); continue; }
        r -= I_A;
        transpose_item8(C.w_o, DM, (r % 32) * 32, nullptr, C.WOT, DM, (r % 32) * 32, (r / 32) * 64, scr, C.lane);
    }
    for (int m0 = gw * 4; m0 < NTOK; m0 += NGW * 4) {
        f32x4 v[4][4]; float s[4];
#pragma unroll
        for (int r = 0; r < 4; ++r) {
            const f32x4* xr = (const f32x4*)(C.x + (size_t)(m0 + r) * DM) + C.lane;
            s[r] = 0.f;
#pragma unroll
            for (int j = 0; j < 4; ++j) v[r][j] = __builtin_nontemporal_load(xr + 64 * j);
        }
#pragma unroll
        for (int r = 0; r < 4; ++r) {
#pragma unroll
            for (int j = 0; j < 4; ++j) s[r] += (v[r][j].x * v[r][j].x + v[r][j].y * v[r][j].y) + (v[r][j].z * v[r][j].z + v[r][j].w * v[r][j].w);
            float t = s[r];
            t += __uint_as_float(dpp_u<0x111, 0xf>(0u, __float_as_uint(t))); t += __uint_as_float(dpp_u<0x112, 0xf>(0u, __float_as_uint(t)));
            t += __uint_as_float(dpp_u<0x114, 0xf>(0u, __float_as_uint(t))); t += __uint_as_float(dpp_u<0x118, 0xf>(0u, __float_as_uint(t)));
            t += __uint_as_float(dpp_u<0x142, 0xa>(0u, __float_as_uint(t))); t += __uint_as_float(dpp_u<0x143, 0xc>(0u, __float_as_uint(t)));
            s[r] = __uint_as_float((unsigned)__builtin_amdgcn_readlane((int)__float_as_uint(t), 63));
        }
#pragma unroll
        for (int r = 0; r < 4; ++r) {
            const float rstd = __builtin_amdgcn_rsqf(s[r] * (1.f / DM) + EPS);
            if (C.lane == 0) C.RSX[m0 + r] = __builtin_amdgcn_sqrtf(s[r] * (1.f / DM) + EPS);
            u32x2* o8 = (u32x2*)(C.XN + (size_t)(m0 + r) * DM) + C.lane;
            unsigned* o4 = (unsigned*)(C.XN8 + (size_t)(m0 + r) * DM) + C.lane;
#pragma unroll
            for (int j = 0; j < 4; ++j) {
                const f32x4 y = v[r][j] * rstd;
                u32x2 w; w.x = cvtpk(y.x, y.y); w.y = cvtpk(y.z, y.w); o8[64 * j] = w;
                o4[64 * j] = pk4_fp8(y.x, y.y, y.z, y.w);
            }
        }
    }
    for (int i = C.bid * 512 + C.tid; i < NTOK; i += C.G * 512) { C.RSS[i] = 0.f;
    }
}

template <bool B> struct BoolC { static constexpr bool value = B; };
constexpr int A_WAVE_LDS = 1280 + 4096 + 9216;
__device__ __forceinline__ s16x4 tr_read(LAS unsigned char* p) { return __builtin_bit_cast(s16x4, __builtin_amdgcn_ds_read_tr16_b64_v4i16((LAS s16x4*)p)); }
template <int VAR> __device__ __forceinline__ void mixerA_unit(Ctx& C, int b, int c, int h, LAS unsigned char* wl, fp8_t* outp, int opitch) {
    const int lane = C.lane, r32 = lane & 31, hi = lane >> 5;
    LAS float* btab = (LAS float*)wl;
    LAS unsigned char* vimg = wl + 1280;
    LAS bf16_t* ost = (LAS bf16_t*)(wl + 1280 + 4096);
    const size_t tok0 = (size_t)b * SEQ + (size_t)c * 64;
    const bf16_t* Qp = C.P + tok0 * PW + C_QA + h * 64;
    bf16x8 qf[2][4];
#pragma unroll
    for (int qg = 0; qg < 2; ++qg)
#pragma unroll
        for (int ks = 0; ks < 4; ++ks) qf[qg][ks] = *(const bf16x8*)(Qp + (size_t)(32 * qg + r32) * PW + 16 * ks + 8 * hi);
    f32x16 o[2][2];
#pragma unroll
    for (int a = 0; a < 2; ++a)
#pragma unroll
        for (int q = 0; q < 2; ++q)
#pragma unroll
            for (int i = 0; i < 16; ++i) o[a][q][i] = 0.f;
    float mrun[2] = {-1e30f, -1e30f}, lrun[2] = {0.f, 0.f};
    const float bfar = C.a_rel[h * 513 + 512] * LOG2E;
    const int t0 = c < 8 ? (8 - c) * 2 : 0;
    const long kbase = (long)b * SEQ + (long)(c - 8) * 64;
    const int i16 = lane & 15, qq = i16 >> 2, pp = i16 & 3, blk = (lane >> 4) & 1;
    bf16x8 kfn[4]; u32x4 vn[4];
#define MA_LOAD(t_) do { const int j0_ = (t_) * 32; const bf16_t* Kp = C.P + (size_t)(kbase + j0_ + r32) * PW + C_KA + h * 64 + 8 * hi; \
        _Pragma("unroll") for (int ks = 0; ks < 4; ++ks) kfn[ks] = *(const bf16x8*)(Kp + 16 * ks); \
        _Pragma("unroll") for (int r = 0; r < 4; ++r) { const int pc = lane + 64 * r, key = pc >> 3, ch = pc & 7; \
            vn[r] = *(const u32x4*)(C.P + (size_t)(kbase + j0_ + key) * PW + C_VA + h * 64 + ch * 8); } } while (0)
    MA_LOAD(t0);
    for (int i = lane; i < 320; i += 64) btab[i] = C.a_rel[h * 513 + i + 193] * LOG2E;
    asm volatile("s_waitcnt lgkmcnt(0)" ::: "memory");
    auto ma_tile = [&](auto FARc, auto CLAMPc, auto LOADc, const int t) __attribute__((always_inline)) {
        constexpr bool FARK = decltype(FARc)::value, CLAMPK = decltype(CLAMPc)::value, LOADK = decltype(LOADc)::value;
        const int j0 = t * 32;
        bf16x8 kf[4];
#pragma unroll
        for (int ks = 0; ks < 4; ++ks) kf[ks] = kfn[ks];
        if (VAR != 1)
#pragma unroll
        for (int r = 0; r < 4; ++r) {
            const int pc = lane + 64 * r, key = pc >> 3, ch = pc & 7;
            *(LAS u32x4*)(vimg + (ch >> 2) * 2048 + key * 64 + (ch & 3) * 16) = vn[r];
        }
        if (VAR == 1) { o[0][0][0] += __uint_as_float(vn[0].x ^ vn[3].w); }
        if (LOADK) MA_LOAD(t + 1);
        constexpr bool far = FARK;
        const float cinit = far ? bfar : 0.f;
        f32x16 s[2];
        __builtin_amdgcn_s_setprio(1);
#pragma unroll
        for (int qg = 0; qg < 2; ++qg) {
#pragma unroll
            for (int i = 0; i < 16; ++i) s[qg][i] = cinit;
#pragma unroll
            for (int ks = 0; ks < 4; ++ks) s[qg] = __builtin_amdgcn_mfma_f32_32x32x16_bf16(kf[ks], qf[qg][ks], s[qg], 0, 0, 0);
        }
        __builtin_amdgcn_s_setprio(0);
        float tmax[2];
#pragma unroll
        for (int qg = 0; qg < 2; ++qg) {
            const int q = 32 * qg + r32;
            float tm = -1e30f;
            if (!far && VAR != 2) {
                if (CLAMPK) {
#pragma unroll
                    for (int i = 0; i < 16; ++i) {
                        const int j = j0 + crow(i, hi); const int rel = 512 + q - j; const int bi = (rel < 256 ? rel : 256) + 63;
                        s[qg][i] += btab[bi];
                    }
                } else {
                    const LAS float* bp = btab + (575 - 27 + q - j0 - 4 * hi);
#pragma unroll
                    for (int i = 0; i < 16; ++i) s[qg][i] += bp[27 - ((i & 3) + 8 * (i >> 2))];
                }
            }
#pragma unroll
            for (int i = 0; i < 16; ++i) tm = fmaxf(tm, s[qg][i]);
            tmax[qg] = xmax32(tm);
        }
        if (__any((tmax[0] > mrun[0] + 8.f) || (tmax[1] > mrun[1] + 8.f))) {
#pragma unroll
            for (int qg = 0; qg < 2; ++qg) {
                const float mn = fmaxf(mrun[qg], tmax[qg]), alpha = __builtin_amdgcn_exp2f(mrun[qg] - mn); mrun[qg] = mn;
                lrun[qg] *= alpha;
#pragma unroll
                for (int dt = 0; dt < 2; ++dt)
#pragma unroll
                    for (int i = 0; i < 16; ++i) o[dt][qg][i] *= alpha;
            }
        }
        bf16x8 pk[2][2];
#pragma unroll
        for (int qg = 0; qg < 2; ++qg) {
            const float mn = mrun[qg];
            float ps = 0.f;
#pragma unroll
            for (int i = 0; i < 16; ++i) { const float p = (VAR == 2) ? s[qg][i] : __builtin_amdgcn_exp2f(s[qg][i] - mn); s[qg][i] = p; ps += p; }
            lrun[qg] += ps;
#pragma unroll
            for (int st = 0; st < 2; ++st) {
                u32x4 w; w.x = cvtpk(s[qg][8 * st + 0], s[qg][8 * st + 1]); w.y = cvtpk(s[qg][8 * st + 2], s[qg][8 * st + 3]);
                w.z = cvtpk(s[qg][8 * st + 4], s[qg][8 * st + 5]); w.w = cvtpk(s[qg][8 * st + 6], s[qg][8 * st + 7]);
                pk[qg][st] = __builtin_bit_cast(bf16x8, w);
            }
        }
        asm volatile("s_waitcnt lgkmcnt(0)" ::: "memory");
        if (VAR == 1) { o[0][0][1] += __uint_as_float(__builtin_bit_cast(u32x4, pk[0][0]).x ^ __builtin_bit_cast(u32x4, pk[1][1]).w ^ __builtin_bit_cast(u32x4, pk[0][1]).y ^ __builtin_bit_cast(u32x4, pk[1][0]).z); } else
#pragma unroll
        for (int dt = 0; dt < 2; ++dt)
#pragma unroll
            for (int st = 0; st < 2; ++st) {
                LAS unsigned char* pb = vimg + dt * 2048 + (16 * st + 4 * hi + qq) * 64 + (16 * blk + 4 * pp) * 2;
                const s16x4 lo = tr_read(pb), hi4 = tr_read(pb + 8 * 64);
                const bf16x8 vf = __builtin_shufflevector(lo, hi4, 0, 1, 2, 3, 4, 5, 6, 7);
                __builtin_amdgcn_s_setprio(1);
#pragma unroll
                for (int qg = 0; qg < 2; ++qg) o[dt][qg] = __builtin_amdgcn_mfma_f32_32x32x16_bf16(vf, pk[qg][st], o[dt][qg], 0, 0, 0);
                __builtin_amdgcn_s_setprio(0);
            }
        asm volatile("s_waitcnt lgkmcnt(0)" ::: "memory");
    };
    u32x2 zv8[8];
    {
        int t = t0;
#pragma unroll 1
        for (; t < 8; ++t) ma_tile(BoolC<true>{}, BoolC<false>{}, BoolC<true>{}, t);
#pragma unroll 1
        for (; t < 10; ++t) ma_tile(BoolC<false>{}, BoolC<true>{}, BoolC<true>{}, t);
#pragma unroll 1
        for (; t < 17; ++t) ma_tile(BoolC<false>{}, BoolC<false>{}, BoolC<true>{}, t);
#pragma unroll
        for (int r = 0; r < 8; ++r) { const int row = (lane >> 3) + 8 * r, ch = lane & 7; zv8[r] = *(const u32x2*)((const unsigned char*)(C.P + (tok0 + row) * PW + C_ZA) + h * 64 + ch * 8); }
        ma_tile(BoolC<false>{}, BoolC<false>{}, BoolC<false>{}, 17);
    }
#undef MA_LOAD
#pragma unroll
    for (int qg = 0; qg < 2; ++qg) {
        const float lt = xsum32(lrun[qg]); const float inv = __builtin_amdgcn_rcpf(lt);
#pragma unroll
        for (int dt = 0; dt < 2; ++dt)
#pragma unroll
            for (int i = 0; i < 16; ++i) ost[(32 * qg + r32) * 72 + 32 * dt + crow(i, hi)] = f2bf(o[dt][qg][i] * inv);
    }
    asm volatile("s_waitcnt lgkmcnt(0)" ::: "memory");
#pragma unroll
    for (int r = 0; r < 8; ++r) {
        const int row = (lane >> 3) + 8 * r, ch = lane & 7;
        const u32x4 ov = *(const LAS u32x4*)(ost + row * 72 + ch * 8);
        const u32x2 zv = zv8[r];
#define Z8(w_, k_) __builtin_amdgcn_cvt_f32_fp8((int)(w_), k_)
        u32x2 w;
        w.x = pk4_fp8(bf_lo(ov[0]) * Z8(zv.x, 0) * Y8_SCALE, bf_hi(ov[0]) * Z8(zv.x, 1) * Y8_SCALE, bf_lo(ov[1]) * Z8(zv.x, 2) * Y8_SCALE, bf_hi(ov[1]) * Z8(zv.x, 3) * Y8_SCALE);
        w.y = pk4_fp8(bf_lo(ov[2]) * Z8(zv.y, 0) * Y8_SCALE, bf_hi(ov[2]) * Z8(zv.y, 1) * Y8_SCALE, bf_lo(ov[3]) * Z8(zv.y, 2) * Y8_SCALE, bf_hi(ov[3]) * Z8(zv.y, 3) * Y8_SCALE);
#undef Z8
        *(u32x2*)(outp + (tok0 + row) * (size_t)opitch + h * 64 + ch * 8) = w;
    }
    asm volatile("s_waitcnt lgkmcnt(0)" ::: "memory");
}

__device__ __forceinline__ int t5_bucket(int rel) {
    const int n = rel < 0 ? -rel : rel;
    int big = 8 + (n >= 12) + (n >= 16) + (n >= 23) + (n >= 32) + (n >= 46) + (n >= 64) + (n >= 91);
    asm volatile("" : "+v"(big));
    int bkt = n < 8 ? n : big;
    return bkt + (rel > 0 ? 16 : 0);
}
constexpr int BF_STRIDE = 580;
constexpr int BF_LIST = 0;
constexpr int BF_CNT = 64 * BF_STRIDE * 4;
constexpr int BF_THRF = BF_CNT + 512;
constexpr int BF_PEND = BF_THRF + 256;
constexpr int BF_HIST = BF_PEND + 768;
constexpr int BF_T5 = BF_HIST + 8192;
constexpr int BF_PBAR = BF_T5 + 1024;
constexpr int BF_END = BF_PBAR + 64;
constexpr int BF_CAP = 576;
static_assert(BF_END <= LDS_BYTES - 64 && 8 * 1024 + 4096 <= 8 * BF_STRIDE * 4, "LDS map");

constexpr int NV = 9;
__device__ __forceinline__ unsigned pack_key(float s, unsigned idxinv) { const int b = __float_as_int(s); const unsigned u = (unsigned)b ^ ((unsigned)(b >> 31) | 0x80000000u); return (u & 0xFFFFE000u) | idxinv; }
__device__ __forceinline__ float key_lower_float(unsigned T) { const unsigned u = T & 0xFFFFE000u; const unsigned bits = (u & 0x80000000u) ? (u & 0x7FFFFFFFu) : ~u; return __uint_as_float(bits); }
__device__ __forceinline__ unsigned wave_prefix_sum(unsigned v) {
    v += dpp_u<0x111, 0xf>(0u, v); v += dpp_u<0x112, 0xf>(0u, v); v += dpp_u<0x114, 0xf>(0u, v); v += dpp_u<0x118, 0xf>(0u, v);
    v += dpp_u<0x142, 0xa>(0u, v); v += dpp_u<0x143, 0xc>(0u, v); return v;
}
__device__ __forceinline__ unsigned wave_max_u(unsigned v) {
    unsigned t;
    t = dpp_u<0x111, 0xf>(0u, v); v = v > t ? v : t; t = dpp_u<0x112, 0xf>(0u, v); v = v > t ? v : t;
    t = dpp_u<0x114, 0xf>(0u, v); v = v > t ? v : t; t = dpp_u<0x118, 0xf>(0u, v); v = v > t ? v : t;
    t = dpp_u<0x142, 0xa>(0u, v); v = v > t ? v : t; t = dpp_u<0x143, 0xc>(0u, v); v = v > t ? v : t;
    return (unsigned)__builtin_amdgcn_readlane((int)v, 63);
}
__device__ __forceinline__ unsigned wave_min_u(unsigned v) {
    unsigned t;
    t = dpp_u<0x111, 0xf>(0xFFFFFFFFu, v); v = v < t ? v : t; t = dpp_u<0x112, 0xf>(0xFFFFFFFFu, v); v = v < t ? v : t;
    t = dpp_u<0x114, 0xf>(0xFFFFFFFFu, v); v = v < t ? v : t; t = dpp_u<0x118, 0xf>(0xFFFFFFFFu, v); v = v < t ? v : t;
    t = dpp_u<0x142, 0xa>(0xFFFFFFFFu, v); v = v < t ? v : t; t = dpp_u<0x143, 0xc>(0xFFFFFFFFu, v); v = v < t ? v : t;
    return (unsigned)__builtin_amdgcn_readlane((int)v, 63);
}
__device__ __forceinline__ int mbcnt64(unsigned long long m) { return __builtin_amdgcn_mbcnt_hi((unsigned)(m >> 32), __builtin_amdgcn_mbcnt_lo((unsigned)m, 0u)); }
#define LDS_BARRIER() do { asm volatile("s_waitcnt lgkmcnt(0)" ::: "memory"); __builtin_amdgcn_s_barrier(); asm volatile("" ::: "memory"); } while (0)

__device__ __forceinline__ void select_query(LAS unsigned* lq, LAS unsigned* cntp, LAS float* thrp, LAS unsigned* hist, LAS unsigned* dummy, const int cn, bool exact, const int lane) {
    unsigned v[NV];
#pragma unroll
    for (int i = 0; i < NV; ++i) v[i] = lq[i * 64 + lane];
    unsigned mx = 0u, mn = 0xFFFFFFFFu;
#pragma unroll
    for (int i = 0; i < NV; ++i) { if (i * 64 + lane >= cn) v[i] = 0u; mx = v[i] > mx ? v[i] : mx; const unsigned w = v[i] ? v[i] : 0xFFFFFFFFu; mn = w < mn ? w : mn; }
    mx = wave_max_u(mx); mn = wave_min_u(mn);
    int need = 256;
    unsigned base = mn;
    const unsigned range = mx - mn;
    int sh = range >= 256u ? (24 - __builtin_clz(range)) : 0;
    unsigned T = 0u;
    for (;;) {
        *(LAS u32x4*)(hist + lane * 4) = (u32x4){0u, 0u, 0u, 0u};
        asm volatile("s_waitcnt lgkmcnt(0)" ::: "memory");
#pragma unroll
        for (int i = 0; i < NV; ++i) {
            const unsigned dgt = (v[i] - base) >> sh;
            const bool in = (v[i] != 0u) && (v[i] >= base) && (dgt < 256u);
            (void)__hip_atomic_fetch_add(in ? hist + (255u - dgt) : dummy, 1u, __ATOMIC_RELAXED, __HIP_MEMORY_SCOPE_WORKGROUP);
        }
        asm volatile("s_waitcnt lgkmcnt(0)" ::: "memory");
        const u32x4 hb = *(const LAS u32x4*)(hist + lane * 4);
        const unsigned S = hb.x + hb.y + hb.z + hb.w;
        const unsigned incl = wave_prefix_sum(S);
        const unsigned excl = incl - S;
        int phys; unsigned popl, abvl;
        {
            const unsigned c0 = excl, c1 = c0 + hb.x, c2 = c1 + hb.y, c3 = c2 + hb.z;
            const bool r0 = c1 >= (unsigned)need, r1 = c2 >= (unsigned)need, r2 = c3 >= (unsigned)need;
            phys = r0 ? 0 : r1 ? 1 : r2 ? 2 : 3;
            popl = r0 ? hb.x : r1 ? hb.y : r2 ? hb.z : hb.w;
            abvl = r0 ? c0 : r1 ? c1 : r2 ? c2 : c3;
            phys += 4 * lane;
        }
        const unsigned long long cm = __ballot(incl >= (unsigned)need);
        const int src = __ffsll((long long)cm) - 1;
        const int bin = 255 - __builtin_amdgcn_readlane(phys, src);
        const int pop = __builtin_amdgcn_readlane((int)popl, src), above = __builtin_amdgcn_readlane((int)abvl, src);
        const unsigned newbase = base + ((unsigned)bin << sh);
        const int kept = (256 - need) + above + pop;
        if (!exact) {
            if (kept <= 288 || sh == 0) { T = newbase; break; }
            exact = true;
        }
        need -= above;
        if (pop <= 64 || sh == 0) {
            int pos = 0;
#pragma unroll
            for (int i = 0; i < NV; ++i) {
                const bool in = (v[i] != 0u) && (v[i] >= newbase) && (((v[i] - newbase) >> sh) == 0u);
                const unsigned long long mk = __ballot(in);
                { LAS unsigned* d_ = in ? hist + (pos + mbcnt64(mk)) : dummy; *d_ = v[i]; }
                pos += __popcll(mk);
            }
            { LAS unsigned* d_ = lane < 4 ? hist + (pos + lane) : dummy; *d_ = 0u; }
            asm volatile("s_waitcnt lgkmcnt(0)" ::: "memory");
            const unsigned e = (lane < pop) ? hist[lane] : 0u;
            int rk = 0;
            for (int k = 0; k < pop; k += 4) {
                const u32x4 h4 = *(const LAS u32x4*)(hist + k);
                rk += ((h4.x > e) ? 1 : 0) + ((h4.y > e) ? 1 : 0) + ((h4.z > e) ? 1 : 0) + ((h4.w > e) ? 1 : 0);
            }
            const bool isT = (lane < pop) && (rk == need - 1);
            const unsigned long long tm = __ballot(isT);
            T = (unsigned)__builtin_amdgcn_readlane((int)e, __ffsll((long long)tm) - 1);
            break;
        }
        base = newbase; sh = sh > 8 ? sh - 8 : 0;
    }
    int pos = 0;
#pragma unroll
    for (int i = 0; i < NV; ++i) {
        const bool k = (v[i] != 0u) && (v[i] >= T);
        const unsigned long long mk = __ballot(k);
        { LAS unsigned* d_ = k ? lq + (pos + mbcnt64(mk)) : dummy; *d_ = v[i]; }
        pos += __popcll(mk);
    }
    if (lane == 0) { *cntp = (unsigned)pos; *thrp = key_lower_float(T); }
    asm volatile("s_waitcnt lgkmcnt(0)" ::: "memory");
}

#define PRUNE_MASKS(T_) asm("v_cmp_le_u32_e64 %0, %9, %10\n\tv_cmp_le_u32_e64 %1, %9, %11\n\tv_cmp_le_u32_e64 %2, %9, %12\n\tv_cmp_le_u32_e64 %3, %9, %13\n\tv_cmp_le_u32_e64 %4, %9, %14\n\t" \
            "v_cmp_le_u32_e64 %5, %9, %15\n\tv_cmp_le_u32_e64 %6, %9, %16\n\tv_cmp_le_u32_e64 %7, %9, %17\n\tv_cmp_le_u32_e64 %8, %9, %18" \
            : "=&s"(m0), "=&s"(m1), "=&s"(m2), "=&s"(m3), "=&s"(m4), "=&s"(m5), "=&s"(m6), "=&s"(m7), "=&s"(m8) \
            : "s"(T_), "v"(v[0]), "v"(v[1]), "v"(v[2]), "v"(v[3]), "v"(v[4]), "v"(v[5]), "v"(v[6]), "v"(v[7]), "v"(v[8]))
__device__ __forceinline__ void prune_query(LAS unsigned* lq, LAS unsigned* cntp, LAS float* thrp, LAS unsigned* dummy, const int cn, const int lane) {
    __builtin_amdgcn_s_setprio(3);
    unsigned v[NV];
#pragma unroll
    for (int i = 0; i < NV; ++i) v[i] = lq[i * 64 + lane];
    const float thr_old = __uint_as_float((unsigned)__builtin_amdgcn_readfirstlane((int)__float_as_uint(*thrp)));
    if (7 * 64 + lane >= cn) v[7] = 0u;
    if (8 * 64 + lane >= cn) v[8] = 0u;
    unsigned mx = v[0];
#pragma unroll
    for (int i = 1; i < NV; ++i) mx = v[i] > mx ? v[i] : mx;
    unsigned hi = wave_max_u(mx), lo;
    if (thr_old == -INFINITY) {
        unsigned mn = v[0];
#pragma unroll
        for (int i = 1; i < 7; ++i) mn = v[i] < mn ? v[i] : mn;
        const unsigned w7 = v[7] ? v[7] : 0xFFFFFFFFu, w8 = v[8] ? v[8] : 0xFFFFFFFFu;
        mn = w7 < mn ? w7 : mn; mn = w8 < mn ? w8 : mn;
        lo = wave_min_u(mn);
    } else lo = pack_key(thr_old, 0u);
    unsigned long long m0, m1, m2, m3, m4, m5, m6, m7, m8;
    bool have = false;
    if (hi != lo) {
        do {
            const unsigned T = lo + ((hi - lo + 1u) >> 1);
            PRUNE_MASKS(T);
            const int c = __popcll(m0) + __popcll(m1) + __popcll(m2) + __popcll(m3) + __popcll(m4) + __popcll(m5) + __popcll(m6) + __popcll(m7) + __popcll(m8);
            const bool ge = c >= 256;
            lo = ge ? T : lo; hi = ge ? hi : T - 1u;
            have = ge && c <= 288;
        } while (!have && hi != lo);
    }
    if (!have) PRUNE_MASKS(lo);
    int pos = 0;
#define PRUNE_PUT(i_, m_) do { LAS unsigned* d_ = __builtin_amdgcn_inverse_ballot_w64(m_) ? lq + (pos + mbcnt64(m_)) : dummy; *d_ = v[i_]; pos += __popcll(m_); } while (0)
    PRUNE_PUT(0, m0); PRUNE_PUT(1, m1); PRUNE_PUT(2, m2); PRUNE_PUT(3, m3); PRUNE_PUT(4, m4); PRUNE_PUT(5, m5); PRUNE_PUT(6, m6); PRUNE_PUT(7, m7); PRUNE_PUT(8, m8);
#undef PRUNE_PUT
    if (lane == 0) { *cntp = (unsigned)pos; *thrp = key_lower_float(lo); }
    asm volatile("s_waitcnt lgkmcnt(0)" ::: "memory");
    __builtin_amdgcn_s_setprio(0);
}
#undef PRUNE_MASKS

__device__ __forceinline__ void b2_loadK(u32x4 (&Kf)[4], const LAS unsigned* sq, int ci, const fp8_t* KBb, int lane) {
    const int g = lane >> 4;
#pragma unroll
    for (int tt = 0; tt < 4; ++tt) {
        const unsigned off = (sq[64 * ci + 16 * tt + (lane & 15)] & 0xFFFFFFu) + 16u * (unsigned)g;
        Kf[tt] = *(const u32x4*)((const char*)KBb + off);
    }
}
__device__ __forceinline__ void b2_loadV(u32x4 (&Vf)[4], const LAS unsigned* sq, int ci, const fp8_t* VBb, int lane) {
#pragma unroll
    for (int r = 0; r < 4; ++r) {
        const int pc = lane + 64 * r, row = pc >> 2, dt = pc & 3;
        const unsigned off = (sq[64 * ci + row] & 0xFFFFFFu) + 16u * (unsigned)dt;
        Vf[r] = *(const u32x4*)((const char*)VBb + off);
    }
}
struct B2State { f32x4 o[4]; float mrun, lrun; long qb[2]; u32x2 qbn[2]; unsigned zz[4]; };
template <int VAR> __device__ __forceinline__ void b2_step(Ctx& C, B2State& st, const u32x4 (&Kf)[4], const u32x4 (&Vf)[4], const LAS unsigned* sq, const LAS float* t5L, LAS unsigned char* vimg,
                                        int ci, int nchunk, int ns, size_t tok, int pos, fp8_t* outp, int opitch, int lane, bool haveNext) {
    const int hd = lane & 15, g = lane >> 4, hd7 = hd & 7;
    const int qq4 = hd >> 2, pp = hd & 3;
    if (ci == 0) {
#pragma unroll
        for (int d = 0; d < 4; ++d) st.o[d] = (f32x4){0.f, 0.f, 0.f, 0.f};
        st.mrun = -1e30f; st.lrun = 0.f;
#pragma unroll
        for (int ks = 0; ks < 2; ++ks) {
            u32x2 q8 = st.qbn[ks];
            if (hd >= 8) q8 = (u32x2){0u, 0u};
            st.qb[ks] = __builtin_bit_cast(long, q8);
        }
#pragma unroll
        for (int d = 0; d < 4; ++d) st.zz[d] = *(const unsigned*)((const unsigned char*)(C.P + tok * PW + C_ZB) + hd7 * 64 + 4 * g + 16 * d);
        {
            const size_t tokn = haveNext ? tok + 1 : tok;
#pragma unroll
            for (int ks = 0; ks < 2; ++ks) st.qbn[ks] = *(const u32x2*)((const unsigned char*)(C.P + tokn * PW + C_QB) + hd7 * 64 + 32 * ks + 8 * g);
        }
    }
#pragma unroll
    for (int r = 0; r < 4; ++r) {
        const int pc = lane + 64 * r, row = pc >> 2, dt = pc & 3;
        const int pos = (row & 32) + 8 * ((row >> 2) & 3) + 4 * ((row >> 4) & 1) + (row & 3);
        *(LAS u32x4*)(vimg + dt * 1024 + pos * 16) = Vf[r];
    }
    const int hup = hd >> 3;
    u32x4 kk[2];
#pragma unroll
    for (int p = 0; p < 2; ++p) kk[p] = *(const LAS u32x4*)(sq + 16 * (4 * ci + 2 * p + hup) + 4 * g);
    float bias[2][4];
#pragma unroll
    for (int p = 0; p < 2; ++p)
#pragma unroll
        for (int i = 0; i < 4; ++i) bias[p][i] = t5L[(kk[p][i] >> 24) * 8 + hd7];
    f32x4 acc4[4];
#pragma unroll
    for (int tt = 0; tt < 4; ++tt) {
        f32x4 a = (f32x4){0.f, 0.f, 0.f, 0.f};
        a = __builtin_amdgcn_mfma_f32_16x16x32_fp8_fp8(__builtin_bit_cast(long, (u32x2){Kf[tt].x, Kf[tt].y}), st.qb[0], a, 0, 0, 0);
        acc4[tt] = __builtin_amdgcn_mfma_f32_16x16x32_fp8_fp8(__builtin_bit_cast(long, (u32x2){Kf[tt].z, Kf[tt].w}), st.qb[1], a, 0, 0, 0);
    }
    float lg[2][4];
    float cmax = -1e30f;
#pragma unroll
    for (int p = 0; p < 2; ++p)
#pragma unroll
        for (int i = 0; i < 4; ++i) {
            const float f = __uint_as_float((unsigned)__builtin_amdgcn_update_dpp((int)__float_as_uint(acc4[2 * p][i]), (int)__float_as_uint(acc4[2 * p + 1][i]), 0x128, 0xf, 0xc, false));
            const float x = __builtin_fmaf(f, 0.125f, bias[p][i]);
            lg[p][i] = x; cmax = fmaxf(cmax, x);
        }
    cmax = xmax32(xmax16(cmax));
    cmax = fmaxf(cmax, __uint_as_float(dpp_u<0x128, 0xf>(0u, __float_as_uint(cmax))));
    const float mn = fmaxf(st.mrun, cmax); const float alpha = __builtin_amdgcn_exp2f(st.mrun - mn); st.mrun = mn;
    float ps = 0.f;
#pragma unroll
    for (int p = 0; p < 2; ++p)
#pragma unroll
        for (int i = 0; i < 4; ++i) { const float e = __builtin_amdgcn_exp2f(lg[p][i] - mn); lg[p][i] = e; ps += e; }
    st.lrun = st.lrun * alpha + ps;
#pragma unroll
    for (int d = 0; d < 4; ++d) st.o[d] = st.o[d] * alpha;
    asm volatile("" ::: "memory");
    {
        long vf[2][4];
#pragma unroll
        for (int ul = 0; ul < 2; ++ul)
#pragma unroll
            for (int d = 0; d < 4; ++d) {
                LAS unsigned char* pa = vimg + d * 1024 + (32 * ul + 8 * g + (hd >> 1)) * 16 + 8 * (hd & 1);
                vf[ul][d] = __builtin_bit_cast(long, __builtin_amdgcn_ds_read_tr8_b64_v2i32((LAS i32x2*)pa));
            }
#pragma unroll
        for (int ul = 0; ul < 2; ++ul) {
            u32x2 w;
            w.x = pk4_fp8_raw(lg[ul][0], lg[ul][1], lg[ul][2], lg[ul][3]);
            w.y = dpp_u<0x128, 0xf>(0u, w.x);
            const long pb = __builtin_bit_cast(long, w);
#pragma unroll
            for (int d = 0; d < 4; ++d) st.o[d] = __builtin_amdgcn_mfma_f32_16x16x32_fp8_fp8(vf[ul][d], pb, st.o[d], 0, 0, 0);
        }
    }
    asm volatile("" ::: "memory");
    if (ci == nchunk - 1) {
        float l = xsum32(xsum16(st.lrun));
        l += __uint_as_float(dpp_u<0x128, 0xf>(0u, __float_as_uint(l)));
        const float inv = __builtin_amdgcn_rcpf(l);
        if (hd < 8) {
            fp8_t* op = outp + tok * (size_t)opitch + hd * 64 + 4 * g;
            const float inv8 = inv * Y8_SCALE;
#pragma unroll
            for (int d = 0; d < 4; ++d) {
                const int z = (int)st.zz[d];
                *(unsigned*)(op + 16 * d) = pk4_fp8(st.o[d][0] * inv8 * __builtin_amdgcn_cvt_f32_fp8(z, 0), st.o[d][1] * inv8 * __builtin_amdgcn_cvt_f32_fp8(z, 1), st.o[d][2] * inv8 * __builtin_amdgcn_cvt_f32_fp8(z, 2), st.o[d][3] * inv8 * __builtin_amdgcn_cvt_f32_fp8(z, 3));
            }
        }
    }
}

template <int MODE> __device__ __forceinline__ void mixerB_unit(Ctx& C, int b, int c, fp8_t* outp, int opitch, unsigned& psync) {
    int lane = C.lane; const int wave = C.wave;
    asm volatile("" : "+v"(lane));
    LAS unsigned* listL = (LAS unsigned*)(C.lds + BF_LIST);
    LAS unsigned* cntL = (LAS unsigned*)(C.lds + BF_CNT);
    LAS float* thrL = (LAS float*)(C.lds + BF_THRF);
    LAS unsigned* histL = (LAS unsigned*)(C.lds + BF_HIST + wave * 1024);
    LAS float* t5L = (LAS float*)(C.lds + BF_T5);
    LAS unsigned* dummyW = (LAS unsigned*)(C.lds + BF_END) + (wave * 64 + lane);
    static_assert(BF_END + 8 * 64 * 4 <= LDS_BYTES - 128, "dummy words fit behind the LDS map");
    const int n = (c + 1) * 64;
    const int nround = (n + 127) >> 7;
    LAS unsigned* cntF = cntL + 64 * (nround & 1);
    const size_t tok0 = (size_t)b * SEQ + (size_t)c * 64;
    LAS unsigned* pbar = (LAS unsigned*)(C.lds + BF_PBAR) + (wave >> 1);
#define PAIR_SYNC() do { asm volatile("s_waitcnt lgkmcnt(0)" ::: "memory"); ++psync; \
                (void)__hip_atomic_fetch_add(lane == 0 ? pbar : dummyW, 1u, __ATOMIC_RELAXED, __HIP_MEMORY_SCOPE_WORKGROUP);        \
                for (unsigned sp_ = 0; sp_ < (1u << 24); ++sp_) { \
                    const unsigned pv_ = (unsigned)__builtin_amdgcn_readfirstlane((int)__hip_atomic_load(pbar, __ATOMIC_RELAXED, __HIP_MEMORY_SCOPE_WORKGROUP)); \
                    if (pv_ >= 2u * psync) break; __builtin_amdgcn_s_sleep(0); } \
                asm volatile("" ::: "memory"); } while (0)
    if (lane < 8) {
        const int q8 = 8 * wave + lane;
        cntL[q8] = 0u; thrL[q8] = -INFINITY;
        LAS unsigned* pe = (LAS unsigned*)(C.lds + BF_PEND);
        pe[q8] = 0u; pe[64 + q8] = 0u; pe[128 + q8] = 0u;
    }
    PAIR_SYNC();
    if (MODE < 4) {
        const int qg4 = wave >> 1, kw = wave & 1;
        const int ql = lane & 15, g = lane >> 4;
        const int q = 16 * qg4 + ql;
        bf16x8 qf[8][2];
        const bf16_t* Qp = C.P + (tok0 + q) * PW + C_QI + 8 * g;
#pragma unroll
        for (int h = 0; h < 8; ++h)
#pragma unroll
            for (int ks = 0; ks < 2; ++ks) qf[h][ks] = *(const bf16x8*)(Qp + h * 64 + 32 * ks);
        float wv[8];
        { const f32x4 w0 = *(const f32x4*)(C.WI + (tok0 + q) * 8), w1 = *(const f32x4*)(C.WI + (tok0 + q) * 8 + 4);
          wv[0] = 0.5f * w0.x; wv[1] = 0.5f * w0.y; wv[2] = 0.5f * w0.z; wv[3] = 0.5f * w0.w; wv[4] = 0.5f * w1.x; wv[5] = 0.5f * w1.y; wv[6] = 0.5f * w1.z; wv[7] = 0.5f * w1.w; }
        bf16x8 qhi[2], qlo[2];
#pragma unroll
        for (int ks = 0; ks < 2; ++ks) {
            float acc8[8];
#pragma unroll
            for (int e = 0; e < 8; ++e) acc8[e] = 0.f;
#pragma unroll
            for (int h = 0; h < 8; ++h) {
                const u32x4 t = __builtin_bit_cast(u32x4, qf[h][ks]);
#pragma unroll
                for (int e = 0; e < 4; ++e) { acc8[2 * e] += wv[h] * bf_lo(t[e]); acc8[2 * e + 1] += wv[h] * bf_hi(t[e]); }
            }
            u32x4 hi_, lo_;
#pragma unroll
            for (int e = 0; e < 4; ++e) {
                const unsigned hp = cvtpk(acc8[2 * e], acc8[2 * e + 1]);
                hi_[e] = hp; lo_[e] = cvtpk(acc8[2 * e] - bf_lo(hp), acc8[2 * e + 1] - bf_hi(hp));
            }
            qhi[ks] = __builtin_bit_cast(bf16x8, hi_); qlo[ks] = __builtin_bit_cast(bf16x8, lo_);
        }
        const __amdgpu_buffer_rsrc_t krs = __builtin_amdgcn_make_buffer_rsrc((void*)(C.KI + (size_t)b * SEQ * 64), (short)0, SEQ * 128, 0x00020000);
        const unsigned kvoff = (unsigned)(ql * 128 + 16 * g);
        LAS unsigned* lq = listL + q * BF_STRIDE;
        LAS unsigned* pendL = (LAS unsigned*)(C.lds + BF_PEND);
        int p3 = 0;
        bf16x8 kc[4][2];
#define B1_COUNT16(np_, t_) asm("v_cmp_ge_f32_e32 vcc, %1, %17\n\tv_addc_co_u32_e32 %0, vcc, 0, %0, vcc\n\tv_cmp_ge_f32_e32 vcc, %2, %17\n\tv_addc_co_u32_e32 %0, vcc, 0, %0, vcc\n\tv_cmp_ge_f32_e32 vcc, %3, %17\n\tv_addc_co_u32_e32 %0, vcc, 0, %0, vcc\n\tv_cmp_ge_f32_e32 vcc, %4, %17\n\tv_addc_co_u32_e32 %0, vcc, 0, %0, vcc\n\tv_cmp_ge_f32_e32 vcc, %5, %17\n\tv_addc_co_u32_e32 %0, vcc, 0, %0, vcc\n\tv_cmp_ge_f32_e32 vcc, %6, %17\n\tv_addc_co_u32_e32 %0, vcc, 0, %0, vcc\n\tv_cmp_ge_f32_e32 vcc, %7, %17\n\tv_addc_co_u32_e32 %0, vcc, 0, %0, vcc\n\tv_cmp_ge_f32_e32 vcc, %8, %17\n\tv_addc_co_u32_e32 %0, vcc, 0, %0, vcc\n\tv_cmp_ge_f32_e32 vcc, %9, %17\n\tv_addc_co_u32_e32 %0, vcc, 0, %0, vcc\n\tv_cmp_ge_f32_e32 vcc, %10, %17\n\tv_addc_co_u32_e32 %0, vcc, 0, %0, vcc\n\tv_cmp_ge_f32_e32 vcc, %11, %17\n\tv_addc_co_u32_e32 %0, vcc, 0, %0, vcc\n\tv_cmp_ge_f32_e32 vcc, %12, %17\n\tv_addc_co_u32_e32 %0, vcc, 0, %0, vcc\n\tv_cmp_ge_f32_e32 vcc, %13, %17\n\tv_addc_co_u32_e32 %0, vcc, 0, %0, vcc\n\tv_cmp_ge_f32_e32 vcc, %14, %17\n\tv_addc_co_u32_e32 %0, vcc, 0, %0, vcc\n\tv_cmp_ge_f32_e32 vcc, %15, %17\n\tv_addc_co_u32_e32 %0, vcc, 0, %0, vcc\n\tv_cmp_ge_f32_e32 vcc, %16, %17\n\tv_addc_co_u32_e32 %0, vcc, 0, %0, vcc" : "+v"(np_) : "v"(sc[0][0]), "v"(sc[0][1]), "v"(sc[0][2]), "v"(sc[0][3]), "v"(sc[1][0]), "v"(sc[1][1]), "v"(sc[1][2]), "v"(sc[1][3]), "v"(sc[2][0]), "v"(sc[2][1]), "v"(sc[2][2]), "v"(sc[2][3]), "v"(sc[3][0]), "v"(sc[3][1]), "v"(sc[3][2]), "v"(sc[3][3]), "v"(t_) : "vcc")
#define B1_LOADKT(tt_, k0_) do { const int so_ = ((k0_) + 16 * (tt_)) * 128; kc[tt_][0] = __builtin_bit_cast(bf16x8, __builtin_amdgcn_raw_buffer_load_b128(krs, (int)kvoff, so_, 0)); kc[tt_][1] = __builtin_bit_cast(bf16x8, __builtin_amdgcn_raw_buffer_load_b128(krs, (int)kvoff + 64, so_, 0)); } while (0)
        if (64 * kw < n) {
#pragma unroll
            for (int tt = 0; tt < 4; ++tt) B1_LOADKT(tt, 64 * kw);
        }
#pragma unroll 1
        for (int r = 0; r < nround; ++r) {
            const int k0 = 128 * r + 64 * kw;
            f32x4 sc[4];
            const int knext = (k0 + 128 < n) ? k0 + 128 : k0;
            const bool live = k0 < n;
            {
                f32x4 hacc[3];
                __builtin_amdgcn_s_setprio(2);
#pragma unroll
                for (int m = 0; m < 34; ++m) {
                    if (m < 32) {
                        const int tt = m >> 3, h = m & 7;
                        if (h == 0) {
                            f32x4 sacc = (f32x4){0.f, 0.f, 0.f, 0.f};
                            sacc = __builtin_amdgcn_mfma_f32_16x16x32_bf16(kc[tt][0], qhi[0], sacc, 0, 0, 0);
                            sacc = __builtin_amdgcn_mfma_f32_16x16x32_bf16(kc[tt][1], qhi[1], sacc, 0, 0, 0);
                            sc[tt] = sacc;
                        }
                        f32x4 a = (f32x4){0.f, 0.f, 0.f, 0.f};
                        a = __builtin_amdgcn_mfma_f32_16x16x32_bf16(kc[tt][0], qf[h][0], a, 0, 0, 0);
                        hacc[m % 3] = __builtin_amdgcn_mfma_f32_16x16x32_bf16(kc[tt][1], qf[h][1], a, 0, 0, 0);
                        if (h == 7) B1_LOADKT(tt, knext);
                    }
                    __builtin_amdgcn_sched_barrier(0);
                    if (m >= 2) {
                        const int mm = m - 2, tt = mm >> 3, h = mm & 7;
#pragma unroll
                        for (int i = 0; i < 4; ++i) { sc[tt][i] = __builtin_fmaf(wv[h], __builtin_fabsf(hacc[mm % 3][i]), sc[tt][i]); asm volatile("" : "+v"(sc[tt][i])); }
                    }
                    __builtin_amdgcn_sched_barrier(0);
                }
                __builtin_amdgcn_s_setprio(0);
            }
            LAS unsigned* cur = cntL + 64 * (r & 1);
            LAS unsigned* nxt = cntL + 64 * ((r + 1) & 1);
            LAS unsigned* pendR = pendL + 64 * p3;
            LAS unsigned* pendZ = pendL + 64 * (p3 == 0 ? 2 : p3 - 1);
            p3 = (p3 == 2) ? 0 : p3 + 1;
            float thr;
            { float t_ = thrL[q]; asm volatile("" : "+v"(t_)); thr = live ? t_ : __builtin_nanf(""); }
            int np = 0;
            B1_COUNT16(np, thr);
            unsigned base = 0u;
            base = __hip_atomic_fetch_add(pendR + q, (unsigned)np, __ATOMIC_RELAXED, __HIP_MEMORY_SCOPE_WORKGROUP);
            PAIR_SYNC();
            {
                const int cmine = (int)cur[q], pmine = (int)pendR[q];
                pendZ[q] = 0u;
                const unsigned pm = (unsigned)__ballot(cmine + pmine > BF_CAP) & 0xFFFFu;
                const bool mine = (pm >> ql) & 1u;
                { LAS unsigned* d_ = mine ? dummyW : nxt + q; *d_ = (unsigned)(cmine + pmine); }
                base += (unsigned)cmine;
                if (pm) {
                    unsigned pw = pm;
                    int idx = 0;
                    while (pw) {
                        const int j = __builtin_ctz(pw); pw &= pw - 1u;
                        if ((idx & 1) == kw) {
                            const int qq = 16 * qg4 + j;
                            const int cn = __builtin_amdgcn_readlane(cmine, j);
                            prune_query(listL + qq * BF_STRIDE, nxt + qq, thrL + qq, dummyW, cn, lane);
                        }
                        ++idx;
                    }
                    PAIR_SYNC();
                    { float t_ = thrL[q]; asm volatile("" : "+v"(t_)); thr = live ? t_ : __builtin_nanf(""); }
                    np = 0;
                    B1_COUNT16(np, thr);
                    const unsigned rb = __hip_atomic_fetch_add(mine ? nxt + q : dummyW, (unsigned)np, __ATOMIC_RELAXED, __HIP_MEMORY_SCOPE_WORKGROUP);
                    base = mine ? rb : base;
                }
            }
            {
                LAS unsigned* ap = lq + base;
                LAS unsigned* dummy = dummyW;
                const unsigned kb = (unsigned)(8191 - (k0 + 4 * g)) & 0x1FCCu;
#pragma unroll
                for (int tt = 0; tt < 4; ++tt) {
#pragma unroll
                    for (int i = 0; i < 4; ++i) {
                        const bool p = sc[tt][i] >= thr;
                        LAS unsigned* dst = p ? ap : dummy;
                        *dst = pack_key(sc[tt][i], kb) | (unsigned)(((3 - tt) << 4) | (3 - i));
                        ap += p ? 1 : 0;
                    }
                }
            }
        }
        PAIR_SYNC();
#undef B1_LOADKT
#undef B1_COUNT16
    }
    if (MODE >= 4) { if (C.tid < 64) cntF[C.tid] = (unsigned)(n < 256 ? n : 256); __syncthreads(); }
#pragma unroll 1
    for (int j = 0; j < 8; ++j) {
        const int qq = 8 * wave + j;
        const int cn = __builtin_amdgcn_readfirstlane((int)cntF[qq]);
        if (MODE < 2 && cn > 256) select_query(listL + qq * BF_STRIDE, cntF + qq, thrL + qq, histL, dummyW, cn, true, lane);
    }
    asm volatile("s_waitcnt lgkmcnt(0)" ::: "memory");
    unsigned selp[8][4];
#pragma unroll
    for (int j = 0; j < 8; ++j) {
        const int qq = 8 * wave + j;
        const int cq = __builtin_amdgcn_readfirstlane((int)cntF[qq]);
        const u32x4 v = *(const LAS u32x4*)(listL + qq * BF_STRIDE + lane * 4);
#pragma unroll
        for (int k = 0; k < 4; ++k) {
            int id = (int)(8191u - (v[k] & 0x1FFFu));
            if (MODE == 4 || MODE >= 6) id = (lane * 4 + k) & 63;
            if (MODE == 5) id = (int)(((unsigned)(lane * 4 + k) * 2654435761u + (unsigned)qq * 40503u) >> 7) % n;
            unsigned sv = ((unsigned)id << 6) | ((unsigned)t5_bucket(id - (c * 64 + qq)) << 24);
            asm volatile("" : "+v"(sv));
            selp[j][k] = (lane * 4 + k < cq) ? sv : 0u;
        }
    }
    asm volatile("s_waitcnt lgkmcnt(0)" ::: "memory");
    LAS unsigned* selL = listL + (8 * wave) * BF_STRIDE;
#pragma unroll
    for (int j = 0; j < 8; ++j) *(LAS u32x4*)(selL + j * 256 + lane * 4) = (u32x4){selp[j][0], selp[j][1], selp[j][2], selp[j][3]};
    asm volatile("s_waitcnt lgkmcnt(0)" ::: "memory");
    if (MODE >= 1 && MODE < 4) { if (lane < 8) outp[(tok0 + 8 * wave + lane) * (size_t)opitch + 1] = (fp8_t)selL[lane * 256 + 3]; __syncthreads(); return; }
    {
        asm volatile("" : "+v"(lane));
        LAS unsigned char* vimg = (LAS unsigned char*)selL + 8192;
        const fp8_t* KBb = (const fp8_t*)C.KB + (size_t)b * SEQ * 64;
        const fp8_t* VBb = (const fp8_t*)C.VB + (size_t)b * SEQ * 64;
        const int nsu = n < 256 ? n : 256, nchunk = nsu >> 6, nsteps = 8 * nchunk;
        u32x4 KA[4], KBf[4]; u32x4 VA[4], VBf[4];
        B2State st;
        int jj = 0, ci = 0, jn = 0, cnx = 0;
#define B2_ADV(j_, c_) do { if (++(c_) == nchunk) { (c_) = 0; ++(j_); } } while (0)
#define B2_STEP(Kf_, Vf_, Kn_, Vn_, more_) do { const int qq_ = 8 * wave + jj; const int ns_ = __builtin_amdgcn_readfirstlane((int)cntF[qq_]); \
        if (more_) { b2_loadK(Kn_, selL + jn * 256, cnx, KBb, lane); b2_loadV(Vn_, selL + jn * 256, cnx, VBb, lane); B2_ADV(jn, cnx); } \
        b2_step<(MODE == 6 ? 1 : MODE == 7 ? 2 : 0)>(C, st, Kf_, Vf_, selL + jj * 256, t5L, vimg, ci, nchunk, ns_, tok0 + qq_, c * 64 + qq_, outp, opitch, lane, jj < 7); B2_ADV(jj, ci); } while (0)
        b2_loadK(KA, selL + jn * 256, cnx, KBb, lane); b2_loadV(VA, selL + jn * 256, cnx, VBb, lane); B2_ADV(jn, cnx);
        { const int hd7_ = lane & 7, g_ = lane >> 4;
#pragma unroll
          for (int ks = 0; ks < 2; ++ks) st.qbn[ks] = *(const u32x2*)((const unsigned char*)(C.P + (tok0 + 8 * wave) * PW + C_QB) + hd7_ * 64 + 32 * ks + 8 * g_); }
        if (nchunk == 4) {
#define B2_LD(Kn_, Vn_, j_, c_) do { b2_loadK(Kn_, selL + (j_) * 256, c_, KBb, lane); b2_loadV(Vn_, selL + (j_) * 256, c_, VBb, lane); } while (0)
#define B2_ST(Kf_, Vf_, j_, c_) b2_step<0>(C, st, Kf_, Vf_, selL + (j_) * 256, t5L, vimg, c_, 4, 256, tok0 + 8 * wave + (j_), c * 64 + 8 * wave + (j_), outp, opitch, lane, (j_) < 7)
#pragma unroll 1
            for (int j = 0; j < 8; ++j) {
                B2_LD(KBf, VBf, j, 1); B2_ST(KA, VA, j, 0);
                B2_LD(KA, VA, j, 2);   B2_ST(KBf, VBf, j, 1);
                B2_LD(KBf, VBf, j, 3); B2_ST(KA, VA, j, 2);
                if (j < 7) B2_LD(KA, VA, j + 1, 0);
                B2_ST(KBf, VBf, j, 3);
            }
#undef B2_LD
#undef B2_ST
        } else {
#pragma unroll 1
            for (int s = 0; s < nsteps; s += 2) {
                B2_STEP(KA, VA, KBf, VBf, true);
                B2_STEP(KBf, VBf, KA, VA, (s + 2 < nsteps));
            }
        }
#undef B2_ADV
#undef B2_STEP
    }
#undef PAIR_SYNC
}

#define XB_TMO      128
#define XB_XCNT(j)  (256  + 64 * (j))
#define XB_XSUB(j)  (1280 + 64 * (j))
#define XB_XGEN(j)  (2304 + 64 * (j))
#define XB_TOP      3328
#define XB_TOPGEN   3392
#define XCD_BAR_WORDS 3456
#define XB_SPIN_CAP (1u << 18)
__device__ __forceinline__ unsigned xb_ld(unsigned* p)              { return __hip_atomic_load(p, __ATOMIC_RELAXED, __HIP_MEMORY_SCOPE_AGENT); }
__device__ __forceinline__ unsigned xb_add(unsigned* p, unsigned v) { return __hip_atomic_fetch_add(p, v, __ATOMIC_RELAXED, __HIP_MEMORY_SCOPE_AGENT); }
__device__ __forceinline__ unsigned xb_xcc_id() { return (unsigned)__builtin_amdgcn_s_getreg((3 << 11) | 20) & 0xFu; }
#define XB_SPIN(cond, bar) do { unsigned _sp = 0; while (cond) { __builtin_amdgcn_s_sleep(1); \
    if ((++_sp & 255u) == 0u) { if (xb_ld(&(bar)[XB_TMO])) break; if (_sp > XB_SPIN_CAP) { atomicAdd(&(bar)[XB_TMO], 1u); break; } } } } while (0)
struct XcdBarrier { unsigned* bar; unsigned x; volatile LAS unsigned* st; };
__device__ __forceinline__ XcdBarrier xcd_barrier_post(unsigned* bar, volatile LAS unsigned* st) {
    XcdBarrier b; b.bar = bar; b.x = xb_xcc_id(); b.st = st;
    if (threadIdx.x == 0) (void)xb_add(&bar[XB_XCNT(b.x)], 1u);
    return b;
}
__device__ __forceinline__ void xcd_barrier_complete(unsigned* bar, unsigned x, unsigned& nloc, unsigned& nx) {
    const unsigned G = gridDim.x * gridDim.y * gridDim.z;
    unsigned sum, cnt, mine, sp = 0u;
    for (;;) {
        sum = 0u; cnt = 0u; mine = 0u;
#pragma unroll
        for (unsigned j = 0; j < 16; ++j) { const unsigned c = xb_ld(&bar[XB_XCNT(j)]); sum += c; cnt += (c > 0u) ? 1u : 0u; mine = (j == x) ? c : mine; }
        if (sum == G) break;
        __builtin_amdgcn_s_sleep(1);
        if ((++sp & 255u) == 0u) { if (xb_ld(&bar[XB_TMO])) break; if (sp > XB_SPIN_CAP) { atomicAdd(&bar[XB_TMO], 1u); break; } }
    }
    nloc = mine > 0u ? mine : 1u; nx = cnt > 0u ? cnt : 1u;
}
__device__ __forceinline__ void xcd_barrier(const XcdBarrier& b) {
    asm volatile("s_waitcnt vmcnt(0)" ::: "memory");
    __syncthreads();
    if (threadIdx.x == 0) {
        unsigned* bar = b.bar;
        __builtin_amdgcn_s_waitcnt(0);
        unsigned nloc = b.st[0], nx = b.st[1];
        if (nloc == 0u) { xcd_barrier_complete(bar, b.x, nloc, nx); b.st[0] = nloc; b.st[1] = nx; }
        const unsigned old = xb_add(&bar[XB_XSUB(b.x)], 1u);
        const unsigned gen = old / nloc;
        if (old + 1u == (gen + 1u) * nloc) {
            __builtin_amdgcn_fence(__ATOMIC_RELEASE, "agent");
            asm volatile("s_waitcnt vmcnt(0)" ::: "memory");
            const unsigned og = xb_add(&bar[XB_TOP], 1u);
            const unsigned tg = og / nx;
            if (og + 1u == (tg + 1u) * nx) xb_add(&bar[XB_TOPGEN], 1u);
            else XB_SPIN(xb_ld(&bar[XB_TOPGEN]) == tg, bar);
            __builtin_amdgcn_fence(__ATOMIC_ACQUIRE, "agent");
            xb_add(&bar[XB_XGEN(b.x)], 1u);
            asm volatile("s_waitcnt vmcnt(0)" ::: "memory");
        } else {
            XB_SPIN(xb_ld(&bar[XB_XGEN(b.x)]) == gen, bar);
            __builtin_amdgcn_fence(__ATOMIC_ACQUIRE, "agent");
            asm volatile("s_waitcnt vmcnt(0)" ::: "memory");
        }
    }
    __syncthreads();
}

struct Args { const float* in[9]; float* out; unsigned char* ws; int ph_lo, ph_hi; };
__global__ void __launch_bounds__(NWAVES * 64, 2) fwd_kernel(Args args) {
    extern __shared__ __attribute__((aligned(16))) unsigned char lds_raw[];
    Ctx C;
    C.lds = (LAS unsigned char*)lds_raw;
    C.tid = threadIdx.x; C.lane = C.tid & 63; C.wave = __builtin_amdgcn_readfirstlane(C.tid >> 6);
    C.G = gridDim.x; C.bid = blockIdx.x; C.dbg = 0ull;
    C.x = args.in[0]; C.norm_gain = args.in[1]; C.w_in = args.in[2]; C.a_rel = args.in[3]; C.t5 = args.in[4];
    C.w_a = args.in[5]; C.w_b = args.in[6]; C.w_o = args.in[7]; C.fgain = args.in[8]; C.out = args.out;
    unsigned char* ws = args.ws;
    C.WT1 = (bf16_t*)(ws + WS_WT1); C.WAT = (fp8_t*)(ws + WS_WAT); C.WBT = (fp8_t*)(ws + WS_WBT); C.WOT = (fp8_t*)(ws + WS_WOT);
    C.Y8 = (fp8_t*)(ws + WS_Y8); C.MG8 = (fp8_t*)(ws + WS_XN8); C.WT18 = (fp8_t*)(ws + WS_WT18); C.XN8 = (fp8_t*)(ws + WS_XN8);
    C.KB = (bf16_t*)(ws + WS_KB); C.VB = (bf16_t*)(ws + WS_VB); C.KI = (bf16_t*)(ws + WS_KI); C.XN = (bf16_t*)(ws + WS_XN); C.P = (bf16_t*)(ws + WS_P);
    C.WI = (float*)(ws + WS_WI); C.RSS = (float*)(ws + WS_RSS); C.RSX = (float*)(ws + WS_RSX);
    const int lo = args.ph_lo, hi = args.ph_hi;
#if MK_ONE_LAUNCH
    volatile LAS unsigned* MISC = (volatile LAS unsigned*)(C.lds + LDS_BYTES - 64);
    if (C.tid < 16) MISC[C.tid] = 0u;
    __syncthreads();
    const XcdBarrier xbar = xcd_barrier_post((unsigned*)(ws + WS_CTL) + 1024, MISC);
#define GRID_SYNC() xcd_barrier(xbar)
#else
#define GRID_SYNC() do {} while (0)
#endif
#ifndef PH_ENABLE
#define PH_ENABLE 63
#endif
#define IN(k) (((PH_ENABLE >> (k)) & 1) && lo <= (k) && (k) < hi)
#define BOTH(k) (IN(k) && IN((k) + 1))

    if (IN(0)) {
        p0_prologue(C); if (BOTH(0)) GRID_SYNC(); }

    if (IN(1)) {
        if ((C.bid >> 3) & 1) { __builtin_amdgcn_s_sleep(127); __builtin_amdgcn_s_sleep(127); }
        {
            pg8::Gemm g{C.XN, C.WT1, C.XN, C.WT1, 2 * DM, 2 * DM, NTOK, 768, 2 * DM, 2 * DM};
            pg8::StaticOrder S; S.init(NTOK, 768, C.G, C.bid);
            EpiProj E{C.P, C.KB, C.VB, C.KI, C.WI, 0, 1.f};
            pg8::gemm_phase<EpiProj, pg8::StaticOrder, true>(C.lds, g, S, E);
        }
        {
            pg8::Gemm g{C.XN8, C.WT18, C.XN8, C.WT18, DM, DM, NTOK, 5120, DM, DM};
            pg8::SplitOrder S; S.init(NTOK, 5120, C.G, C.bid);
            EpiProj E{C.P, C.KB, C.VB, C.KI, C.WI, 1, 1.f / W8_SCALE};
            pg8::gemm_phase<EpiProj, pg8::SplitOrder, true, true>(C.lds, g, S, E);
        }
        if (BOTH(1)) GRID_SYNC();
    }

    if (IN(2)) {
        {
            if (C.tid < 4) ((LAS unsigned*)(C.lds + BF_PBAR))[C.tid] = 0u;
            for (int i = C.tid; i < 256; i += NWAVES * 64) ((LAS float*)(C.lds + BF_T5))[i] = C.t5[i] * LOG2E;
            __syncthreads();
            unsigned psync = 0u;
            for (int u = C.bid; u < BATCH * 64; u += C.G) { const int bb = (u & 7) >> 1, pi = (u >> 3) + 32 * (u & 1); mixerB_unit<0>(C, bb, 127 - pi, C.Y8 + 512, 1024, psync); mixerB_unit<0>(C, bb, pi, C.Y8 + 512, 1024, psync); }
        }
        {
            unsigned* actr = (unsigned*)(ws + WS_CTL) + 12288;
            LAS unsigned char* wlA = C.lds + BF_LIST + (8 * C.wave) * BF_STRIDE * 4;
            static_assert(A_WAVE_LDS <= 8 * BF_STRIDE * 4, "mixer A wave LDS fits in a wave's lists");
            int li = 0, px = C.bid & 7;
            unsigned pv = 0u;
#define A_ISSUE() do { px = (C.bid + li) & 7; pv = 0u; if (C.lane == 0) pv = __hip_atomic_fetch_add(actr + 16 * px, 1u, __ATOMIC_RELAXED, __HIP_MEMORY_SCOPE_AGENT); } while (0)
#define A_RESOLVE(t_) do { unsigned idx_ = (unsigned)__builtin_amdgcn_readfirstlane((int)pv); (t_) = -1; \
                for (;;) { if (idx_ < 512u) { (t_) = px + 8 * (int)idx_; break; } if (++li >= 8) break; A_ISSUE(); idx_ = (unsigned)__builtin_amdgcn_readfirstlane((int)pv); } } while (0)
            int task;
            A_ISSUE(); A_RESOLVE(task);
            while (task >= 0) {
                A_ISSUE();
                const int u = (task & 7) + 8 * (task >> 6), h = (task >> 3) & 7, uu = u & 255;
                mixerA_unit<0>(C, (uu & 7) >> 1, 64 * (uu & 1) + (uu >> 3) + 32 * (u >> 8), h, wlA, C.Y8, 1024);
                A_RESOLVE(task);
            }
#undef A_ISSUE
#undef A_RESOLVE
            __syncthreads();
        }
        if (BOTH(2)) GRID_SYNC();
    }

    if (IN(3)) {
        pg8::Gemm g{C.Y8, C.WAT, C.Y8 + 512, C.WBT, 1024, 512, NTOK, DM, 1024, 512};
        pg8::StaticOrder S; S.init(NTOK, DM, C.G, C.bid);
        EpiMerge E{C.P, C.MG8};
        pg8::gemm_phase<EpiMerge, pg8::StaticOrder, true, true>(C.lds, g, S, E);
        if (BOTH(3)) GRID_SYNC();
    }

    if (IN(4)) {
        pg8::Gemm g{C.MG8, C.WOT, C.MG8, C.WOT, DM, DM, NTOK, DM, DM, DM};
        pg8::StaticOrder S; S.init(NTOK, DM, C.G, C.bid);
        EpiOut E{C.XN, C.RSX, C.out, C.RSS, C.fgain, (unsigned*)(ws + WS_CTL) + 8192};
        pg8::gemm_phase<EpiOut, pg8::StaticOrder, true, true>(C.lds, g, S, E);
    }
#undef IN
#undef BOTH
}

extern "C" void kernel_launch(void* const* d_in, const int* in_sizes, int n_in, void* d_out, int out_size, void* d_ws, size_t ws_size, hipStream_t stream) {
    static int grid = 0;
    if (grid == 0) {
        if (n_in != 9 || in_sizes[0] != NTOK * DM || out_size != NTOK * DM || ws_size < WS_END) {
            fprintf(stderr, "kernel_launch: unexpected shapes (n_in %d, in0 %d, out %d, ws %zu)\n", n_in, n_in > 0 ? in_sizes[0] : -1, out_size, ws_size); grid = -1; return; }
        int dev = 0, cus = 0, per_cu = 0;
        if (hipGetDevice(&dev) != hipSuccess || hipDeviceGetAttribute(&cus, hipDeviceAttributeMultiprocessorCount, dev) != hipSuccess) { grid = -1; return; }
        if (hipFuncSetAttribute((const void*)fwd_kernel, hipFuncAttributeMaxDynamicSharedMemorySize, LDS_BYTES) != hipSuccess) { fprintf(stderr, "kernel_launch: hipFuncSetAttribute failed\n"); grid = -1; return; }
        if (hipOccupancyMaxActiveBlocksPerMultiprocessor(&per_cu, (const void*)fwd_kernel, NWAVES * 64, LDS_BYTES) != hipSuccess || per_cu < 1) { fprintf(stderr, "kernel_launch: occupancy query gives %d\n", per_cu); per_cu = 1; }
        (void)hipGetLastError();
        grid = cus;
    }
    if (grid < 0) return;
    Args a{};
    for (int i = 0; i < 9; ++i) a.in[i] = (const float*)d_in[i];
    a.out = (float*)d_out; a.ws = (unsigned char*)d_ws;
#if MK_ONE_LAUNCH
    a.ph_lo = 0; a.ph_hi = 5;
    if (hipMemsetAsync((char*)d_ws + WS_CTL, 0, 65536, stream) != hipSuccess) { fprintf(stderr, "kernel_launch: hipMemsetAsync failed\n"); return; }
    hipLaunchKernelGGL(fwd_kernel, dim3(grid), dim3(NWAVES * 64), LDS_BYTES, stream, a);
#else
    for (int ph = 0; ph < 5; ++ph) {
        a.ph_lo = ph; a.ph_hi = ph + 1;
        hipLaunchKernelGGL(fwd_kernel, dim3(grid), dim3(NWAVES * 64), LDS_BYTES, stream, a);
    }
#endif
}
```
